# Optimizing an MI355X kernel written in HIP

```python
import math
import jax, jax.numpy as jnp
from jax import lax
import numpy as np

D_MODEL = 1024
BATCH = 1
SEQ = 16384
DEPTH = 4
DEC_BATCH = 16
DEC_SEQ = 64
PAST_LEN = 4096

CHUNK = 64
Q_BLOCK = 128
MIX_WIDTH = D_MODEL
GLA_WIDTH = MIX_WIDTH // 2
GLA_HEADS = 4
GLA_DV = GLA_WIDTH // GLA_HEADS
GLA_DK = GLA_DV // 2
GLA_GATE_RANK = 16
GLA_GATE_NORMALIZER = 16.0
DIFF_WIDTH = MIX_WIDTH - GLA_WIDTH
DIFF_HEADS = 4
DIFF_DV = DIFF_WIDTH // DIFF_HEADS
DIFF_HEAD_DIM = DIFF_DV // 2
DIFF_KDIM = 2 * DIFF_HEAD_DIM
T5_BUCKETS = 32
T5_MAX_DIST = 128
D_FF = ((8 * D_MODEL // 3 + 255) // 256) * 256
NEG_INF = -1e30
RMS_EPS = 1e-6
IN_SPLITS = (GLA_HEADS * GLA_DK, GLA_HEADS * GLA_DK, GLA_WIDTH, GLA_WIDTH, GLA_GATE_RANK,
             DIFF_HEADS * DIFF_KDIM, DIFF_HEADS * DIFF_KDIM, DIFF_WIDTH)
D_IN = 2 * GLA_HEADS * GLA_DK + 2 * GLA_WIDTH + GLA_GATE_RANK + 2 * DIFF_HEADS * DIFF_KDIM + DIFF_WIDTH

kernel_name = 'hymba_gla_diffattn_streaming_step'


def split_points():
    pts, acc = [], 0
    for s in IN_SPLITS[:-1]:
        acc += s
        pts.append(acc)
    return pts


def rmsnorm(x, g):
    xf = x.astype(jnp.float32)
    y = xf * lax.rsqrt(jnp.mean(xf * xf, axis=-1, keepdims=True) + RMS_EPS)
    return (y * g.astype(jnp.float32)).astype(x.dtype)


def t5_bucket(rel):
    nb = T5_BUCKETS // 2
    max_exact = nb // 2
    ret = jnp.where(rel > 0, nb, 0)
    n = jnp.abs(rel)
    nf = jnp.maximum(n, 1).astype(jnp.float32)
    large = max_exact + (jnp.log(nf / max_exact) / math.log(T5_MAX_DIST / max_exact)
                         * (nb - max_exact)).astype(jnp.int32)
    large = jnp.minimum(large, nb - 1)
    return ret + jnp.where(n < max_exact, n, large)


def gla_chunk(S, q, k, v, log_a):
    L = q.shape[1]
    b = jnp.cumsum(log_a.astype(jnp.float32), axis=1)
    causal = jnp.tril(jnp.ones((L, L), dtype=bool))
    rel = b[:, :, None] - b[:, None, :]
    decay = jnp.exp(jnp.where(causal[None, :, :, None, None], rel, NEG_INF))
    scores = jnp.einsum('bthd,bshd,btshd->bhts', q, k, decay)
    o_intra = jnp.einsum('bhts,bshv->bthv', scores, v)
    o_inter = jnp.einsum('bthd,bhdv->bthv', q * jnp.exp(b), S)
    b_last = b[:, -1]
    k_dec = k * jnp.exp(b_last[:, None] - b)
    S_new = jnp.exp(b_last)[..., None] * S + jnp.einsum('bshd,bshv->bhdv', k_dec, v)
    return S_new.astype(S.dtype), (o_intra + o_inter).astype(jnp.float32)


def gla_prompt(q, k, v, log_a):
    B, T = q.shape[:2]
    n = T // CHUNK

    def to_chunks(a):
        return jnp.moveaxis(a.reshape(B, n, CHUNK, *a.shape[2:]), 1, 0)

    S0 = jnp.zeros((B, GLA_HEADS, GLA_DK, GLA_DV), jnp.float32)
    S_fin, o = lax.scan(lambda S, c: gla_chunk(S, *c), S0,
                        (to_chunks(q), to_chunks(k), to_chunks(v), to_chunks(log_a)))
    o = jnp.moveaxis(o, 0, 1).reshape(B, T, GLA_HEADS, GLA_DV)
    return o, S_fin


def diff_attend(q, k, v, qpos, kpos, lam, rel_bias):
    logits = jnp.einsum('bqhmd,bkhmd->bhmqk', q, k).astype(jnp.float32) * (DIFF_HEAD_DIM ** -0.5)
    bias = jnp.transpose(rel_bias[t5_bucket(kpos[None, :] - qpos[:, None])].astype(jnp.float32), (2, 0, 1))
    allowed = (kpos[None, :] // CHUNK) <= (qpos[:, None] // CHUNK)
    logits = jnp.where(allowed, logits + bias[None, :, None], NEG_INF)
    p = jax.nn.softmax(logits, axis=-1)
    a = p[:, :, 0] - lam * p[:, :, 1]
    return jnp.einsum('bhqk,bkhv->bqhv', a, v.astype(jnp.float32))


def diff_prompt(q, k, v, lam, rel_bias):
    B, T = q.shape[:2]
    nb = T // Q_BLOCK
    qb = jnp.moveaxis(q.reshape(B, nb, Q_BLOCK, *q.shape[2:]), 1, 0)
    starts = jnp.arange(nb, dtype=jnp.int32) * Q_BLOCK
    kpos = jnp.arange(T, dtype=jnp.int32)

    def block(args):
        qblk, s = args
        return diff_attend(qblk, k, v, s + jnp.arange(Q_BLOCK, dtype=jnp.int32), kpos, lam, rel_bias)

    o = lax.map(block, (qb, starts))
    return jnp.moveaxis(o, 0, 1).reshape(B, T, DIFF_HEADS, DIFF_DV)


def run_trunk(x, past_k, past_v, gla_state, w_in, gla_w_alpha2, gla_b_alpha, gla_norm_g,
              diff_lambda, diff_norm_g, w_out, norm_mix_g, norm_ffn_g, w_ffn_in, w_ffn_out,
              final_norm_g, rel_bias):
    B, T, _ = x.shape
    new_k, new_v, new_s = [], [], []
    for l in range(DEPTH):
        xn = rmsnorm(x, norm_mix_g[l])
        gq, gk, gv, gg, glr, dq, dk, dv = jnp.split(xn @ w_in[l], split_points(), axis=-1)
        q = gq.reshape(B, T, GLA_HEADS, GLA_DK) * (GLA_DK ** -0.5)
        k = gk.reshape(B, T, GLA_HEADS, GLA_DK)
        v = gv.reshape(B, T, GLA_HEADS, GLA_DV)
        z = (glr @ gla_w_alpha2[l] + gla_b_alpha[l]).astype(jnp.float32)
        log_a = (jax.nn.log_sigmoid(z) / GLA_GATE_NORMALIZER).reshape(B, T, GLA_HEADS, GLA_DK)
        if gla_state is None:
            o_gla, s_fin = gla_prompt(q, k, v, log_a)
        else:
            s_fin, o_gla = gla_chunk(gla_state[l], q, k, v, log_a)
        o_gla = rmsnorm(o_gla, gla_norm_g[l]).reshape(B, T, GLA_WIDTH) * jax.nn.silu(gg.astype(jnp.float32))
        lam_init = 0.8 - 0.6 * math.exp(-0.3 * l)
        lp = diff_lambda[l].astype(jnp.float32)
        lam = jnp.exp(jnp.sum(lp[0] * lp[1])) - jnp.exp(jnp.sum(lp[2] * lp[3])) + lam_init
        qd = dq.reshape(B, T, DIFF_HEADS, 2, DIFF_HEAD_DIM)
        kd = dk.reshape(B, T, DIFF_HEADS, 2, DIFF_HEAD_DIM)
        vd = dv.reshape(B, T, DIFF_HEADS, DIFF_DV)
        if past_k is None:
            o_diff = diff_prompt(qd, kd, vd, lam, rel_bias)
        else:
            P = past_k.shape[2]
            k_all = jnp.concatenate([past_k[l].reshape(B, P, DIFF_HEADS, 2, DIFF_HEAD_DIM), kd], axis=1)
            v_all = jnp.concatenate([past_v[l], vd], axis=1)
            qpos = P + jnp.arange(T, dtype=jnp.int32)
            kpos = jnp.arange(P + T, dtype=jnp.int32)
            o_diff = diff_attend(qd, k_all, v_all, qpos, kpos, lam, rel_bias)
        o_diff = rmsnorm(o_diff, diff_norm_g[l]).reshape(B, T, DIFF_WIDTH) * (1.0 - lam_init)
        x = x + jnp.concatenate([o_gla, o_diff], axis=-1).astype(x.dtype) @ w_out[l]
        hn = rmsnorm(x, norm_ffn_g[l])
        gate, up = jnp.split(hn @ w_ffn_in[l], 2, axis=-1)
        x = x + (jax.nn.silu(gate) * up) @ w_ffn_out[l]
        new_k.append(dk.reshape(B, T, DIFF_HEADS, DIFF_KDIM))
        new_v.append(vd)
        new_s.append(s_fin)
    y = rmsnorm(x, final_norm_g)
    return y, jnp.stack(new_k), jnp.stack(new_v), jnp.stack(new_s)


def setup_inputs(seed: int = 0) -> dict:
    key = jax.random.key(seed)
    ks = jax.random.split(key, 18)
    f32 = jnp.float32

    def nrm(k, shape, scale):
        return jax.random.normal(k, shape, f32) * scale

    return {
        'x_prompt': nrm(ks[0], (BATCH, SEQ, D_MODEL), 1.0),
        'x_sample': nrm(ks[1], (DEC_BATCH, DEC_SEQ, D_MODEL), 1.0),
        'cache_diff_k': nrm(ks[2], (DEPTH, DEC_BATCH, PAST_LEN, DIFF_HEADS, DIFF_KDIM), 1.0),
        'cache_diff_v': nrm(ks[3], (DEPTH, DEC_BATCH, PAST_LEN, DIFF_HEADS, DIFF_DV), 1.0),
        'state_gla': nrm(ks[4], (DEPTH, DEC_BATCH, GLA_HEADS, GLA_DK, GLA_DV), 0.5),
        'w_in': nrm(ks[5], (DEPTH, D_MODEL, D_IN), D_MODEL ** -0.5),
        'gla_w_alpha2': nrm(ks[6], (DEPTH, GLA_GATE_RANK, GLA_HEADS * GLA_DK), GLA_GATE_RANK ** -0.5),
        'gla_b_alpha': nrm(ks[7], (DEPTH, GLA_HEADS * GLA_DK), 0.1),
        'gla_norm_g': 1.0 + nrm(ks[8], (DEPTH, GLA_DV), 0.02),
        'diff_lambda': nrm(ks[9], (DEPTH, 4, DIFF_HEAD_DIM), 0.1),
        'diff_norm_g': 1.0 + nrm(ks[10], (DEPTH, DIFF_DV), 0.02),
        'w_out': nrm(ks[11], (DEPTH, MIX_WIDTH, D_MODEL), MIX_WIDTH ** -0.5),
        'norm_mix_g': 1.0 + nrm(ks[12], (DEPTH, D_MODEL), 0.02),
        'norm_ffn_g': 1.0 + nrm(ks[13], (DEPTH, D_MODEL), 0.02),
        'w_ffn_in': nrm(ks[14], (DEPTH, D_MODEL, 2 * D_FF), D_MODEL ** -0.5),
        'w_ffn_out': nrm(ks[15], (DEPTH, D_FF, D_MODEL), D_FF ** -0.5),
        'final_norm_g': 1.0 + nrm(ks[16], (D_MODEL,), 0.02),
        'rel_bias': nrm(ks[17], (T5_BUCKETS, DIFF_HEADS), 0.5),
    }


def reference(x_prompt, x_sample, cache_diff_k, cache_diff_v, state_gla, w_in, gla_w_alpha2,
              gla_b_alpha, gla_norm_g, diff_lambda, diff_norm_g, w_out, norm_mix_g, norm_ffn_g,
              w_ffn_in, w_ffn_out, final_norm_g, rel_bias):
    y_prompt, new_k_prompt, new_v_prompt, new_gla_prompt = run_trunk(
        x_prompt, None, None, None, w_in, gla_w_alpha2, gla_b_alpha, gla_norm_g, diff_lambda,
        diff_norm_g, w_out, norm_mix_g, norm_ffn_g, w_ffn_in, w_ffn_out, final_norm_g, rel_bias)
    y_sample, new_k_sample, new_v_sample, new_gla_sample = run_trunk(
        x_sample, cache_diff_k, cache_diff_v, state_gla, w_in, gla_w_alpha2, gla_b_alpha, gla_norm_g,
        diff_lambda, diff_norm_g, w_out, norm_mix_g, norm_ffn_g, w_ffn_in, w_ffn_out, final_norm_g, rel_bias)
    return (y_prompt, y_sample, new_k_prompt, new_v_prompt, new_gla_prompt,
            new_k_sample, new_v_sample, new_gla_sample)
```

```cpp
#include <hip/hip_runtime.h>
#include <cstdio>
#include <cstdint>
namespace pg8 {
#define PG8_LAS __attribute__((address_space(3)))
typedef unsigned short bf16_t;
typedef short bf16x8 __attribute__((ext_vector_type(8)));
typedef float f32x4 __attribute__((ext_vector_type(4)));
typedef unsigned u32x4 __attribute__((ext_vector_type(4)));
constexpr int BM = 256, BK = 64, HALF = 128, HTB = HALF * BK * 2  , STAGE_BYTES = 8 * HTB, NXCD = 8, WGM = 8;

__host__ __device__ __forceinline__ int lds_byte(int r, int c) { const int st = (r >> 4) * 2 + (c >> 5), rr = r & 15, cc = c & 31, ob = rr * 64 + cc * 2; return st * 1024 + (ob ^ (((ob >> 9) & 1) << 5)); }
__host__ __device__ __forceinline__ void stage_rc(int b, int& R, int& C) { const int st = b / 1024, sb = b % 1024, swz = sb ^ (((sb >> 9) & 1) << 5); R = (st >> 1) * 16 + swz / 64; C = (st & 1) * 32 + (swz % 64) / 2; }
__host__ __device__ __forceinline__ int perm32(int rho) { const int n = rho >> 4, i = rho & 15; return 8 * (i >> 2) + 4 * n + (i & 3); }

struct Unit { int pm, pn; };
struct Gemm { const bf16_t* A; const bf16_t* Bt; int M, N, K; };

struct StaticOrder {
    int nM, nN, nwg, G, c;
    __host__ __device__ void init(int M, int N, int G_, int c_) { nM = M / BM; nN = N / BM; nwg = nM * nN; G = G_; c = c_; }
    __host__ __device__ bool next(int i, Unit& u) const {
        const long L = (long)i * G + c; if (L >= nwg) return false;
        int wgid = (int)L; { const int q = nwg / NXCD, r = nwg % NXCD, xcd = wgid % NXCD, off = wgid / NXCD; wgid = (xcd < r ? xcd * (q + 1) : r * (q + 1) + (xcd - r) * q) + off; }
        const int nig = WGM * nN, gid = wgid / nig, fm = gid * WGM, gsz = (nM - fm) < WGM ? (nM - fm) : WGM;
        u.pm = fm + ((wgid % nig) % gsz); u.pn = (wgid % nig) / gsz; return true;
    }
    __device__ __forceinline__ void a_ready(const Unit&) const {}
    __device__ __forceinline__ void done(const Unit&) const {}
};

__device__ __forceinline__ unsigned cvt_pk_bf16(float lo, float hi) { unsigned r; asm volatile("v_cvt_pk_bf16_f32 %0, %1, %2" : "=v"(r) : "v"(lo), "v"(hi)); return r; }
__device__ __forceinline__ float silu_f(float v) { return v * __builtin_amdgcn_rcpf(1.f + __expf(-v)); }
__device__ __forceinline__ float logsig_f(float z) { return fminf(z, 0.f) - log1pf(__expf(-fabsf(z))); }

constexpr int IN_N = 3328;
constexpr int PROMPT_ROWS = 16384;

struct EpiIn {
    static constexpr bool PERM = true, AFTER_DRAIN = false;
    unsigned char* ws; float* out; int layer;
    size_t act_off, loga_off;
    __device__ __forceinline__ void operator()(const f32x4 (&acc)[2][2][4][2], const Unit& u, int wr, int wc, int fr, int fq) const {
        const int row0 = u.pm * BM + wr * 64 + fr; const int pn = u.pn; const int cl0 = wc * 32 + 8 * fq;
        float* fo = nullptr; int fld = 512;
        if (pn == 2) { fo = (float*)(ws + loga_off) + (size_t)row0 * 256 + cl0; fld = 256; }
        else if (pn >= 9) { const bool samp = (u.pm >= PROMPT_ROWS / BM); const bool isv = (pn >= 11);
            const size_t b = samp ? (isv ? (size_t)87162880 : (size_t)85065728) + (size_t)layer * 524288 : (isv ? (size_t)51380224 : (size_t)17825792) + (size_t)layer * 8388608;
            fo = out + b + (size_t)(row0 - (samp ? PROMPT_ROWS : 0)) * 512 + ((pn - 9) & 1) * 256 + cl0; }
        bf16_t* ab = (bf16_t*)(ws + act_off) + (size_t)row0 * IN_N + pn * BM + cl0;
#pragma unroll
        for (int ai = 0; ai < 2; ++ai)
#pragma unroll
            for (int m = 0; m < 4; ++m) { const size_t ro = (size_t)(ai * HALF + m * 16);
#pragma unroll
                for (int bj = 0; bj < 2; ++bj) { f32x4 v0 = acc[ai][bj][m][0], v1 = acc[ai][bj][m][1];
                    u32x4 w; w.x = cvt_pk_bf16(v0[0], v0[1]); w.y = cvt_pk_bf16(v0[2], v0[3]); w.z = cvt_pk_bf16(v1[0], v1[1]); w.w = cvt_pk_bf16(v1[2], v1[3]);
                    *(u32x4*)(ab + ro * IN_N + bj * HALF) = w;
                    if (fo) { *(f32x4*)(fo + ro * fld + bj * HALF) = v0; *(f32x4*)(fo + ro * fld + bj * HALF + 4) = v1; } } }
    }
};

struct EpiSwi {
    static constexpr bool PERM = true, AFTER_DRAIN = false;
    bf16_t* H; int ldh;
    __device__ __forceinline__ void operator()(const f32x4 (&acc)[2][2][4][2], const Unit& u, int wr, int wc, int fr, int fq) const {
        const int row0 = u.pm * BM + wr * 64 + fr; bf16_t* hb = H + (size_t)row0 * ldh + u.pn * HALF + wc * 32 + 8 * fq;
#pragma unroll
        for (int ai = 0; ai < 2; ++ai)
#pragma unroll
            for (int m = 0; m < 4; ++m) { const f32x4 g0 = acc[ai][0][m][0], g1 = acc[ai][0][m][1], u0 = acc[ai][1][m][0], u1 = acc[ai][1][m][1];
                u32x4 w; w.x = cvt_pk_bf16(silu_f(g0[0]) * u0[0], silu_f(g0[1]) * u0[1]); w.y = cvt_pk_bf16(silu_f(g0[2]) * u0[2], silu_f(g0[3]) * u0[3]);
                w.z = cvt_pk_bf16(silu_f(g1[0]) * u1[0], silu_f(g1[1]) * u1[1]); w.w = cvt_pk_bf16(silu_f(g1[2]) * u1[2], silu_f(g1[3]) * u1[3]);
                *(u32x4*)(hb + (size_t)(ai * HALF + m * 16) * ldh) = w; }
    }
};

struct EpiRes {
    static constexpr bool PERM = true, AFTER_DRAIN = false;
    const float* srcp; const float* srcs; float* dst;
    __device__ __forceinline__ void operator()(const f32x4 (&acc)[2][2][4][2], const Unit& u, int wr, int wc, int fr, int fq) const {
        const int row0 = u.pm * BM + wr * 64 + fr; const int c0 = u.pn * BM + wc * 32 + 8 * fq;
        const bool samp = (u.pm >= PROMPT_ROWS / BM);
        const float* sb = (samp ? srcs + (size_t)(row0 - PROMPT_ROWS) * 1024 : srcp + (size_t)row0 * 1024) + c0;
        float* db = dst + (size_t)row0 * 1024 + c0;
#pragma unroll
        for (int ai = 0; ai < 2; ++ai)
#pragma unroll
            for (int m = 0; m < 4; ++m) { const size_t ro = (size_t)(ai * HALF + m * 16) * 1024;
#pragma unroll
                for (int bj = 0; bj < 2; ++bj) { const f32x4 s0 = *(const f32x4*)(sb + ro + bj * HALF), s1 = *(const f32x4*)(sb + ro + bj * HALF + 4);
                    *(f32x4*)(db + ro + bj * HALF) = s0 + acc[ai][bj][m][0]; *(f32x4*)(db + ro + bj * HALF + 4) = s1 + acc[ai][bj][m][1]; }
                asm volatile("" ::: "memory"); }
    }
};
template <class Epi, class Sched, bool ALIGN_EPI = false, bool SP2 = false>
__device__ __forceinline__ void gemm_phase(PG8_LAS unsigned char* lds, const Gemm g, const Sched& S, const Epi& E) {
    int tid_ = threadIdx.x; asm volatile("" : "+v"(tid_));
    const int tid = tid_, wid = __builtin_amdgcn_readfirstlane(tid >> 6), lane = tid & 63, wr = wid >> 2, wc = wid & 3, fr = lane & 15, fq = lane >> 4;
    const int K = g.K, nt = K / BK;
    unsigned voffA[2], voffB[2];
#pragma unroll
    for (int i = 0; i < 2; ++i) { int R, C; stage_rc(tid * 16 + i * 8192, R, C); const int Rb = Epi::PERM ? ((R & ~31) + perm32(R & 31)) : R;
        voffA[i] = (unsigned)(R * K + C) * 2u; voffB[i] = (unsigned)(Rb * K + C) * 2u; }
    const size_t kstep = (size_t)(BK * 2);
    const size_t hstep = (size_t)HALF * K * 2;
    const size_t tstep = 2 * hstep;
    const unsigned ldsw = (unsigned)wid * 1024u;
    const int aoff = lds_byte(wr * 64 + fr, fq * 8), boff = lds_byte(wc * 32 + fr, fq * 8);
#define PG8_SA(b, h) (((b) * 2 + (h)) * HTB)
#define PG8_SB(b, h) ((4 + (b) * 2 + (h)) * HTB)
#define PG8_STAGE(bufoff, gbase, voff) do { _Pragma("unroll") for (int _i = 0; _i < 2; ++_i) \
        __builtin_amdgcn_global_load_lds((const unsigned*)((const char*)(gbase) + (voff)[_i]), (PG8_LAS unsigned*)(lds + (bufoff) + ldsw + _i * 8192), 16, 0, 0); } while (0)
#define PG8_LDA(dst, b, h) do { _Pragma("unroll") for (int m = 0; m < 4; ++m) _Pragma("unroll") for (int k = 0; k < 2; ++k) dst[m][k] = *(const PG8_LAS bf16x8*)(lds + PG8_SA(b, h) + aoff + m * 2048 + k * 1024); } while (0)
#define PG8_LDB(dst, b, h) do { _Pragma("unroll") for (int n = 0; n < 2; ++n) _Pragma("unroll") for (int k = 0; k < 2; ++k) dst[n][k] = *(const PG8_LAS bf16x8*)(lds + PG8_SB(b, h) + boff + n * 2048 + k * 1024); } while (0)
#define PG8_MMA(ai, bj, At, Bt) do { __builtin_amdgcn_s_setprio(1); _Pragma("unroll") for (int m = 0; m < 4; ++m) _Pragma("unroll") for (int n = 0; n < 2; ++n) _Pragma("unroll") for (int k = 0; k < 2; ++k) \
        acc[ai][bj][m][n] = __builtin_amdgcn_mfma_f32_16x16x32_bf16(Bt[n][k], At[m][k], acc[ai][bj][m][n], 0, 0, 0); __builtin_amdgcn_s_setprio(0); } while (0)
#define PG8_WAIT_V(n) asm volatile("s_waitcnt vmcnt(" #n ")" ::: "memory")
#define PG8_WAIT_L(n) asm volatile("s_waitcnt lgkmcnt(" #n ")" ::: "memory")
#define PG8_BAR __builtin_amdgcn_s_barrier()
#define PG8_SCHED __builtin_amdgcn_sched_barrier(0)
    Unit cur, nxt; int ui = 0;
    if (!S.next(0, cur)) return;
    f32x4 acc[2][2][4][2];
#pragma unroll
    for (int a = 0; a < 2; ++a)
#pragma unroll
        for (int b = 0; b < 2; ++b)
#pragma unroll
            for (int m = 0; m < 4; ++m)
#pragma unroll
                for (int n = 0; n < 2; ++n) acc[a][b][m][n] = (f32x4){0.f, 0.f, 0.f, 0.f};
    bf16x8 At[4][2], B0[2][2], B1[2][2];
    const char* cA = (const char*)g.A + (size_t)cur.pm * tstep; const char* cB = (const char*)g.Bt + (size_t)cur.pn * tstep;
    S.a_ready(cur);
    if constexpr (SP2) {
        PG8_STAGE(PG8_SB(0, 0), cB, voffB); PG8_STAGE(PG8_SB(0, 1), cB + hstep, voffB); PG8_STAGE(PG8_SA(0, 0), cA, voffA); PG8_STAGE(PG8_SA(0, 1), cA + hstep, voffA);
        if (wr == 1) PG8_BAR;
        PG8_WAIT_V(2); PG8_BAR;
        PG8_STAGE(PG8_SB(1, 0), cB + kstep, voffB); PG8_STAGE(PG8_SA(1, 0), cA + kstep, voffA); PG8_STAGE(PG8_SB(1, 1), cB + hstep + kstep, voffB);
        PG8_WAIT_V(6); PG8_BAR;
    } else {
        PG8_STAGE(PG8_SB(0, 0), cB, voffB); PG8_STAGE(PG8_SA(0, 0), cA, voffA); PG8_STAGE(PG8_SB(0, 1), cB + hstep, voffB); PG8_STAGE(PG8_SA(0, 1), cA + hstep, voffA);
        if (wr == 1) PG8_BAR;
        PG8_WAIT_V(4); PG8_BAR;
        PG8_STAGE(PG8_SB(1, 0), cB + kstep, voffB); PG8_STAGE(PG8_SA(1, 0), cA + kstep, voffA); PG8_STAGE(PG8_SB(1, 1), cB + hstep + kstep, voffB);
        PG8_WAIT_V(6); PG8_BAR;
    }
    for (;;) {
        const bool has_next = S.next(ui + 1, nxt);
        const char* nA = has_next ? (const char*)g.A + (size_t)nxt.pm * tstep : cA; const char* nB = has_next ? (const char*)g.Bt + (size_t)nxt.pn * tstep : cB;
        for (int t = 0; t < nt; t += 2) {
            const bool last = (t == nt - 2);
            const char* a1 = cA + (size_t)(t + 1) * kstep;
            const char* a2 = last ? nA : cA + (size_t)(t + 2) * kstep; const char* b2 = last ? nB : cB + (size_t)(t + 2) * kstep;
            const char* a3 = a2 + kstep; const char* b3 = b2 + kstep;
            if (last && has_next) S.a_ready(nxt);
            if constexpr (SP2) {
            PG8_LDB(B0, 0, 0); PG8_LDB(B1, 0, 1); PG8_SCHED; PG8_LDA(At, 0, 0); PG8_STAGE(PG8_SA(1, 1), a1 + hstep, voffA);
            PG8_WAIT_V(8); PG8_WAIT_L(0); PG8_BAR; PG8_MMA(0, 0, At, B0); PG8_MMA(0, 1, At, B1); PG8_BAR; PG8_SCHED;
            PG8_LDA(At, 0, 1); PG8_STAGE(PG8_SB(0, 0), b2, voffB); PG8_STAGE(PG8_SB(0, 1), b2 + hstep, voffB); PG8_STAGE(PG8_SA(0, 0), a2, voffA);
            PG8_WAIT_V(8); PG8_WAIT_L(0); PG8_BAR; PG8_MMA(1, 0, At, B0); PG8_MMA(1, 1, At, B1); PG8_BAR; PG8_SCHED;
            PG8_LDB(B0, 1, 0); PG8_LDB(B1, 1, 1); PG8_SCHED; PG8_LDA(At, 1, 0); PG8_STAGE(PG8_SA(0, 1), a2 + hstep, voffA);
            PG8_WAIT_V(8); PG8_WAIT_L(0); PG8_BAR; PG8_MMA(0, 0, At, B0); PG8_MMA(0, 1, At, B1); PG8_BAR; PG8_SCHED;
            PG8_LDA(At, 1, 1); PG8_STAGE(PG8_SB(1, 0), b3, voffB); PG8_STAGE(PG8_SB(1, 1), b3 + hstep, voffB); PG8_STAGE(PG8_SA(1, 0), a3, voffA);
            PG8_WAIT_V(8); PG8_WAIT_L(0); PG8_BAR; PG8_MMA(1, 0, At, B0); PG8_MMA(1, 1, At, B1); PG8_BAR; PG8_SCHED;
            } else {
            PG8_LDB(B0, 0, 0); PG8_SCHED; PG8_LDA(At, 0, 0); PG8_STAGE(PG8_SA(1, 1), a1 + hstep, voffA);
            PG8_WAIT_L(8); PG8_BAR; PG8_WAIT_L(0); PG8_MMA(0, 0, At, B0); PG8_BAR; PG8_SCHED;
            PG8_LDB(B1, 0, 1); PG8_STAGE(PG8_SB(0, 0), b2, voffB);
            PG8_BAR; PG8_WAIT_L(0); PG8_MMA(0, 1, At, B1); PG8_BAR;
            PG8_LDA(At, 0, 1); PG8_STAGE(PG8_SA(0, 0), a2, voffA);
            PG8_BAR; PG8_WAIT_L(0); PG8_MMA(1, 0, At, B0); PG8_BAR; PG8_SCHED;
            PG8_STAGE(PG8_SB(0, 1), b2 + hstep, voffB);
            PG8_WAIT_V(6); PG8_BAR; PG8_MMA(1, 1, At, B1); PG8_BAR;
            PG8_LDB(B0, 1, 0); PG8_SCHED; PG8_LDA(At, 1, 0); PG8_STAGE(PG8_SA(0, 1), a2 + hstep, voffA);
            PG8_WAIT_L(8); PG8_BAR; PG8_WAIT_L(0); PG8_MMA(0, 0, At, B0); PG8_BAR; PG8_SCHED;
            PG8_LDB(B1, 1, 1); PG8_STAGE(PG8_SB(1, 0), b3, voffB);
            PG8_BAR; PG8_WAIT_L(0); PG8_MMA(0, 1, At, B1); PG8_BAR;
            PG8_LDA(At, 1, 1); PG8_STAGE(PG8_SA(1, 0), a3, voffA);
            PG8_BAR; PG8_WAIT_L(0); PG8_MMA(1, 0, At, B0); PG8_BAR; PG8_SCHED;
            PG8_STAGE(PG8_SB(1, 1), b3 + hstep, voffB);
            PG8_WAIT_V(6); PG8_BAR; PG8_MMA(1, 1, At, B1); PG8_BAR;
            }
        }
        if constexpr (ALIGN_EPI) { if (wr == 0) PG8_BAR; }
        if constexpr (!Epi::AFTER_DRAIN) { E(acc, cur, wr, wc, fr, fq); S.done(cur); }
        if (!has_next) break;
#pragma unroll
        for (int a = 0; a < 2; ++a)
#pragma unroll
            for (int b = 0; b < 2; ++b)
#pragma unroll
                for (int m = 0; m < 4; ++m)
#pragma unroll
                    for (int n = 0; n < 2; ++n) acc[a][b][m][n] = (f32x4){0.f, 0.f, 0.f, 0.f};
        cur = nxt; cA = nA; cB = nB; ++ui;
        if constexpr (ALIGN_EPI) { if (wr == 1) PG8_BAR; }
    }
    PG8_WAIT_V(0);
    if constexpr (!ALIGN_EPI) { if (wr == 0) PG8_BAR; }
    PG8_BAR;
    if constexpr (Epi::AFTER_DRAIN) { E.fused(acc, cur, wr, wc, fr, fq, lds, wid, lane); S.done(cur); }
#undef PG8_SA
#undef PG8_SB
#undef PG8_STAGE
#undef PG8_LDA
#undef PG8_LDB
#undef PG8_MMA
#undef PG8_WAIT_V
#undef PG8_WAIT_L
#undef PG8_BAR
#undef PG8_SCHED
}
}
constexpr int NWAVES = 8;
constexpr int DM = 1024, SEQ = 16384, DEPTH = 4, DECB = 16, DECS = 64, PAST = 4096;
constexpr int M = SEQ + DECB * DECS;
constexpr int NIN = pg8::IN_N;
constexpr int DFF = 2816, NF1 = 2 * DFF;
constexpr int WIN_ORIG = 3088;
constexpr int NCHUNK = M / 64;
constexpr int NPCH = SEQ / 64;
constexpr float RMS_EPS = 1e-6f;
constexpr size_t OY = 0, OK_P = 17825792, OV_P = 51380224, OG_P = 84934656, OK_S = 85065728, OV_S = 87162880, OG_S = 89260032, OUT_TOTAL = 91357184;

constexpr size_t MiB = 1u << 20;
constexpr size_t WS_CTL = 0, CTL_ZERO_BYTES = 1 * MiB;
constexpr size_t WS_W = 2 * MiB, W_LAYER = 25 * MiB;
constexpr size_t WO_IN = 0, WO_OUT = 6815744, WO_F1 = WO_OUT + 2 * MiB, WO_F2 = WO_F1 + 11 * MiB;
static_assert(WO_F2 + (size_t)DM * DFF * 2 == W_LAYER, "weight map");
constexpr size_t WS_X = 104 * MiB;
constexpr size_t WS_XN = 172 * MiB;
constexpr size_t WS_ACT = 206 * MiB;
constexpr size_t WS_MIX = 317 * MiB;
constexpr size_t WS_H = 351 * MiB;
constexpr size_t WS_LOGA = 445 * MiB;
constexpr size_t WS_U = 462 * MiB;
constexpr size_t WS_D = 496 * MiB;
constexpr size_t WS_SC = 497 * MiB;
constexpr size_t WS_OI = 529 * MiB;
constexpr size_t WS_QT = 563 * MiB;
constexpr size_t WS_END = 576 * MiB;
static_assert(WS_X + (size_t)M * DM * 4 <= WS_XN && WS_XN + (size_t)M * DM * 2 <= WS_ACT && WS_ACT + (size_t)M * NIN * 2 <= WS_MIX && WS_MIX + (size_t)M * DM * 2 <= WS_H &&
              WS_H + (size_t)M * DFF * 2 <= WS_LOGA && WS_LOGA + (size_t)M * 256 * 4 <= WS_U && WS_U + (size_t)NCHUNK * 4 * 64 * 128 * 4 <= WS_D && WS_D + (size_t)NCHUNK * 4 * 64 * 4 <= WS_SC &&
              WS_SC + (size_t)NPCH * 4 * 64 * 128 * 4 <= WS_OI && WS_OI + (size_t)M * 512 * 4 <= WS_QT && WS_QT + (size_t)M * 256 * 2 <= WS_END, "d_ws map");
constexpr int CW_TMO = 0, CW_CODE = 1;
constexpr int CW_BAR = 4096;
constexpr int CW_QUEUE = 16384;

constexpr int RING_OFF = 0, RING_BYTES = 131072;
constexpr int LDSCTL_OFF = RING_BYTES, MISC_OFF = LDSCTL_OFF + 320;
constexpr int LDS_BYTES = 147456;

#define GAS __attribute__((address_space(1)))
#define LAS __attribute__((address_space(3)))
typedef unsigned short bf16;
typedef unsigned v4u __attribute__((ext_vector_type(4)));
typedef unsigned v2u __attribute__((ext_vector_type(2)));
typedef float f32x4 __attribute__((ext_vector_type(4)));
typedef float f32x16 __attribute__((ext_vector_type(16)));
typedef short bf16x8 __attribute__((ext_vector_type(8)));
typedef short s16x4 __attribute__((ext_vector_type(4)));
typedef GAS unsigned gu32;
#define RLX_AGENT __ATOMIC_RELAXED, __HIP_MEMORY_SCOPE_AGENT
#define LDS_WAIT() asm volatile("s_waitcnt lgkmcnt(0)" ::: "memory")
#define VM_WAIT() asm volatile("s_waitcnt vmcnt(0)" ::: "memory")
__device__ __forceinline__ unsigned f2bf(float f) { unsigned u = __builtin_bit_cast(unsigned, f); return (u + 0x7fffu + ((u >> 16) & 1u)) >> 16; }
__device__ __forceinline__ unsigned pk2(float lo, float hi) { return f2bf(lo) | (f2bf(hi) << 16); }
__device__ __forceinline__ float bf2f(unsigned short b) { return __builtin_bit_cast(float, (unsigned)b << 16); }
__device__ __forceinline__ float wave_sum(float v) {
#pragma unroll
    for (int o = 1; o < 64; o <<= 1) v += __shfl_xor(v, o);
    return v;
}
#define XB_TMO      128
#define XB_XCNT(j)  (256  + 64 * (j))
#define XB_XSUB(j)  (1280 + 64 * (j))
#define XB_XGEN(j)  (2304 + 64 * (j))
#define XB_TOP      3328
#define XB_TOPGEN   3392
#define XCD_BAR_WORDS 3456
#define XB_SPIN_CAP (1u << 18)

__device__ __forceinline__ unsigned xb_ld(unsigned* p)              { return __hip_atomic_load(p, __ATOMIC_RELAXED, __HIP_MEMORY_SCOPE_AGENT); }
__device__ __forceinline__ unsigned xb_add(unsigned* p, unsigned v) { return __hip_atomic_fetch_add(p, v, __ATOMIC_RELAXED, __HIP_MEMORY_SCOPE_AGENT); }
__device__ __forceinline__ unsigned xb_xcc_id() { return (unsigned)__builtin_amdgcn_s_getreg((3 << 11) | 20) & 0xFu; }
#define XB_SPIN(cond, bar) do { unsigned _sp = 0; while (cond) { __builtin_amdgcn_s_sleep(1); \
    if ((++_sp & 255u) == 0u) { if (xb_ld(&(bar)[XB_TMO])) break; if (_sp > XB_SPIN_CAP) { atomicAdd(&(bar)[XB_TMO], 1u); break; } } } } while (0)

struct XcdBarrier {
    unsigned* bar; unsigned x;
    volatile LAS unsigned* st;
};

__device__ __forceinline__ XcdBarrier xcd_barrier_post(unsigned* bar, volatile LAS unsigned* st) {
    XcdBarrier b; b.bar = bar; b.x = xb_xcc_id(); b.st = st;
    if (threadIdx.x == 0) (void)xb_add(&bar[XB_XCNT(b.x)], 1u);
    return b;
}
__device__ __forceinline__ void xcd_barrier_complete(unsigned* bar, unsigned x, unsigned& nloc, unsigned& nx) {
    const unsigned G = gridDim.x * gridDim.y * gridDim.z;
    unsigned sum, cnt, mine, sp = 0u;
    for (;;) {
        sum = 0u; cnt = 0u; mine = 0u;
#pragma unroll
        for (unsigned j = 0; j < 16; ++j) { const unsigned c = xb_ld(&bar[XB_XCNT(j)]); sum += c; cnt += (c > 0u) ? 1u : 0u; mine = (j == x) ? c : mine; }
        if (sum == G) break;
        __builtin_amdgcn_s_sleep(1);
        if ((++sp & 255u) == 0u) { if (xb_ld(&bar[XB_TMO])) break; if (sp > XB_SPIN_CAP) { atomicAdd(&bar[XB_TMO], 1u); break; } }
    }
    nloc = mine > 0u ? mine : 1u; nx = cnt > 0u ? cnt : 1u;
}

__device__ __forceinline__ void xcd_barrier(const XcdBarrier& b) {
    asm volatile("s_waitcnt vmcnt(0)" ::: "memory");
    __syncthreads();
    if (threadIdx.x == 0) {
        unsigned* bar = b.bar;
        __builtin_amdgcn_s_waitcnt(0);
        unsigned nloc = b.st[0], nx = b.st[1];
        if (nloc == 0u) { xcd_barrier_complete(bar, b.x, nloc, nx); b.st[0] = nloc; b.st[1] = nx; }
        const unsigned old = xb_add(&bar[XB_XSUB(b.x)], 1u);
        const unsigned gen = old / nloc;
        if (old + 1u == (gen + 1u) * nloc) {
            __builtin_amdgcn_fence(__ATOMIC_RELEASE, "agent");
            asm volatile("s_waitcnt vmcnt(0)" ::: "memory");
            const unsigned og = xb_add(&bar[XB_TOP], 1u);
            const unsigned tg = og / nx;
            if (og + 1u == (tg + 1u) * nx) xb_add(&bar[XB_TOPGEN], 1u);
            else XB_SPIN(xb_ld(&bar[XB_TOPGEN]) == tg, bar);
            __builtin_amdgcn_fence(__ATOMIC_ACQUIRE, "agent");
            xb_add(&bar[XB_XGEN(b.x)], 1u);
            asm volatile("s_waitcnt vmcnt(0)" ::: "memory");
        } else {
            XB_SPIN(xb_ld(&bar[XB_XGEN(b.x)]) == gen, bar);
            __builtin_amdgcn_fence(__ATOMIC_ACQUIRE, "agent");
            asm volatile("s_waitcnt vmcnt(0)" ::: "memory");
        }
    }
    __syncthreads();
}
struct Frame {
    LAS unsigned char* lds;
};
__device__ __forceinline__ int grid_n() { return (int)gridDim.x; }
__device__ __forceinline__ int vcu_id() { const int G = (int)gridDim.x, bx = (int)blockIdx.x; return (G % 8 == 0) ? (bx % 8) * (G / 8) + bx / 8 : bx; }
__device__ __forceinline__ int fresh_tid() { int t = threadIdx.x; asm volatile("" : "+v"(t)); return t; }

__device__ __forceinline__ void tr_store(LAS float* scr, bf16* WT, int K, int dstrow0, int k0, int lane) {
    LDS_WAIT(); asm volatile("" ::: "memory");
    const int c = lane & 7;
#pragma unroll
    for (int j = 0; j < 4; ++j) { const int n = (lane >> 3) + 8 * j; const LAS float* s = scr + (8 * c) * 33 + n;
        v4u o; o.x = pk2(s[0 * 33], s[1 * 33]); o.y = pk2(s[2 * 33], s[3 * 33]); o.z = pk2(s[4 * 33], s[5 * 33]); o.w = pk2(s[6 * 33], s[7 * 33]);
        *(GAS v4u*)(WT + (size_t)(dstrow0 + n) * K + k0 + 8 * c) = o; }
    LDS_WAIT(); asm volatile("" ::: "memory");
}
__device__ __forceinline__ void tr_item(const float* W, int ld, int K, int srccol0, bf16* WT, int dstrow0, int k0, LAS float* scr, int lane) {
#pragma unroll 8
    for (int i = 0; i < 32; ++i) { const int kk = 2 * i + (lane >> 5); scr[kk * 33 + (lane & 31)] = W[(size_t)(k0 + kk) * ld + srccol0 + (lane & 31)]; }
    tr_store(scr, WT, K, dstrow0, k0, lane);
}
__device__ __forceinline__ void tr_item_z(const float* Win, const float* a2, int n0z, bf16* WT, int k0, LAS float* scr, int lane) {
    float av[16];
#pragma unroll
    for (int r = 0; r < 16; ++r) av[r] = a2[r * 256 + n0z + (lane & 31)];
    for (int i = 0; i < 32; ++i) { const int kk = 2 * i + (lane >> 5); const float* wr_ = Win + (size_t)(k0 + kk) * WIN_ORIG + 1536; float s = 0.f;
#pragma unroll
        for (int r = 0; r < 16; ++r) s = fmaf(wr_[r], av[r], s);
        scr[kk * 33 + (lane & 31)] = s; }
    tr_store(scr, WT, DM, 512 + n0z, k0, lane);
}

struct Args { const float* in[18]; float* out; unsigned char* ws; };
constexpr int PTAB_OFF = MISC_OFF + 128;
__device__ __forceinline__ const float* inp(const Frame& F, int i) {
    const volatile LAS unsigned* t = (const volatile LAS unsigned*)(F.lds + PTAB_OFF) + 2 * i;
    const unsigned lo = __builtin_amdgcn_readfirstlane(t[0]), hi = __builtin_amdgcn_readfirstlane(t[1]);
    return (const float*)(((unsigned long long)hi << 32) | lo);
}
__device__ __forceinline__ float* outp(const Frame& F) { return (float*)inp(F, 18); }
__device__ __forceinline__ unsigned char* wsp(const Frame& F) { return (unsigned char*)inp(F, 19); }

__device__ __forceinline__ void p0_prologue(Frame& F) {
    const int tid_ = fresh_tid(), lane_ = tid_ & 63, wave_ = __builtin_amdgcn_readfirstlane(tid_ >> 6);
    LAS float* scr = (LAS float*)(F.lds + RING_OFF + wave_ * 16384);
    const int gw = vcu_id() * NWAVES + wave_, NGW = grid_n() * NWAVES;
    constexpr int I_IN = 16 * 104, I_OUT = 16 * 32, I_F1 = 16 * 176, I_F2 = 44 * 32, I_L = I_IN + I_OUT + I_F1 + I_F2;
    for (int it = gw; it < DEPTH * I_L; it += NGW) {
        const int l = it / I_L; int r = it % I_L;
        unsigned char* wl = wsp(F) + WS_W + (size_t)l * W_LAYER;
        if (r < I_IN) { const int kb = r / 104, nb = r % 104, n0 = 32 * nb; const float* W = inp(F, 5) + (size_t)l * DM * WIN_ORIG;
            if (n0 >= 512 && n0 < 768) tr_item_z(W, inp(F, 6) + (size_t)l * 16 * 256, n0 - 512, (bf16*)(wl + WO_IN), 64 * kb, scr, lane_);
            else { const int src = n0 < 512 ? n0 : (n0 < 1792 ? n0 - 256 : n0 - 240); tr_item(W, WIN_ORIG, DM, src, (bf16*)(wl + WO_IN), n0, 64 * kb, scr, lane_); }
            continue; }
        r -= I_IN;
        if (r < I_OUT) { const int kb = r / 32, nb = r % 32; tr_item(inp(F, 11) + (size_t)l * DM * DM, DM, DM, 32 * nb, (bf16*)(wl + WO_OUT), 32 * nb, 64 * kb, scr, lane_); continue; }
        r -= I_OUT;
        if (r < I_F1) { const int kb = r / 176, nb = r % 176, n0 = 32 * nb, pn = n0 >> 8, j = n0 & 255; const int src = j < 128 ? 128 * pn + j : DFF + 128 * pn + (j - 128);
            tr_item(inp(F, 14) + (size_t)l * DM * NF1, NF1, DM, src, (bf16*)(wl + WO_F1), n0, 64 * kb, scr, lane_); continue; }
        r -= I_F1;
        { const int kb = r / 32, nb = r % 32; tr_item(inp(F, 15) + (size_t)l * DFF * DM, DM, DFF, 32 * nb, (bf16*)(wl + WO_F2), 32 * nb, 64 * kb, scr, lane_); }
    }
}

__device__ __forceinline__ void norm_rows_bf16(Frame& F, const float* srcp, const float* srcs, const float* g, bf16* XN) {
    const int tid_ = fresh_tid(), lane_ = tid_ & 63, wave_ = __builtin_amdgcn_readfirstlane(tid_ >> 6);
    const int gw = vcu_id() * NWAVES + wave_, NGW = grid_n() * NWAVES;
    f32x4 gv[4];
#pragma unroll
    for (int j = 0; j < 4; ++j) gv[j] = ((const GAS f32x4*)g)[lane_ + 64 * j];
    for (int m = gw; m < M; m += NGW) {
        const float* xrow = m < SEQ ? srcp + (size_t)m * DM : srcs + (size_t)(m - SEQ) * DM;
        const GAS f32x4* xr = (const GAS f32x4*)xrow + lane_;
        f32x4 v[4]; float s = 0.f;
#pragma unroll
        for (int j = 0; j < 4; ++j) { v[j] = xr[64 * j]; s += (v[j].x * v[j].x + v[j].y * v[j].y) + (v[j].z * v[j].z + v[j].w * v[j].w); }
        const float rstd = 1.f / sqrtf(wave_sum(s) * (1.f / DM) + RMS_EPS);
        GAS unsigned long long* o8 = (GAS unsigned long long*)(XN + (size_t)m * DM) + lane_;
#pragma unroll
        for (int j = 0; j < 4; ++j) { const f32x4 y = v[j] * rstd * gv[j]; o8[64 * j] = (unsigned long long)pk2(y.x, y.y) | ((unsigned long long)pk2(y.z, y.w) << 32); }
    }
}
__device__ __forceinline__ void norm_rows_f32(Frame& F, const float* src, const float* g, float* out) {
    const int tid_ = fresh_tid(), lane_ = tid_ & 63, wave_ = __builtin_amdgcn_readfirstlane(tid_ >> 6);
    const int gw = vcu_id() * NWAVES + wave_, NGW = grid_n() * NWAVES;
    f32x4 gv[4];
#pragma unroll
    for (int j = 0; j < 4; ++j) gv[j] = ((const GAS f32x4*)g)[lane_ + 64 * j];
    for (int m = gw; m < M; m += NGW) {
        const GAS f32x4* xr = (const GAS f32x4*)(src + (size_t)m * DM) + lane_;
        f32x4 v[4]; float s = 0.f;
#pragma unroll
        for (int j = 0; j < 4; ++j) { v[j] = xr[64 * j]; s += (v[j].x * v[j].x + v[j].y * v[j].y) + (v[j].z * v[j].z + v[j].w * v[j].w); }
        const float rstd = 1.f / sqrtf(wave_sum(s) * (1.f / DM) + RMS_EPS);
        GAS f32x4* o = (GAS f32x4*)(out + (size_t)m * DM) + lane_;
#pragma unroll
        for (int j = 0; j < 4; ++j) o[64 * j] = v[j] * rstd * gv[j];
    }
}

namespace att {
typedef float f32x8 __attribute__((ext_vector_type(8)));
typedef unsigned u32x4 __attribute__((ext_vector_type(4)));
constexpr float SCALE = 0.125f, THR = 8.f;
constexpr int SHM_V = 16384, SHM_K = 16384;
constexpr int OFF_V = 0, OFF_K = 2 * SHM_V, OFF_WS = 65536, OFF_TAB = OFF_WS + 2048, TAB_N = 384, OFF_LAM = OFF_TAB + 4 * TAB_N * 4, OFF_G3 = OFF_LAM + 256, OFF_QL = OFF_G3 + 1024, OFF_END = OFF_QL + 8 * 4096;
static_assert(OFF_END <= RING_BYTES, "attention LDS map");
#define KSWZ(row, colB) ((row) * 256 + ((colB) ^ (((row) & 7) << 4)))
#define SBAR() __builtin_amdgcn_sched_barrier(0)
__device__ __forceinline__ int crow(int r, int hi) { return (r & 3) + 8 * (r >> 2) + 4 * hi; }
__device__ __forceinline__ unsigned cvtpk(float lo, float hi) { unsigned r; asm volatile("v_cvt_pk_bf16_f32 %0, %1, %2" : "=v"(r) : "v"(lo), "v"(hi)); return r; }
template <bool F32> struct Stage;
template <> struct Stage<false> { using E = bf16; using T = bf16x8;
  __device__ static __forceinline__ T ld8(const E* p) { return *reinterpret_cast<const bf16x8*>(p); }
  __device__ static __forceinline__ bf16x8 tobf(T x) { return x; } };
template <> struct Stage<true> { using E = float; using T = f32x8;
  __device__ static __forceinline__ T ld8(const E* p) { return *reinterpret_cast<const f32x8*>(p); }
  __device__ static __forceinline__ bf16x8 tobf(T x) { u32x4 w = {cvtpk(x[0], x[1]), cvtpk(x[2], x[3]), cvtpk(x[4], x[5]), cvtpk(x[6], x[7])}; return __builtin_bit_cast(bf16x8, w); } };

__device__ __forceinline__ void partialSM(f32x16& p0, f32x16& p1, float& m_reg, float& mn, float& alpha) {
  constexpr float C = SCALE * 1.4426950408889634f;
  float pmax = p0[0];
#pragma unroll
  for (int r = 1; r < 16; ++r) pmax = fmaxf(pmax, p0[r]);
#pragma unroll
  for (int r = 0; r < 16; ++r) pmax = fmaxf(pmax, p1[r]);
  { auto rr = __builtin_amdgcn_permlane32_swap(__float_as_uint(pmax), __float_as_uint(pmax), false, false);
    pmax = fmaxf(__uint_as_float(rr[0]), __uint_as_float(rr[1])); }
  if (__builtin_expect(__all(pmax - m_reg <= THR / SCALE), 1)) { mn = m_reg; alpha = 1.f; }
  else { mn = fmaxf(m_reg, pmax); alpha = __builtin_amdgcn_exp2f((m_reg - mn) * C); m_reg = mn; }
  float mnC = -mn * C;
#pragma unroll
  for (int r = 0; r < 16; ++r) p0[r] = fmaf(p0[r], C, mnC);
#pragma unroll
  for (int r = 0; r < 16; ++r) p1[r] = fmaf(p1[r], C, mnC);
#pragma unroll
  for (int r = 0; r < 16; ++r) p0[r] = __builtin_amdgcn_exp2f(p0[r]);
}
__device__ __forceinline__ void finishSM(f32x16& p0, f32x16& p1, float alpha, float& l_reg, bf16x8& pa0, bf16x8& pa1, bf16x8& pa2, bf16x8& pa3) {
#pragma unroll
  for (int r = 0; r < 16; ++r) p1[r] = __builtin_amdgcn_exp2f(p1[r]);
  float ps = 0;
#pragma unroll
  for (int r = 0; r < 16; ++r) ps += p0[r];
#pragma unroll
  for (int r = 0; r < 16; ++r) ps += p1[r];
  { auto rr = __builtin_amdgcn_permlane32_swap(__float_as_uint(ps), __float_as_uint(ps), false, false);
    ps = __uint_as_float(rr[0]) + __uint_as_float(rr[1]); }
  l_reg = l_reg * alpha + ps;
#define PK4(P, BASE, OUT) do { unsigned a0 = cvtpk(P[BASE + 0], P[BASE + 1]), a1 = cvtpk(P[BASE + 2], P[BASE + 3]);   \
    unsigned b0 = cvtpk(P[BASE + 4], P[BASE + 5]), b1 = cvtpk(P[BASE + 6], P[BASE + 7]);                              \
    auto r0 = __builtin_amdgcn_permlane32_swap(a0, b0, false, false); auto r1 = __builtin_amdgcn_permlane32_swap(a1, b1, false, false); \
    u32x4 w = {r0[0], r1[0], r0[1], r1[1]}; OUT = __builtin_bit_cast(bf16x8, w); } while (0)
  PK4(p0, 0, pa0); PK4(p0, 8, pa1); PK4(p1, 0, pa2); PK4(p1, 8, pa3);
#undef PK4
}
template <bool QL>
__device__ __forceinline__ void qkt(f32x16& p0, f32x16& p1, const LAS char* Ks, const bf16x8* qr, const LAS char* ql, int r32, int hi, int g) {
  p0 = f32x16{}; p1 = f32x16{};
#pragma unroll
  for (int d0 = 0; d0 < 4; ++d0) { const int cb = ((g * 4 + d0) * 16 + hi * 8) * 2;
    const bf16x8 b0 = *(const LAS bf16x8*)(Ks + KSWZ(r32, cb));
    const bf16x8 b1 = *(const LAS bf16x8*)(Ks + KSWZ(32 + r32, cb));
    bf16x8 q; if constexpr (QL) q = *(const LAS bf16x8*)(ql + d0 * 1024); else q = qr[d0];
    p0 = __builtin_amdgcn_mfma_f32_32x32x16_bf16(b0, q, p0, 0, 0, 0);
    p1 = __builtin_amdgcn_mfma_f32_32x32x16_bf16(b1, q, p1, 0, 0, 0); }
}
__device__ __forceinline__ int v_st(int k, int c) { const int kk = (k & ~0xC) | ((k & 4) << 1) | ((k & 8) >> 1); return ((kk >> 3) * 4 + (c >> 5)) * 512 + ((kk & 7) * 32 + (c & 31)) * 2; }
__device__ __forceinline__ int v_rd_base(int lane) { return ((lane & 3) << 3) | (((lane >> 2) & 3) << 6) | (((lane >> 4) & 1) << 5) | (((lane >> 5) & 1) << 8); }
constexpr int v_rd_off(int d0, int ks, int half) { return d0 * 512 + ks * 4096 + half * 2048; }
template <int OFF> __device__ __forceinline__ s16x4 tr_read(int vb) {
  s16x4 r; asm volatile("ds_read_b64_tr_b16 %0, %1 offset:%2" : "=&v"(r) : "v"(vb), "i"(OFF) : "memory"); return r;
}
template <int D0> __device__ __forceinline__ void pv_one(f32x16& od, int vb, bf16x8 pa0, bf16x8 pa1, bf16x8 pa2, bf16x8 pa3) {
  const s16x4 l0 = tr_read<v_rd_off(D0, 0, 0)>(vb), h0 = tr_read<v_rd_off(D0, 0, 1)>(vb), l1 = tr_read<v_rd_off(D0, 1, 0)>(vb), h1 = tr_read<v_rd_off(D0, 1, 1)>(vb);
  const s16x4 l2 = tr_read<v_rd_off(D0, 2, 0)>(vb), h2 = tr_read<v_rd_off(D0, 2, 1)>(vb), l3 = tr_read<v_rd_off(D0, 3, 0)>(vb), h3 = tr_read<v_rd_off(D0, 3, 1)>(vb);
  asm volatile("s_waitcnt lgkmcnt(0)" ::: "memory"); SBAR();
#define PK(L, H) (bf16x8){L[0], L[1], L[2], L[3], H[0], H[1], H[2], H[3]}
  od = __builtin_amdgcn_mfma_f32_32x32x16_bf16(pa0, PK(l0, h0), od, 0, 0, 0);
  od = __builtin_amdgcn_mfma_f32_32x32x16_bf16(pa1, PK(l1, h1), od, 0, 0, 0);
  od = __builtin_amdgcn_mfma_f32_32x32x16_bf16(pa2, PK(l2, h2), od, 0, 0, 0);
  od = __builtin_amdgcn_mfma_f32_32x32x16_bf16(pa3, PK(l3, h3), od, 0, 0, 0);
#undef PK
}
__device__ __forceinline__ void pv_d0(f32x16* o, int vb, bf16x8 pa0, bf16x8 pa1, bf16x8 pa2, bf16x8 pa3) {
  pv_one<0>(o[0], vb, pa0, pa1, pa2, pa3); pv_one<1>(o[1], vb, pa0, pa1, pa2, pa3); pv_one<2>(o[2], vb, pa0, pa1, pa2, pa3); pv_one<3>(o[3], vb, pa0, pa1, pa2, pa3);
}

__device__ __forceinline__ int t5_bucket(int rel) {
  const int ret = rel > 0 ? 16 : 0; const int n = rel < 0 ? -rel : rel;
  if (n < 8) return ret + n;
  int large = 8 + (31 - __builtin_clz((unsigned)(n * n))) - 6; if (large > 15) large = 15;
  return ret + large;
}
__device__ __forceinline__ void attn_setup(LAS unsigned char* lds, const float* rel_bias, const float* lamp  , int layer) {
  const int tid = fresh_tid();
  LAS float* tab = (LAS float*)(lds + OFF_TAB);
  for (int e = tid; e < 4 * TAB_N; e += 512) { const int h = e / TAB_N, idx = e % TAB_N, rel = idx - 255;
    tab[e] = (rel_bias[t5_bucket(rel) * 4 + h] - rel_bias[15 * 4 + h]) * (1.f / SCALE); }
  if (tid < 64) { const float a = lamp[tid] * lamp[64 + tid], b = lamp[128 + tid] * lamp[192 + tid];
    const float sa = wave_sum(a), sb = wave_sum(b);
    if (tid == 0) { const float lam_init = 0.8f - 0.6f * expf(-0.3f * (float)layer);
      ((LAS float*)(lds + OFF_LAM))[0] = expf(sa) - expf(sb) + lam_init; ((LAS float*)(lds + OFF_LAM))[1] = 1.f - lam_init; } }
  __syncthreads();
}

template <bool SAMPLE>
__device__ __forceinline__ void attn_unit(LAS unsigned char* lds, const void* Kg_, const void* Vg_, const void* Kl_, const void* Vl_, const bf16* Qrow0, bf16* Orow0,
                                          int NT, int qpos0, int h, const float* gnorm) {
  using St = Stage<SAMPLE>; using E = typename St::E;
  constexpr int LDK = SAMPLE ? 512 : 3328;
  const E* Kg = (const E*)Kg_; const E* Vg = (const E*)Vg_; const E* Kl = (const E*)Kl_; const E* Vl = (const E*)Vl_;
  const int tid = fresh_tid(), wid = __builtin_amdgcn_readfirstlane(tid >> 6), lane = tid & 63, r32 = lane & 31, hi = lane >> 5;
  const int g = SAMPLE ? (wid & 1) : (wid >> 2), rb = SAMPLE ? ((wid >> 1) & 1) : (wid & 3); const bool live = SAMPLE ? (wid < 4) : true;
  LAS char* V_lds = (LAS char*)lds + OFF_V; LAS char* K_lds = (LAS char*)lds + OFF_K;
  LAS float* wsf = (LAS float*)(lds + OFF_WS) + wid * 64; LAS float* li_l = wsf; LAS float* al_l = wsf + 32;
  const LAS float* tab = (const LAS float*)(lds + OFF_TAB) + h * TAB_N;
  float m_reg = -1e30f, l_reg = 0; f32x16 o[4] = {}; bf16x8 qr[4];
  const bf16* Qw = Qrow0 + (size_t)(rb * 32 + r32) * 3328 + g * 64 + hi * 8;
  const LAS char* ql = (const LAS char*)lds + OFF_QL + wid * 4096 + lane * 16;
#pragma unroll
  for (int d0 = 0; d0 < 4; ++d0) { qr[d0] = *reinterpret_cast<const bf16x8*>(Qw + d0 * 16); if constexpr (SAMPLE) *(LAS bf16x8*)((LAS char*)lds + OFF_QL + wid * 4096 + lane * 16 + d0 * 1024) = qr[d0]; }
  const int qpos = qpos0 + rb * 32 + r32;
  const int sr = tid >> 4, sc = (tid & 15) * 8, vst0 = v_st(sr, sc), vst1 = v_st(32 + sr, sc);
  const int vb0 = (int)(unsigned)(uintptr_t)V_lds + v_rd_base(lane);
  constexpr int SD = SAMPLE ? 1 : 2;
  struct { typename St::T vs0, vs1, ks0, ks1; } sr_[SD];
#define KT_(t) (SAMPLE ? ((t) < 64 ? Kg + (size_t)(t) * 64 * LDK : Kl) : Kg + (size_t)(t) * 64 * LDK)
#define VT_(t) (SAMPLE ? ((t) < 64 ? Vg + (size_t)(t) * 64 * LDK : Vl) : Vg + (size_t)(t) * 64 * LDK)
#define SLOAD(i, t) do { const E* kb_ = KT_(t); const E* vb_ = VT_(t); sr_[i].vs0 = St::ld8(vb_ + (size_t)sr * LDK + sc); sr_[i].vs1 = St::ld8(vb_ + (size_t)(32 + sr) * LDK + sc); \
    sr_[i].ks0 = St::ld8(kb_ + (size_t)sr * LDK + sc); sr_[i].ks1 = St::ld8(kb_ + (size_t)(32 + sr) * LDK + sc); } while (0)
#define SWRITE(b, i) do { *(LAS bf16x8*)(V_lds + (b) * SHM_V + vst0) = St::tobf(sr_[i].vs0); *(LAS bf16x8*)(V_lds + (b) * SHM_V + vst1) = St::tobf(sr_[i].vs1); const int kc = sc * 2; \
    *(LAS bf16x8*)(K_lds + (b) * SHM_K + KSWZ(sr, kc)) = St::tobf(sr_[i].ks0); *(LAS bf16x8*)(K_lds + (b) * SHM_K + KSWZ(32 + sr, kc)) = St::tobf(sr_[i].ks1); } while (0)
#define SWAIT() do { if constexpr (SD == 1) asm volatile("s_waitcnt vmcnt(0)" ::: "memory"); else asm volatile("s_waitcnt vmcnt(4)" ::: "memory"); } while (0)
#define RESC(a) do { if (__any((a) < 1.f)) { if (hi == 0) al_l[r32] = (a); asm volatile("s_waitcnt lgkmcnt(0)" ::: "memory"); \
    _Pragma("unroll") for (int d = 0; d < 4; ++d) _Pragma("unroll") for (int r = 0; r < 16; ++r) o[d][r] *= al_l[crow(r, hi)]; } } while (0)
#define BIASMASK(P0, P1, j) do { if ((j) >= NT - 4) { const bool msk_ = SAMPLE ? ((j) == NT - 1) : ((j) == NT - 1 && rb < 2); \
    if (msk_) { _Pragma("unroll") for (int r = 0; r < 16; ++r) { P0[r] = -1e30f; P1[r] = -1e30f; } } \
    else { const int base_ = 64 * (j) - qpos + 255 + 4 * hi; \
      _Pragma("unroll") for (int r = 0; r < 16; ++r) { const int i0_ = base_ + (r & 3) + 8 * (r >> 2); P0[r] += tab[i0_]; P1[r] += tab[i0_ + 32]; } } } } while (0)
  f32x16 pA0, pA1, pB0, pB1; float mnA, mnB, alA = 1.f, alB = 1.f; bf16x8 pa0, pa1, pa2, pa3;
  constexpr int SE = 0, SO = SD - 1;
  SLOAD(SE, 0); asm volatile("s_waitcnt vmcnt(0)" ::: "memory"); SWRITE(0, SE); __syncthreads();
  if (live) { qkt<SAMPLE>(pA0, pA1, K_lds, qr, ql, r32, hi, g); BIASMASK(pA0, pA1, 0); partialSM(pA0, pA1, m_reg, mnA, alA); }
  SLOAD(SO, 1); if constexpr (SD == 2) { if (2 < NT) SLOAD(SE, 2); }
  SWAIT(); SWRITE(1, SO); __syncthreads();
  for (int j = 1; j + 1 < NT; j += 2) {
    SBAR(); if (live) { qkt<SAMPLE>(pB0, pB1, K_lds + SHM_K, qr, ql, r32, hi, g); finishSM(pA0, pA1, alA, l_reg, pa0, pa1, pa2, pa3); } SBAR();
    SLOAD(SO, j + SD); SBAR();
    if (live) { pv_d0(o, vb0, pa0, pa1, pa2, pa3); BIASMASK(pB0, pB1, j); partialSM(pB0, pB1, m_reg, mnB, alB); }
    __syncthreads(); SWAIT(); SWRITE(0, SE);
    if (live) RESC(alB);
    __syncthreads();
    SBAR(); if (live) { qkt<SAMPLE>(pA0, pA1, K_lds, qr, ql, r32, hi, g); finishSM(pB0, pB1, alB, l_reg, pa0, pa1, pa2, pa3); } SBAR();
    if (SD == 1 || j + 3 < NT) SLOAD(SE, j + 1 + SD);
    SBAR();
    if (live) { pv_d0(o, vb0 + SHM_V, pa0, pa1, pa2, pa3); BIASMASK(pA0, pA1, j + 1); partialSM(pA0, pA1, m_reg, mnA, alA); }
    __syncthreads(); SWAIT(); SWRITE(1, SO);
    if (live) RESC(alA);
    __syncthreads();
  }
  SBAR();
  if (live) { qkt<SAMPLE>(pB0, pB1, K_lds + SHM_K, qr, ql, r32, hi, g); finishSM(pA0, pA1, alA, l_reg, pa0, pa1, pa2, pa3); SBAR();
    pv_d0(o, vb0, pa0, pa1, pa2, pa3); BIASMASK(pB0, pB1, NT - 1); partialSM(pB0, pB1, m_reg, mnB, alB); }
  __syncthreads();
  if (live) { RESC(alB); finishSM(pB0, pB1, alB, l_reg, pa0, pa1, pa2, pa3); SBAR(); pv_d0(o, vb0 + SHM_V, pa0, pa1, pa2, pa3); }
  if (hi == 0) li_l[r32] = l_reg;
  asm volatile("s_waitcnt lgkmcnt(0)" ::: "memory");
  float rli[16];
#pragma unroll
  for (int r = 0; r < 16; ++r) rli[r] = __builtin_amdgcn_rcpf(li_l[crow(r, hi)]);
  __syncthreads();
  LAS float* X = (LAS float*)lds + rb * 4096 + lane;
  if (live && g == 1) {
#pragma unroll
    for (int r = 0; r < 16; ++r)
#pragma unroll
      for (int d0 = 0; d0 < 4; ++d0) X[(r * 4 + d0) * 64] = o[d0][r] * rli[r];
  }
  __syncthreads();
  if (live && g == 0) {
    const float lam = ((const LAS float*)(lds + OFF_LAM))[0], osc = ((const LAS float*)(lds + OFF_LAM))[1];
    float ss[16];
#pragma unroll
    for (int r = 0; r < 16; ++r) { float s = 0.f;
#pragma unroll
      for (int d0 = 0; d0 < 4; ++d0) { const float od = o[d0][r] * rli[r] - lam * X[(r * 4 + d0) * 64]; o[d0][r] = od; s += od * od; }
      ss[r] = s; }
#pragma unroll
    for (int r = 0; r < 16; ++r) { float s = ss[r]; s += __shfl_xor(s, 1); s += __shfl_xor(s, 2); s += __shfl_xor(s, 4); s += __shfl_xor(s, 8); s += __shfl_xor(s, 16);
      ss[r] = osc / sqrtf(s * (1.f / 128.f) + RMS_EPS); }
    float gn[4];
#pragma unroll
    for (int d0 = 0; d0 < 4; ++d0) gn[d0] = gnorm[d0 * 32 + r32];
    bf16* Ow = Orow0 + (size_t)(rb * 32) * 1024 + r32;
#pragma unroll
    for (int r = 0; r < 16; ++r) { const int orow = crow(r, hi);
#pragma unroll
      for (int d0 = 0; d0 < 4; ++d0) Ow[(size_t)orow * 1024 + d0 * 32] = (bf16)f2bf(o[d0][r] * ss[r] * gn[d0]); }
  }
  __syncthreads();
#undef KT_
#undef VT_
#undef SLOAD
#undef SWRITE
#undef SWAIT
#undef RESC
#undef BIASMASK
}

__device__ __forceinline__ void attn_unit_sample(LAS unsigned char* lds, const float* Kg, const float* Vg, const float* Kl, const float* Vl, const bf16* Qrow0, bf16* Orow0,
                                                 int qpos0, int h, const float* gnorm) {
  using St = Stage<true>; constexpr int LDK = 512, NT = 65;
  const int tid = fresh_tid(), wid = __builtin_amdgcn_readfirstlane(tid >> 6), lane = tid & 63, r32 = lane & 31, hi = lane >> 5;
  const int g = wid & 1, rb = (wid >> 1) & 1; const bool live = wid < 4;
  LAS char* V_lds = (LAS char*)lds + OFF_V; LAS char* K_lds = (LAS char*)lds + OFF_K;
  LAS float* wsf = (LAS float*)(lds + OFF_WS) + wid * 64; LAS float* li_l = wsf; LAS float* al_l = wsf + 32;
  const LAS float* tab = (const LAS float*)(lds + OFF_TAB) + h * TAB_N;
  float m_reg = -1e30f, l_reg = 0; f32x16 o[4] = {}; bf16x8 qr[4];
  const bf16* Qw = Qrow0 + (size_t)(rb * 32 + r32) * 3328 + g * 64 + hi * 8;
#pragma unroll
  for (int d0 = 0; d0 < 4; ++d0) qr[d0] = *reinterpret_cast<const bf16x8*>(Qw + d0 * 16);
  const int qpos = qpos0 + rb * 32 + r32;
  const int sr = tid >> 4, sc = (tid & 15) * 8, vst0 = v_st(sr, sc), vst1 = v_st(32 + sr, sc);
  const int vb0 = (int)(unsigned)(uintptr_t)V_lds + v_rd_base(lane);
  typename St::T vs0, vs1, ks0, ks1;
#define SLOAD1(t) do { const float* kb_ = (t) < 64 ? Kg + (size_t)(t) * 64 * LDK : Kl; const float* vb_ = (t) < 64 ? Vg + (size_t)(t) * 64 * LDK : Vl; \
    vs0 = St::ld8(vb_ + (size_t)sr * LDK + sc); vs1 = St::ld8(vb_ + (size_t)(32 + sr) * LDK + sc); ks0 = St::ld8(kb_ + (size_t)sr * LDK + sc); ks1 = St::ld8(kb_ + (size_t)(32 + sr) * LDK + sc); } while (0)
#define SWRITE1(b) do { *(LAS bf16x8*)(V_lds + (b) * SHM_V + vst0) = St::tobf(vs0); *(LAS bf16x8*)(V_lds + (b) * SHM_V + vst1) = St::tobf(vs1); const int kc = sc * 2; \
    *(LAS bf16x8*)(K_lds + (b) * SHM_K + KSWZ(sr, kc)) = St::tobf(ks0); *(LAS bf16x8*)(K_lds + (b) * SHM_K + KSWZ(32 + sr, kc)) = St::tobf(ks1); } while (0)
  SLOAD1(0); asm volatile("s_waitcnt vmcnt(0)" ::: "memory"); SWRITE1(0); __syncthreads();
  for (int j = 0; j < NT; ++j) {
    const int bsel = j & 1;
    if (j + 1 < NT) SLOAD1(j + 1);
    SBAR();
    if (live) { f32x16 p0, p1; float mn, al; bf16x8 pa0, pa1, pa2, pa3;
      qkt<false>(p0, p1, K_lds + bsel * SHM_K, qr, nullptr, r32, hi, g);
      if (j >= NT - 3) { const int base_ = 64 * j - qpos + 255 + 4 * hi;
#pragma unroll
        for (int r = 0; r < 16; ++r) { const int i0_ = base_ + (r & 3) + 8 * (r >> 2); p0[r] += tab[i0_]; p1[r] += tab[i0_ + 32]; } }
      partialSM(p0, p1, m_reg, mn, al);
      if (__any(al < 1.f)) { if (hi == 0) al_l[r32] = al; asm volatile("s_waitcnt lgkmcnt(0)" ::: "memory");
#pragma unroll
        for (int d = 0; d < 4; ++d)
#pragma unroll
          for (int r = 0; r < 16; ++r) o[d][r] *= al_l[crow(r, hi)]; }
      finishSM(p0, p1, al, l_reg, pa0, pa1, pa2, pa3); SBAR();
      pv_d0(o, vb0 + bsel * SHM_V, pa0, pa1, pa2, pa3); }
    SBAR();
    if (j + 1 < NT) { asm volatile("s_waitcnt vmcnt(0)" ::: "memory"); SWRITE1(bsel ^ 1); }
    __syncthreads();
  }
#undef SLOAD1
#undef SWRITE1
  if (hi == 0) li_l[r32] = l_reg;
  asm volatile("s_waitcnt lgkmcnt(0)" ::: "memory");
  float rli[16];
#pragma unroll
  for (int r = 0; r < 16; ++r) rli[r] = __builtin_amdgcn_rcpf(li_l[crow(r, hi)]);
  LAS float* X = (LAS float*)lds + rb * 4096 + lane;
  if (live && g == 1) {
#pragma unroll
    for (int r = 0; r < 16; ++r)
#pragma unroll
      for (int d0 = 0; d0 < 4; ++d0) X[(r * 4 + d0) * 64] = o[d0][r] * rli[r];
  }
  __syncthreads();
  if (live && g == 0) {
    const float lam = ((const LAS float*)(lds + OFF_LAM))[0], osc = ((const LAS float*)(lds + OFF_LAM))[1];
    float ss[16];
#pragma unroll
    for (int r = 0; r < 16; ++r) { float s = 0.f;
#pragma unroll
      for (int d0 = 0; d0 < 4; ++d0) { const float od = o[d0][r] * rli[r] - lam * X[(r * 4 + d0) * 64]; o[d0][r] = od; s += od * od; }
      ss[r] = s; }
#pragma unroll
    for (int r = 0; r < 16; ++r) { float s = ss[r]; s += __shfl_xor(s, 1); s += __shfl_xor(s, 2); s += __shfl_xor(s, 4); s += __shfl_xor(s, 8); s += __shfl_xor(s, 16);
      ss[r] = osc / sqrtf(s * (1.f / 128.f) + RMS_EPS); }
    float gn[4];
#pragma unroll
    for (int d0 = 0; d0 < 4; ++d0) gn[d0] = gnorm[d0 * 32 + r32];
    bf16* Ow = Orow0 + (size_t)(rb * 32) * 1024 + r32;
#pragma unroll
    for (int r = 0; r < 16; ++r) { const int orow = crow(r, hi);
#pragma unroll
      for (int d0 = 0; d0 < 4; ++d0) Ow[(size_t)orow * 1024 + d0 * 32] = (bf16)f2bf(o[d0][r] * ss[r] * gn[d0]); }
  }
  __syncthreads();
}
#undef KSWZ
#undef SBAR
}

namespace gla {
constexpr int P72 = 72;
constexpr int L_TOT = 0, L_DL = 2048, L_QT = 4096, L_KT = L_QT + 64 * P72 * 2, L_KDT = L_KT + 64 * P72 * 2, L_A = L_KDT + 64 * P72 * 2, L_VT = L_A + 64 * P72 * 2, L_END = L_VT + 128 * P72 * 2;
static_assert(L_END <= RING_BYTES, "gla LDS map");
__device__ __forceinline__ int crow(int r, int hi) { return (r & 3) + 8 * (r >> 2) + 4 * hi; }
__device__ __forceinline__ float logsig(float z) { return fminf(z, 0.f) - log1pf(__expf(-fabsf(z))); }
__device__ __forceinline__ bf16x8 ldsfrag(const LAS unsigned char* img, int row, int k0) { return *(const LAS bf16x8*)(img + (row * P72 + k0) * 2); }

__device__ __forceinline__ void g1_unit(LAS unsigned char* lds, int c, int h, int layer, const bf16* ACT, const float* LOGA, const float* balpha  ,
                                        float* UT, float* Dw, float* OI, bf16* QT, bf16* SCT, const float* state_in  , float* state_out  ) {
    const int tid = fresh_tid(), wid = __builtin_amdgcn_readfirstlane(tid >> 6), lane = tid & 63, r = lane & 31, hh = lane >> 5;
    const int row0 = 64 * c;
    LAS float* TOT = (LAS float*)(lds + L_TOT); LAS float* DL = (LAS float*)(lds + L_DL);
    LAS unsigned char* Qi = lds + L_QT; LAS unsigned char* Ki = lds + L_KT; LAS unsigned char* KDi = lds + L_KDT; LAS unsigned char* Ai = lds + L_A; LAS unsigned char* Vi = lds + L_VT;
    { const int d = lane, tg = wid, t0 = 8 * tg;
      const float bal = balpha[h * 64 + d];
      float cs[8]; float run = 0.f;
#pragma unroll
      for (int i = 0; i < 8; ++i) { const float z = LOGA[(size_t)(row0 + t0 + i) * 256 + h * 64 + d] + bal; run += logsig(z) * 0.0625f; cs[i] = run; }
      float qv[8], kv[8];
#pragma unroll
      for (int i = 0; i < 8; ++i) { const bf16* ap = ACT + (size_t)(row0 + t0 + i) * NIN + h * 64 + d; qv[i] = bf2f(ap[0]); kv[i] = bf2f(ap[256]); }
      TOT[tg * 64 + d] = run;
#pragma unroll
      for (int k = 0; k < 2; ++k) { const int ci = tid + 512 * k, s = ci >> 4, jc = (ci & 15) * 8;
        const bf16x8 v = *(const bf16x8*)(ACT + (size_t)(row0 + s) * NIN + 768 + h * 128 + jc);
#pragma unroll
        for (int e = 0; e < 8; ++e) *(LAS short*)(Vi + ((jc + e) * P72 + s) * 2) = v[e]; }
      __syncthreads();
      float off = 0.f, blast = 0.f;
#pragma unroll
      for (int g2 = 0; g2 < 8; ++g2) { const float tv = TOT[g2 * 64 + d]; blast += tv; if (g2 < tg) off += tv; }
      unsigned kd[4];
      float kdf[8];
#pragma unroll
      for (int i = 0; i < 8; ++i) { const float b = off + cs[i]; const float eb = __expf(b);
        const float qt = qv[i] * 0.125f * eb, kt = kv[i] * __expf(-b); kdf[i] = kv[i] * __expf(blast - b);
        const unsigned short qb = (unsigned short)f2bf(qt);
        *(LAS unsigned short*)(Qi + ((t0 + i) * P72 + d) * 2) = qb; *(LAS unsigned short*)(Ki + ((t0 + i) * P72 + d) * 2) = (unsigned short)f2bf(kt);
        QT[(size_t)(row0 + t0 + i) * 256 + h * 64 + d] = qb; }
#pragma unroll
      for (int i = 0; i < 4; ++i) kd[i] = pk2(kdf[2 * i], kdf[2 * i + 1]);
      *(LAS v4u*)(KDi + (d * P72 + t0) * 2) = (v4u){kd[0], kd[1], kd[2], kd[3]};
      if (tg == 0) { const float Dd = __expf(blast); DL[d] = Dd; Dw[(size_t)(c * 4 + h) * 64 + d] = Dd; }
    }
    __syncthreads();
    if (wid < 3) { const int sb = (wid == 2), tb = (wid >= 1); f32x16 acc = {};
#pragma unroll
      for (int kk = 0; kk < 4; ++kk) acc = __builtin_amdgcn_mfma_f32_32x32x16_bf16(ldsfrag(Ki, sb * 32 + r, kk * 16 + 8 * hh), ldsfrag(Qi, tb * 32 + r, kk * 16 + 8 * hh), acc, 0, 0, 0);
      const int t = tb * 32 + r;
#pragma unroll
      for (int q = 0; q < 4; ++q) { const int s0 = sb * 32 + 8 * q + 4 * hh; float v[4];
#pragma unroll
        for (int e = 0; e < 4; ++e) v[e] = (s0 + e <= t) ? acc[4 * q + e] : 0.f;
        *(LAS v2u*)(Ai + (t * P72 + s0) * 2) = (v2u){pk2(v[0], v[1]), pk2(v[2], v[3])}; }
    } else if (wid == 3) {
#pragma unroll
      for (int q = 0; q < 4; ++q) *(LAS v2u*)(Ai + (r * P72 + 32 + 8 * q + 4 * hh) * 2) = (v2u){0u, 0u};
    } else {
      const int jb = wid - 4, j = jb * 32 + r;
#pragma unroll
      for (int db = 0; db < 2; ++db) { f32x16 acc = {};
#pragma unroll
        for (int kk = 0; kk < 4; ++kk) acc = __builtin_amdgcn_mfma_f32_32x32x16_bf16(ldsfrag(KDi, db * 32 + r, kk * 16 + 8 * hh), ldsfrag(Vi, j, kk * 16 + 8 * hh), acc, 0, 0, 0);
        if (c < NPCH) {
#pragma unroll
          for (int q = 0; q < 4; ++q) { const int d0 = db * 32 + 8 * q + 4 * hh;
            *(f32x4*)(UT + ((size_t)(c * 4 + h) * 128 + j) * 64 + d0) = (f32x4){acc[4 * q], acc[4 * q + 1], acc[4 * q + 2], acc[4 * q + 3]}; }
        } else { const int b = c - NPCH; const size_t sbase = (size_t)(b * 4 + h) * 8192;
#pragma unroll
          for (int q = 0; q < 4; ++q) { const int d0 = db * 32 + 8 * q + 4 * hh; float si[4];
#pragma unroll
            for (int e = 0; e < 4; ++e) { si[e] = state_in[sbase + (size_t)(d0 + e) * 128 + j]; state_out[sbase + (size_t)(d0 + e) * 128 + j] = DL[d0 + e] * si[e] + acc[4 * q + e]; }
            *(v2u*)(SCT + ((size_t)(c * 4 + h) * 128 + j) * 64 + d0) = (v2u){pk2(si[0], si[1]), pk2(si[2], si[3])}; }
        }
      }
    }
    __syncthreads();
    { const int jb = wid >> 1, tb = wid & 1; f32x16 acc = {};
#pragma unroll
      for (int kk = 0; kk < 4; ++kk) acc = __builtin_amdgcn_mfma_f32_32x32x16_bf16(ldsfrag(Vi, jb * 32 + r, kk * 16 + 8 * hh), ldsfrag(Ai, tb * 32 + r, kk * 16 + 8 * hh), acc, 0, 0, 0);
      float* op = OI + (size_t)(row0 + tb * 32 + r) * 512 + h * 128 + jb * 32 + 4 * hh;
#pragma unroll
      for (int q = 0; q < 4; ++q) *(f32x4*)(op + 8 * q) = (f32x4){acc[4 * q], acc[4 * q + 1], acc[4 * q + 2], acc[4 * q + 3]}; }
    __syncthreads();
}

__device__ __forceinline__ void g2_group(LAS unsigned char* lds, int eg, const float* UT, const float* Dw, bf16* SCT, float* gout  ) {
    const int tid = fresh_tid(); const int el = tid & 127, seg = tid >> 7; const int e = eg * 128 + el; const int h = e >> 13, j = (e >> 6) & 127, d = e & 63;
    LAS float* PL = (LAS float*)lds;
    const size_t ustride = 4 * 128 * 64, dstride = 4 * 64;
    const float* up = UT + ((size_t)h * 128 + j) * 64 + d + (size_t)(64 * seg) * ustride; const float* dp = Dw + h * 64 + d + (size_t)(64 * seg) * dstride;
    float P = 1.f, L = 0.f;
#pragma unroll 8
    for (int cc = 0; cc < 64; ++cc) { const float Dv = dp[(size_t)cc * dstride], Uv = up[(size_t)cc * ustride]; L = fmaf(Dv, L, Uv); P *= Dv; }
    PL[(seg * 128 + el) * 2] = P; PL[(seg * 128 + el) * 2 + 1] = L;
    __syncthreads();
    float S = 0.f;
    for (int s2 = 0; s2 < seg; ++s2) S = fmaf(PL[(s2 * 128 + el) * 2], S, PL[(s2 * 128 + el) * 2 + 1]);
    bf16* sp = SCT + ((size_t)h * 128 + j) * 64 + d + (size_t)(64 * seg) * ustride;
#pragma unroll 8
    for (int cc = 0; cc < 64; ++cc) { const float Dv = dp[(size_t)cc * dstride], Uv = up[(size_t)cc * ustride]; sp[(size_t)cc * ustride] = (bf16)f2bf(S); S = fmaf(Dv, S, Uv); }
    if (seg == 3) gout[((size_t)h * 64 + d) * 128 + j] = S;
    __syncthreads();
}

__device__ __forceinline__ void g3_unit(LAS float* part, int c, int h, const bf16* ACT, const float* OI, const bf16* QT, const bf16* SCT, const float* gnorm  , bf16* MIX) {
    const int tid = fresh_tid(), wid = __builtin_amdgcn_readfirstlane(tid >> 6), lane = tid & 63, r = lane & 31, hh = lane >> 5;
    const int jb = wid >> 1, tb = wid & 1; const int row = 64 * c + tb * 32 + r;
    f32x16 acc = {};
    const bf16* ap = SCT + ((size_t)(c * 4 + h) * 128 + jb * 32 + r) * 64 + 8 * hh; const bf16* bp = QT + (size_t)row * 256 + h * 64 + 8 * hh;
#pragma unroll
    for (int kk = 0; kk < 4; ++kk) acc = __builtin_amdgcn_mfma_f32_32x32x16_bf16(*(const bf16x8*)(ap + kk * 16), *(const bf16x8*)(bp + kk * 16), acc, 0, 0, 0);
    const int j0 = jb * 32 + 4 * hh;
    const float* oip = OI + (size_t)row * 512 + h * 128 + j0;
    float ss = 0.f;
#pragma unroll
    for (int q = 0; q < 4; ++q) { const f32x4 oi = *(const f32x4*)(oip + 8 * q);
#pragma unroll
      for (int e = 0; e < 4; ++e) { acc[4 * q + e] += oi[e]; ss += acc[4 * q + e] * acc[4 * q + e]; } }
    ss += __shfl_xor(ss, 32);
    if (hh == 0) part[wid * 32 + r] = ss;
    __syncthreads();
    const float tot = part[tb * 32 + r] + part[(tb + 2) * 32 + r] + part[(tb + 4) * 32 + r] + part[(tb + 6) * 32 + r];
    const float rstd = 1.f / sqrtf(tot * (1.f / 128.f) + RMS_EPS);
    const bf16* gp = ACT + (size_t)row * NIN + 1280 + h * 128 + j0; bf16* mp = MIX + (size_t)row * 1024 + h * 128 + j0;
#pragma unroll
    for (int q = 0; q < 4; ++q) { const v2u gg = *(const v2u*)(gp + 8 * q); const f32x4 gn = *(const f32x4*)(gnorm + j0 + 8 * q);
      float gv[4] = {bf2f((unsigned short)(gg.x & 0xffffu)), bf2f((unsigned short)(gg.x >> 16)), bf2f((unsigned short)(gg.y & 0xffffu)), bf2f((unsigned short)(gg.y >> 16))}; float y[4];
#pragma unroll
      for (int e = 0; e < 4; ++e) { const float sg = gv[e] / (1.f + __expf(-gv[e])); y[e] = acc[4 * q + e] * rstd * gn[e] * sg; }
      *(v2u*)(mp + 8 * q) = (v2u){pk2(y[0], y[1]), pk2(y[2], y[3])}; }
    __syncthreads();
}
}

__global__ void __launch_bounds__(NWAVES * 64, 2) hymba_fwd(Args args) {
    extern __shared__ __attribute__((aligned(16))) unsigned char lds[];
    Frame F;
    F.lds = (LAS unsigned char*)lds;
    for (int u = threadIdx.x; u < (LDS_BYTES - LDSCTL_OFF) / 4; u += NWAVES * 64) ((LAS unsigned*)(F.lds + LDSCTL_OFF))[u] = 0u;
    __syncthreads();
    if (threadIdx.x == 0) { LAS unsigned long long* t = (LAS unsigned long long*)(F.lds + PTAB_OFF);
#pragma unroll
        for (int i = 0; i < 18; ++i) t[i] = (unsigned long long)args.in[i];
        t[18] = (unsigned long long)args.out; t[19] = (unsigned long long)args.ws; }
    __syncthreads();
#define CTL_ ((gu32*)(wsp(F) + WS_CTL))
    (void)xcd_barrier_post((unsigned*)(CTL_ + CW_BAR), (volatile LAS unsigned*)(F.lds + MISC_OFF) + 8);
#define GRID_BAR() do { XcdBarrier b_; b_.bar = (unsigned*)(CTL_ + CW_BAR); b_.x = xb_xcc_id(); b_.st = (volatile LAS unsigned*)(F.lds + MISC_OFF) + 8; xcd_barrier(b_); } while (0)

#define WSB(off) (wsp(F) + (off))
#define X_ ((float*)WSB(WS_X))
#define XN_ ((bf16*)WSB(WS_XN))
#define ACT_ ((bf16*)WSB(WS_ACT))
#define MIX_ ((bf16*)WSB(WS_MIX))
#define HB_ ((bf16*)WSB(WS_H))
#define LOGA_ ((float*)WSB(WS_LOGA))

#ifndef SKIP_P0
    p0_prologue(F);
#endif
    GRID_BAR();

    for (int l = 0; l < DEPTH; ++l) {
#define WL_ (WSB(WS_W) + (size_t)l * W_LAYER)
#define SRCP_ (l == 0 ? inp(F, 0) : (const float*)X_)
#define SRCS_ (l == 0 ? inp(F, 1) : (const float*)X_ + (size_t)SEQ * DM)
        norm_rows_bf16(F, SRCP_, SRCS_, inp(F, 12) + (size_t)l * DM, XN_);
        GRID_BAR();
#ifndef SKIP_IN
        { pg8::Gemm g{XN_, (const bf16*)(WL_ + WO_IN), M, NIN, DM}; pg8::StaticOrder S; S.init(M, NIN, grid_n(), (int)blockIdx.x);
          pg8::EpiIn E{wsp(F), outp(F), l, WS_ACT, WS_LOGA};
          pg8::gemm_phase<pg8::EpiIn, pg8::StaticOrder, true, true>(F.lds + RING_OFF, g, S, E); }
#endif
        GRID_BAR();
        for (int u = blockIdx.x; u < NCHUNK * 4; u += grid_n())
#ifndef SKIP_G1
            gla::g1_unit(F.lds + RING_OFF, u >> 2, u & 3, l, ACT_, LOGA_, inp(F, 7) + (size_t)l * 256, (float*)WSB(WS_U), (float*)WSB(WS_D), (float*)WSB(WS_OI), (bf16*)WSB(WS_QT), (bf16*)WSB(WS_SC),
                         inp(F, 4) + (size_t)l * DECB * 4 * 8192, outp(F) + OG_S + (size_t)l * DECB * 4 * 8192);
#endif
            ;
        GRID_BAR();
        for (int eg = blockIdx.x; eg < 256; eg += grid_n())
#ifndef SKIP_G2
            gla::g2_group(F.lds + RING_OFF, eg, (const float*)WSB(WS_U), (const float*)WSB(WS_D), (bf16*)WSB(WS_SC), outp(F) + OG_P + (size_t)l * 4 * 8192);
#endif
            ;
        GRID_BAR();
        att::attn_setup(F.lds + RING_OFF, inp(F, 17), inp(F, 9) + (size_t)l * 256, l);
        for (int it = 0;; ++it) {
            volatile LAS int* slot = (volatile LAS int*)(F.lds + MISC_OFF) + 16 + (it & 1);
            if (threadIdx.x == 0) *slot = (int)__hip_atomic_fetch_add((unsigned*)(CTL_ + CW_QUEUE + 64 * l), 1u, __ATOMIC_RELAXED, __HIP_MEMORY_SCOPE_AGENT);
            __syncthreads();
            const int idx = __builtin_amdgcn_readfirstlane(*slot);
            if (idx >= 64 + 512 + NCHUNK * 4) break;
            if (idx < 64) { const int b = idx >> 2, h = idx & 3;
                const float* kc = inp(F, 2) + ((size_t)(l * DECB + b) * PAST) * 512 + h * 128; const float* vc = inp(F, 3) + ((size_t)(l * DECB + b) * PAST) * 512 + h * 128;
                const float* kn = outp(F) + OK_S + ((size_t)(l * DECB + b) * 64) * 512 + h * 128; const float* vn = outp(F) + OV_S + ((size_t)(l * DECB + b) * 64) * 512 + h * 128;
#ifndef SKIP_AS
                att::attn_unit_sample(F.lds + RING_OFF, kc, vc, kn, vn, ACT_ + (size_t)(SEQ + 64 * b) * NIN + 1792 + h * 128, MIX_ + (size_t)(SEQ + 64 * b) * DM + 512 + h * 128,
                                      PAST, h, inp(F, 10) + (size_t)l * 128);
#endif
            } else if (idx < 576) { const int i = idx - 64, u = 127 - (i >> 2), h = i & 3;
#ifndef SKIP_AP
                att::attn_unit<false>(F.lds + RING_OFF, ACT_ + 2304 + h * 128, ACT_ + 2816 + h * 128, nullptr, nullptr, ACT_ + (size_t)(128 * u) * NIN + 1792 + h * 128,
                                      MIX_ + (size_t)(128 * u) * DM + 512 + h * 128, 2 * u + 2, 128 * u, h, inp(F, 10) + (size_t)l * 128);
#endif
            } else { const int i = idx - 576;
#ifndef SKIP_G3
                gla::g3_unit((LAS float*)(F.lds + RING_OFF + att::OFF_G3), i >> 2, i & 3, ACT_, (const float*)WSB(WS_OI), (const bf16*)WSB(WS_QT), (const bf16*)WSB(WS_SC), inp(F, 8) + (size_t)l * 128, MIX_);
#endif
            }
        }
        GRID_BAR();
#ifndef SKIP_OUT
        { pg8::Gemm g{MIX_, (const bf16*)(WL_ + WO_OUT), M, DM, DM}; pg8::StaticOrder S; S.init(M, DM, grid_n(), (int)blockIdx.x);
          pg8::EpiRes E{SRCP_, SRCS_, X_};
          pg8::gemm_phase<pg8::EpiRes, pg8::StaticOrder, true, true>(F.lds + RING_OFF, g, S, E); }
#endif
        GRID_BAR();
        norm_rows_bf16(F, X_, X_ + (size_t)SEQ * DM, inp(F, 13) + (size_t)l * DM, XN_);
        GRID_BAR();
#ifndef SKIP_F1
        { pg8::Gemm g{XN_, (const bf16*)(WL_ + WO_F1), M, NF1, DM}; pg8::StaticOrder S; S.init(M, NF1, grid_n(), (int)blockIdx.x);
          pg8::EpiSwi E{HB_, DFF};
          pg8::gemm_phase<pg8::EpiSwi, pg8::StaticOrder, true, true>(F.lds + RING_OFF, g, S, E); }
#endif
        GRID_BAR();
#ifndef SKIP_F2
        { pg8::Gemm g{HB_, (const bf16*)(WL_ + WO_F2), M, DM, DFF}; pg8::StaticOrder S; S.init(M, DM, grid_n(), (int)blockIdx.x);
          pg8::EpiRes E{X_, X_ + (size_t)SEQ * DM, X_};
          pg8::gemm_phase<pg8::EpiRes, pg8::StaticOrder, true, true>(F.lds + RING_OFF, g, S, E); }
#endif
        GRID_BAR();
    }
    norm_rows_f32(F, X_, inp(F, 16), outp(F) + OY);
}

extern "C" void kernel_launch(void* const* d_in, const int* in_sizes, int n_in, void* d_out, int out_size, void* d_ws, size_t ws_size, hipStream_t stream) {
    static int grid = 0;
    if (grid == 0) {
        if (n_in != 18 || (size_t)out_size != OUT_TOTAL || ws_size < WS_END) { fprintf(stderr, "kernel_launch: shape mismatch n_in %d out %d ws %zu\n", n_in, out_size, ws_size); grid = -1; return; }
        int dev = 0, cus = 0, per_cu = 0;
        if (hipGetDevice(&dev) != hipSuccess || hipDeviceGetAttribute(&cus, hipDeviceAttributeMultiprocessorCount, dev) != hipSuccess) { grid = -1; return; }
        if (hipFuncSetAttribute((const void*)hymba_fwd, hipFuncAttributeMaxDynamicSharedMemorySize, LDS_BYTES) != hipSuccess) { fprintf(stderr, "kernel_launch: hipFuncSetAttribute failed\n"); grid = -1; return; }
        if (hipOccupancyMaxActiveBlocksPerMultiprocessor(&per_cu, (const void*)hymba_fwd, NWAVES * 64, LDS_BYTES) != hipSuccess || per_cu < 1)
            fprintf(stderr, "kernel_launch: occupancy query reports %d\n", per_cu);
        (void)hipGetLastError();
        grid = cus;
    }
    if (grid < 0) return;
    if (hipMemsetAsync((char*)d_ws + WS_CTL, 0, CTL_ZERO_BYTES, stream) != hipSuccess) return;
    Args a{};
    for (int i = 0; i < 18; ++i) a.in[i] = (const float*)d_in[i];
    a.out = (float*)d_out; a.ws = (unsigned char*)d_ws;
    hipLaunchKernelGGL(hymba_fwd, dim3(grid), dim3(NWAVES * 64), LDS_BYTES, stream, a);
    const hipError_t le = hipPeekAtLastError();
    if (le != hipSuccess) fprintf(stderr, "kernel_launch: launch failed: %s\n", hipGetErrorName(le));
}
```

```cpp
#include <hip/hip_runtime.h>
#include <cstdio>
#include <cstdint>
namespace pg8 {
#define PG8_LAS __attribute__((address_space(3)))
typedef unsigned short bf16_t;
typedef short bf16x8 __attribute__((ext_vector_type(8)));
typedef float f32x4 __attribute__((ext_vector_type(4)));
typedef unsigned u32x4 __attribute__((ext_vector_type(4)));
constexpr int BM = 256, BK = 64, HALF = 128, HTB = HALF * BK * 2  , STAGE_BYTES = 8 * HTB, NXCD = 8, WGM = 8;

__host__ __device__ __forceinline__ int lds_byte(int r, int c) { const int st = (r >> 4) * 2 + (c >> 5), rr = r & 15, cc = c & 31, ob = rr * 64 + cc * 2; return st * 1024 + (ob ^ (((ob >> 9) & 1) << 5)); }
__host__ __device__ __forceinline__ void stage_rc(int b, int& R, int& C) { const int st = b / 1024, sb = b % 1024, swz = sb ^ (((sb >> 9) & 1) << 5); R = (st >> 1) * 16 + swz / 64; C = (st & 1) * 32 + (swz % 64) / 2; }
__host__ __device__ __forceinline__ int perm32(int rho) { const int n = rho >> 4, i = rho & 15; return 8 * (i >> 2) + 4 * n + (i & 3); }

struct Unit { int pm, pn; };
struct Gemm { const bf16_t* A; const bf16_t* Bt; int M, N, K; };

struct StaticOrder {
    int nM, nN, nwg, G, c;
    __host__ __device__ void init(int M, int N, int G_, int c_) { nM = M / BM; nN = N / BM; nwg = nM * nN; G = G_; c = c_; }
    __host__ __device__ bool next(int i, Unit& u) const {
        const long L = (long)i * G + c; if (L >= nwg) return false;
        int wgid = (int)L; { const int q = nwg / NXCD, r = nwg % NXCD, xcd = wgid % NXCD, off = wgid / NXCD; wgid = (xcd < r ? xcd * (q + 1) : r * (q + 1) + (xcd - r) * q) + off; }
        const int nig = WGM * nN, gid = wgid / nig, fm = gid * WGM, gsz = (nM - fm) < WGM ? (nM - fm) : WGM;
        u.pm = fm + ((wgid % nig) % gsz); u.pn = (wgid % nig) / gsz; return true;
    }
    __device__ __forceinline__ void a_ready(const Unit&) const {}
    __device__ __forceinline__ void done(const Unit&) const {}
};

__device__ __forceinline__ unsigned cvt_pk_bf16(float lo, float hi) { unsigned r; asm volatile("v_cvt_pk_bf16_f32 %0, %1, %2" : "=v"(r) : "v"(lo), "v"(hi)); return r; }
__device__ __forceinline__ float silu_f(float v) { return v * __builtin_amdgcn_rcpf(1.f + __expf(-v)); }
__device__ __forceinline__ float logsig_f(float z) { return fminf(z, 0.f) - log1pf(__expf(-fabsf(z))); }

__device__ __forceinline__ float row_rstd(const float* rsq, int row) {
    const f32x4* p = (const f32x4*)(rsq + (size_t)row * 16); const f32x4 a = p[0], b = p[1], c = p[2], d = p[3];
    const float s = ((a[0] + a[1]) + (a[2] + a[3])) + ((b[0] + b[1]) + (b[2] + b[3])) + (((c[0] + c[1]) + (c[2] + c[3])) + ((d[0] + d[1]) + (d[2] + d[3])));
    return 1.f / sqrtf(s * (1.f / 1024.f) + 1e-6f);
}
constexpr int IN_N = 3328;
constexpr int PROMPT_ROWS = 16384;

struct EpiIn {
    static constexpr bool PERM = true, AFTER_DRAIN = false;
    unsigned char* ws; float* out; int layer;
    size_t act_off, loga_off;
    const PG8_LAS float* rstd;
    __device__ __forceinline__ void operator()(const f32x4 (&acc)[2][2][4][2], const Unit& u, int wr, int wc, int fr, int fq, int ui) const {
        const int row0 = u.pm * BM + wr * 64 + fr; const int pn = u.pn; const int cl0 = wc * 32 + 8 * fq;
        float* fo = nullptr; int fld = 512;
        if (pn == 2) { fo = (float*)(ws + loga_off) + (size_t)row0 * 256 + cl0; fld = 256; }
        else if (pn >= 9) { const bool samp = (u.pm >= PROMPT_ROWS / BM); const bool isv = (pn >= 11);
            const size_t b = samp ? (isv ? (size_t)87162880 : (size_t)85065728) + (size_t)layer * 524288 : (isv ? (size_t)51380224 : (size_t)17825792) + (size_t)layer * 8388608;
            fo = out + b + (size_t)(row0 - (samp ? PROMPT_ROWS : 0)) * 512 + ((pn - 9) & 1) * 256 + cl0; }
        bf16_t* ab = (bf16_t*)(ws + act_off) + (size_t)row0 * IN_N + pn * BM + cl0;
#pragma unroll
        for (int ai = 0; ai < 2; ++ai)
#pragma unroll
            for (int m = 0; m < 4; ++m) { const size_t ro = (size_t)(ai * HALF + m * 16);
                const float rs = rstd[ui * BM + wr * 64 + fr + ai * HALF + m * 16];
#pragma unroll
                for (int bj = 0; bj < 2; ++bj) { f32x4 v0 = acc[ai][bj][m][0] * rs, v1 = acc[ai][bj][m][1] * rs;
                    u32x4 w; w.x = cvt_pk_bf16(v0[0], v0[1]); w.y = cvt_pk_bf16(v0[2], v0[3]); w.z = cvt_pk_bf16(v1[0], v1[1]); w.w = cvt_pk_bf16(v1[2], v1[3]);
                    *(u32x4*)(ab + ro * IN_N + bj * HALF) = w;
                    if (fo) { *(f32x4*)(fo + ro * fld + bj * HALF) = v0; *(f32x4*)(fo + ro * fld + bj * HALF + 4) = v1; } } }
    }
};

struct EpiSwi {
    static constexpr bool PERM = true, AFTER_DRAIN = false;
    bf16_t* H; int ldh; const PG8_LAS float* rstd;
    __device__ __forceinline__ void operator()(const f32x4 (&acc)[2][2][4][2], const Unit& u, int wr, int wc, int fr, int fq, int ui) const {
        const int row0 = u.pm * BM + wr * 64 + fr; bf16_t* hb = H + (size_t)row0 * ldh + u.pn * HALF + wc * 32 + 8 * fq;
#pragma unroll
        for (int ai = 0; ai < 2; ++ai)
#pragma unroll
            for (int m = 0; m < 4; ++m) { const float rs = rstd[ui * BM + wr * 64 + fr + ai * HALF + m * 16];
                const f32x4 g0 = acc[ai][0][m][0] * rs, g1 = acc[ai][0][m][1] * rs, u0 = acc[ai][1][m][0] * rs, u1 = acc[ai][1][m][1] * rs;
                u32x4 w; w.x = cvt_pk_bf16(silu_f(g0[0]) * u0[0], silu_f(g0[1]) * u0[1]); w.y = cvt_pk_bf16(silu_f(g0[2]) * u0[2], silu_f(g0[3]) * u0[3]);
                w.z = cvt_pk_bf16(silu_f(g1[0]) * u1[0], silu_f(g1[1]) * u1[1]); w.w = cvt_pk_bf16(silu_f(g1[2]) * u1[2], silu_f(g1[3]) * u1[3]);
                *(u32x4*)(hb + (size_t)(ai * HALF + m * 16) * ldh) = w; }
    }
};

struct EpiRes {
    static constexpr bool PERM = true, AFTER_DRAIN = false;
    const float* srcp; const float* srcs; float* dst; bf16_t* xb; float* rowsq;
    __device__ __forceinline__ void operator()(const f32x4 (&acc)[2][2][4][2], const Unit& u, int wr, int wc, int fr, int fq, int ui) const {
        const int row0 = u.pm * BM + wr * 64 + fr; const int c0 = u.pn * BM + wc * 32 + 8 * fq;
        const bool samp = (u.pm >= PROMPT_ROWS / BM);
        const float* sb = (samp ? srcs + (size_t)(row0 - PROMPT_ROWS) * 1024 : srcp + (size_t)row0 * 1024) + c0;
        float* db = dst + (size_t)row0 * 1024 + c0; bf16_t* xbb = xb + (size_t)row0 * 1024 + c0;
#pragma unroll
        for (int ai = 0; ai < 2; ++ai)
#pragma unroll
            for (int m = 0; m < 4; ++m) { const size_t ro = (size_t)(ai * HALF + m * 16) * 1024; float sq = 0.f;
#pragma unroll
                for (int bj = 0; bj < 2; ++bj) { const f32x4 s0 = *(const f32x4*)(sb + ro + bj * HALF), s1 = *(const f32x4*)(sb + ro + bj * HALF + 4);
                    const f32x4 v0 = s0 + acc[ai][bj][m][0], v1 = s1 + acc[ai][bj][m][1];
                    *(f32x4*)(db + ro + bj * HALF) = v0; *(f32x4*)(db + ro + bj * HALF + 4) = v1;
                    sq += (v0[0] * v0[0] + v0[1] * v0[1]) + (v0[2] * v0[2] + v0[3] * v0[3]) + (v1[0] * v1[0] + v1[1] * v1[1]) + (v1[2] * v1[2] + v1[3] * v1[3]);
                    u32x4 w; w.x = cvt_pk_bf16(v0[0], v0[1]); w.y = cvt_pk_bf16(v0[2], v0[3]); w.z = cvt_pk_bf16(v1[0], v1[1]); w.w = cvt_pk_bf16(v1[2], v1[3]);
                    *(u32x4*)(xbb + ro + bj * HALF) = w; }
                sq += __shfl_xor(sq, 16); sq += __shfl_xor(sq, 32);
                if (fq == 0) rowsq[(size_t)(row0 + ai * HALF + m * 16) * 16 + u.pn * 4 + wc] = sq;
                if (m & 1) asm volatile("" ::: "memory"); }
    }
};
template <class Epi, class Sched, bool ALIGN_EPI = false, bool SP2 = false>
__device__ __forceinline__ void gemm_phase(PG8_LAS unsigned char* lds, const Gemm g, const Sched& S, const Epi& E) {
    int tid_ = threadIdx.x; asm volatile("" : "+v"(tid_));
    const int tid = tid_, wid = __builtin_amdgcn_readfirstlane(tid >> 6), lane = tid & 63, wr = wid >> 2, wc = wid & 3, fr = lane & 15, fq = lane >> 4;
    const int K = g.K, nt = K / BK;
    unsigned voffA[2], voffB[2];
#pragma unroll
    for (int i = 0; i < 2; ++i) { int R, C; stage_rc(tid * 16 + i * 8192, R, C); const int Rb = Epi::PERM ? ((R & ~31) + perm32(R & 31)) : R;
        voffA[i] = (unsigned)(R * K + C) * 2u; voffB[i] = (unsigned)(Rb * K + C) * 2u; }
    const size_t kstep = (size_t)(BK * 2);
    const size_t hstep = (size_t)HALF * K * 2;
    const size_t tstep = 2 * hstep;
    const unsigned ldsw = (unsigned)wid * 1024u;
    const int aoff = lds_byte(wr * 64 + fr, fq * 8), boff = lds_byte(wc * 32 + fr, fq * 8);
#define PG8_SA(b, h) (((b) * 2 + (h)) * HTB)
#define PG8_SB(b, h) ((4 + (b) * 2 + (h)) * HTB)
#define PG8_STAGE(bufoff, gbase, voff) do { _Pragma("unroll") for (int _i = 0; _i < 2; ++_i) \
        __builtin_amdgcn_global_load_lds((const unsigned*)((const char*)(gbase) + (voff)[_i]), (PG8_LAS unsigned*)(lds + (bufoff) + ldsw + _i * 8192), 16, 0, 0); } while (0)
#define PG8_LDA(dst, b, h) do { _Pragma("unroll") for (int m = 0; m < 4; ++m) _Pragma("unroll") for (int k = 0; k < 2; ++k) dst[m][k] = *(const PG8_LAS bf16x8*)(lds + PG8_SA(b, h) + aoff + m * 2048 + k * 1024); } while (0)
#define PG8_LDB(dst, b, h) do { _Pragma("unroll") for (int n = 0; n < 2; ++n) _Pragma("unroll") for (int k = 0; k < 2; ++k) dst[n][k] = *(const PG8_LAS bf16x8*)(lds + PG8_SB(b, h) + boff + n * 2048 + k * 1024); } while (0)
#define PG8_MMA(ai, bj, At, Bt) do { __builtin_amdgcn_s_setprio(1); _Pragma("unroll") for (int m = 0; m < 4; ++m) _Pragma("unroll") for (int n = 0; n < 2; ++n) _Pragma("unroll") for (int k = 0; k < 2; ++k) \
        acc[ai][bj][m][n] = __builtin_amdgcn_mfma_f32_16x16x32_bf16(Bt[n][k], At[m][k], acc[ai][bj][m][n], 0, 0, 0); __builtin_amdgcn_s_setprio(0); } while (0)
#define PG8_WAIT_V(n) asm volatile("s_waitcnt vmcnt(" #n ")" ::: "memory")
#define PG8_WAIT_L(n) asm volatile("s_waitcnt lgkmcnt(" #n ")" ::: "memory")
#define PG8_BAR __builtin_amdgcn_s_barrier()
#define PG8_SCHED __builtin_amdgcn_sched_barrier(0)
    Unit cur, nxt; int ui = 0;
    if (!S.next(0, cur)) return;
    f32x4 acc[2][2][4][2];
#pragma unroll
    for (int a = 0; a < 2; ++a)
#pragma unroll
        for (int b = 0; b < 2; ++b)
#pragma unroll
            for (int m = 0; m < 4; ++m)
#pragma unroll
                for (int n = 0; n < 2; ++n) acc[a][b][m][n] = (f32x4){0.f, 0.f, 0.f, 0.f};
    bf16x8 At[4][2], B0[2][2], B1[2][2];
    const char* cA = (const char*)g.A + (size_t)cur.pm * tstep; const char* cB = (const char*)g.Bt + (size_t)cur.pn * tstep;
    S.a_ready(cur);
    if constexpr (SP2) {
        PG8_STAGE(PG8_SB(0, 0), cB, voffB); PG8_STAGE(PG8_SB(0, 1), cB + hstep, voffB); PG8_STAGE(PG8_SA(0, 0), cA, voffA); PG8_STAGE(PG8_SA(0, 1), cA + hstep, voffA);
        if (wr == 1) PG8_BAR;
        PG8_WAIT_V(2); PG8_BAR;
        PG8_STAGE(PG8_SB(1, 0), cB + kstep, voffB); PG8_STAGE(PG8_SA(1, 0), cA + kstep, voffA); PG8_STAGE(PG8_SB(1, 1), cB + hstep + kstep, voffB);
        PG8_WAIT_V(6); PG8_BAR;
    } else {
        PG8_STAGE(PG8_SB(0, 0), cB, voffB); PG8_STAGE(PG8_SA(0, 0), cA, voffA); PG8_STAGE(PG8_SB(0, 1), cB + hstep, voffB); PG8_STAGE(PG8_SA(0, 1), cA + hstep, voffA);
        if (wr == 1) PG8_BAR;
        PG8_WAIT_V(4); PG8_BAR;
        PG8_STAGE(PG8_SB(1, 0), cB + kstep, voffB); PG8_STAGE(PG8_SA(1, 0), cA + kstep, voffA); PG8_STAGE(PG8_SB(1, 1), cB + hstep + kstep, voffB);
        PG8_WAIT_V(6); PG8_BAR;
    }
    for (;;) {
        const bool has_next = S.next(ui + 1, nxt);
        const char* nA = has_next ? (const char*)g.A + (size_t)nxt.pm * tstep : cA; const char* nB = has_next ? (const char*)g.Bt + (size_t)nxt.pn * tstep : cB;
        for (int t = 0; t < nt; t += 2) {
            const bool last = (t == nt - 2);
            const char* a1 = cA + (size_t)(t + 1) * kstep;
            const char* a2 = last ? nA : cA + (size_t)(t + 2) * kstep; const char* b2 = last ? nB : cB + (size_t)(t + 2) * kstep;
            const char* a3 = a2 + kstep; const char* b3 = b2 + kstep;
            if (last && has_next) S.a_ready(nxt);
            if constexpr (SP2) {
            PG8_LDB(B0, 0, 0); PG8_LDB(B1, 0, 1); PG8_SCHED; PG8_LDA(At, 0, 0); PG8_STAGE(PG8_SA(1, 1), a1 + hstep, voffA);
            PG8_WAIT_V(8); PG8_WAIT_L(0); PG8_BAR; PG8_MMA(0, 0, At, B0); PG8_MMA(0, 1, At, B1); PG8_BAR; PG8_SCHED;
            PG8_LDA(At, 0, 1); PG8_STAGE(PG8_SB(0, 0), b2, voffB); PG8_STAGE(PG8_SB(0, 1), b2 + hstep, voffB); PG8_STAGE(PG8_SA(0, 0), a2, voffA);
            PG8_WAIT_V(8); PG8_WAIT_L(0); PG8_BAR; PG8_MMA(1, 0, At, B0); PG8_MMA(1, 1, At, B1); PG8_BAR; PG8_SCHED;
            PG8_LDB(B0, 1, 0); PG8_LDB(B1, 1, 1); PG8_SCHED; PG8_LDA(At, 1, 0); PG8_STAGE(PG8_SA(0, 1), a2 + hstep, voffA);
            PG8_WAIT_V(8); PG8_WAIT_L(0); PG8_BAR; PG8_MMA(0, 0, At, B0); PG8_MMA(0, 1, At, B1); PG8_BAR; PG8_SCHED;
            PG8_LDA(At, 1, 1); PG8_STAGE(PG8_SB(1, 0), b3, voffB); PG8_STAGE(PG8_SB(1, 1), b3 + hstep, voffB); PG8_STAGE(PG8_SA(1, 0), a3, voffA);
            PG8_WAIT_V(8); PG8_WAIT_L(0); PG8_BAR; PG8_MMA(1, 0, At, B0); PG8_MMA(1, 1, At, B1); PG8_BAR; PG8_SCHED;
            } else {
            PG8_LDB(B0, 0, 0); PG8_SCHED; PG8_LDA(At, 0, 0); PG8_STAGE(PG8_SA(1, 1), a1 + hstep, voffA);
            PG8_WAIT_L(8); PG8_BAR; PG8_WAIT_L(0); PG8_MMA(0, 0, At, B0); PG8_BAR; PG8_SCHED;
            PG8_LDB(B1, 0, 1); PG8_STAGE(PG8_SB(0, 0), b2, voffB);
            PG8_BAR; PG8_WAIT_L(0); PG8_MMA(0, 1, At, B1); PG8_BAR;
            PG8_LDA(At, 0, 1); PG8_STAGE(PG8_SA(0, 0), a2, voffA);
            PG8_BAR; PG8_WAIT_L(0); PG8_MMA(1, 0, At, B0); PG8_BAR; PG8_SCHED;
            PG8_STAGE(PG8_SB(0, 1), b2 + hstep, voffB);
            PG8_WAIT_V(6); PG8_BAR; PG8_MMA(1, 1, At, B1); PG8_BAR;
            PG8_LDB(B0, 1, 0); PG8_SCHED; PG8_LDA(At, 1, 0); PG8_STAGE(PG8_SA(0, 1), a2 + hstep, voffA);
            PG8_WAIT_L(8); PG8_BAR; PG8_WAIT_L(0); PG8_MMA(0, 0, At, B0); PG8_BAR; PG8_SCHED;
            PG8_LDB(B1, 1, 1); PG8_STAGE(PG8_SB(1, 0), b3, voffB);
            PG8_BAR; PG8_WAIT_L(0); PG8_MMA(0, 1, At, B1); PG8_BAR;
            PG8_LDA(At, 1, 1); PG8_STAGE(PG8_SA(1, 0), a3, voffA);
            PG8_BAR; PG8_WAIT_L(0); PG8_MMA(1, 0, At, B0); PG8_BAR; PG8_SCHED;
            PG8_STAGE(PG8_SB(1, 1), b3 + hstep, voffB);
            PG8_WAIT_V(6); PG8_BAR; PG8_MMA(1, 1, At, B1); PG8_BAR;
            }
        }
        if constexpr (ALIGN_EPI) { if (wr == 0) PG8_BAR; }
        if constexpr (!Epi::AFTER_DRAIN) { E(acc, cur, wr, wc, fr, fq, ui); S.done(cur); }
        if (!has_next) break;
#pragma unroll
        for (int a = 0; a < 2; ++a)
#pragma unroll
            for (int b = 0; b < 2; ++b)
#pragma unroll
                for (int m = 0; m < 4; ++m)
#pragma unroll
                    for (int n = 0; n < 2; ++n) acc[a][b][m][n] = (f32x4){0.f, 0.f, 0.f, 0.f};
        cur = nxt; cA = nA; cB = nB; ++ui;
        if constexpr (ALIGN_EPI) { if (wr == 1) PG8_BAR; }
    }
    PG8_WAIT_V(0);
    if constexpr (!ALIGN_EPI) { if (wr == 0) PG8_BAR; }
    PG8_BAR;
    if constexpr (Epi::AFTER_DRAIN) { E.fused(acc, cur, wr, wc, fr, fq, lds, wid, lane); S.done(cur); }
#undef PG8_SA
#undef PG8_SB
#undef PG8_STAGE
#undef PG8_LDA
#undef PG8_LDB
#undef PG8_MMA
#undef PG8_WAIT_V
#undef PG8_WAIT_L
#undef PG8_BAR
#undef PG8_SCHED
}
}
constexpr int NWAVES = 8;
constexpr int DM = 1024, SEQ = 16384, DEPTH = 4, DECB = 16, DECS = 64, PAST = 4096;
constexpr int M = SEQ + DECB * DECS;
constexpr int NIN = pg8::IN_N;
constexpr int DFF = 2816, NF1 = 2 * DFF;
constexpr int WIN_ORIG = 3088;
constexpr int NCHUNK = M / 64;
constexpr int NPCH = SEQ / 64;
constexpr float RMS_EPS = 1e-6f;
constexpr size_t OY = 0, OK_P = 17825792, OV_P = 51380224, OG_P = 84934656, OK_S = 85065728, OV_S = 87162880, OG_S = 89260032, OUT_TOTAL = 91357184;

constexpr size_t MiB = 1u << 20;
constexpr size_t WS_CTL = 0, CTL_ZERO_BYTES = 1 * MiB;
constexpr size_t WS_W = 2 * MiB, W_LAYER = 25 * MiB;
constexpr size_t WO_IN = 0, WO_OUT = 6815744, WO_F1 = WO_OUT + 2 * MiB, WO_F2 = WO_F1 + 11 * MiB;
static_assert(WO_F2 + (size_t)DM * DFF * 2 == W_LAYER, "weight map");
constexpr size_t WS_X = 104 * MiB;
constexpr size_t WS_XN = 172 * MiB;
constexpr size_t WS_ACT = 206 * MiB;
constexpr size_t WS_MIX = 317 * MiB;
constexpr size_t WS_H = 351 * MiB;
constexpr size_t WS_LOGA = 445 * MiB;
constexpr size_t WS_U = 462 * MiB;
constexpr size_t WS_D = 496 * MiB;
constexpr size_t WS_SC = 497 * MiB;
constexpr size_t WS_OI = 529 * MiB;
constexpr size_t WS_QT = 563 * MiB;
constexpr size_t WS_RSQ = 576 * MiB;
constexpr size_t WS_END = 588 * MiB;
static_assert(WS_X + (size_t)M * DM * 4 <= WS_XN && WS_XN + (size_t)M * DM * 2 <= WS_ACT && WS_ACT + (size_t)M * NIN * 2 <= WS_MIX && WS_MIX + (size_t)M * DM * 2 <= WS_H &&
              WS_H + (size_t)M * DFF * 2 <= WS_LOGA && WS_LOGA + (size_t)M * 256 * 4 <= WS_U && WS_U + (size_t)NCHUNK * 4 * 64 * 128 * 4 <= WS_D && WS_D + (size_t)NCHUNK * 4 * 64 * 4 <= WS_SC &&
              WS_SC + (size_t)NPCH * 4 * 64 * 128 * 4 <= WS_OI && WS_OI + (size_t)M * 512 * 4 <= WS_QT && WS_QT + (size_t)M * 256 * 2 <= WS_RSQ && WS_RSQ + (size_t)9 * M * 64 <= WS_END, "d_ws map");
constexpr int CW_TMO = 0, CW_CODE = 1;
constexpr int CW_BAR = 4096;
constexpr int CW_QUEUE = 16384;

constexpr int RING_OFF = 0, RING_BYTES = 131072;
constexpr int LDSCTL_OFF = RING_BYTES, MISC_OFF = LDSCTL_OFF + 320;
constexpr int LDS_BYTES = 147456;

#define GAS __attribute__((address_space(1)))
#define LAS __attribute__((address_space(3)))
typedef unsigned short bf16;
typedef unsigned v4u __attribute__((ext_vector_type(4)));
typedef unsigned v2u __attribute__((ext_vector_type(2)));
typedef float f32x4 __attribute__((ext_vector_type(4)));
typedef float f32x16 __attribute__((ext_vector_type(16)));
typedef short bf16x8 __attribute__((ext_vector_type(8)));
typedef short s16x4 __attribute__((ext_vector_type(4)));
typedef GAS unsigned gu32;
#define RLX_AGENT __ATOMIC_RELAXED, __HIP_MEMORY_SCOPE_AGENT
#define LDS_WAIT() asm volatile("s_waitcnt lgkmcnt(0)" ::: "memory")
#define VM_WAIT() asm volatile("s_waitcnt vmcnt(0)" ::: "memory")
__device__ __forceinline__ unsigned f2bf(float f) { unsigned u = __builtin_bit_cast(unsigned, f); return (u + 0x7fffu + ((u >> 16) & 1u)) >> 16; }
__device__ __forceinline__ unsigned pk2(float lo, float hi) { return f2bf(lo) | (f2bf(hi) << 16); }
__device__ __forceinline__ float bf2f(unsigned short b) { return __builtin_bit_cast(float, (unsigned)b << 16); }
__device__ __forceinline__ float wave_sum(float v) {
#pragma unroll
    for (int o = 1; o < 64; o <<= 1) v += __shfl_xor(v, o);
    return v;
}
#define XB_TMO      128
#define XB_XCNT(j)  (256  + 64 * (j))
#define XB_XSUB(j)  (1280 + 64 * (j))
#define XB_XGEN(j)  (2304 + 64 * (j))
#define XB_TOP      3328
#define XB_TOPGEN   3392
#define XCD_BAR_WORDS 3456
#define XB_SPIN_CAP (1u << 18)

__device__ __forceinline__ unsigned xb_ld(unsigned* p)              { return __hip_atomic_load(p, __ATOMIC_RELAXED, __HIP_MEMORY_SCOPE_AGENT); }
__device__ __forceinline__ unsigned xb_add(unsigned* p, unsigned v) { return __hip_atomic_fetch_add(p, v, __ATOMIC_RELAXED, __HIP_MEMORY_SCOPE_AGENT); }
__device__ __forceinline__ unsigned xb_xcc_id() { return (unsigned)__builtin_amdgcn_s_getreg((3 << 11) | 20) & 0xFu; }
#define XB_SPIN(cond, bar) do { unsigned _sp = 0; while (cond) { __builtin_amdgcn_s_sleep(1); \
    if ((++_sp & 255u) == 0u) { if (xb_ld(&(bar)[XB_TMO])) break; if (_sp > XB_SPIN_CAP) { atomicAdd(&(bar)[XB_TMO], 1u); break; } } } } while (0)

struct XcdBarrier {
    unsigned* bar; unsigned x;
    volatile LAS unsigned* st;
};

__device__ __forceinline__ XcdBarrier xcd_barrier_post(unsigned* bar, volatile LAS unsigned* st) {
    XcdBarrier b; b.bar = bar; b.x = xb_xcc_id(); b.st = st;
    if (threadIdx.x == 0) (void)xb_add(&bar[XB_XCNT(b.x)], 1u);
    return b;
}
__device__ __forceinline__ void xcd_barrier_complete(unsigned* bar, unsigned x, unsigned& nloc, unsigned& nx) {
    const unsigned G = gridDim.x * gridDim.y * gridDim.z;
    unsigned sum, cnt, mine, sp = 0u;
    for (;;) {
        sum = 0u; cnt = 0u; mine = 0u;
#pragma unroll
        for (unsigned j = 0; j < 16; ++j) { const unsigned c = xb_ld(&bar[XB_XCNT(j)]); sum += c; cnt += (c > 0u) ? 1u : 0u; mine = (j == x) ? c : mine; }
        if (sum == G) break;
        __builtin_amdgcn_s_sleep(1);
        if ((++sp & 255u) == 0u) { if (xb_ld(&bar[XB_TMO])) break; if (sp > XB_SPIN_CAP) { atomicAdd(&bar[XB_TMO], 1u); break; } }
    }
    nloc = mine > 0u ? mine : 1u; nx = cnt > 0u ? cnt : 1u;
}

__device__ __forceinline__ void xcd_barrier(const XcdBarrier& b) {
    asm volatile("s_waitcnt vmcnt(0)" ::: "memory");
    __syncthreads();
    if (threadIdx.x == 0) {
        unsigned* bar = b.bar;
        __builtin_amdgcn_s_waitcnt(0);
        unsigned nloc = b.st[0], nx = b.st[1];
        if (nloc == 0u) { xcd_barrier_complete(bar, b.x, nloc, nx); b.st[0] = nloc; b.st[1] = nx; }
        const unsigned old = xb_add(&bar[XB_XSUB(b.x)], 1u);
        const unsigned gen = old / nloc;
        if (old + 1u == (gen + 1u) * nloc) {
            __builtin_amdgcn_fence(__ATOMIC_RELEASE, "agent");
            asm volatile("s_waitcnt vmcnt(0)" ::: "memory");
            const unsigned og = xb_add(&bar[XB_TOP], 1u);
            const unsigned tg = og / nx;
            if (og + 1u == (tg + 1u) * nx) xb_add(&bar[XB_TOPGEN], 1u);
            else XB_SPIN(xb_ld(&bar[XB_TOPGEN]) == tg, bar);
            __builtin_amdgcn_fence(__ATOMIC_ACQUIRE, "agent");
            xb_add(&bar[XB_XGEN(b.x)], 1u);
            asm volatile("s_waitcnt vmcnt(0)" ::: "memory");
        } else {
            XB_SPIN(xb_ld(&bar[XB_XGEN(b.x)]) == gen, bar);
            __builtin_amdgcn_fence(__ATOMIC_ACQUIRE, "agent");
            asm volatile("s_waitcnt vmcnt(0)" ::: "memory");
        }
    }
    __syncthreads();
}
struct Frame {
    LAS unsigned char* lds;
};
__device__ __forceinline__ int grid_n() { return (int)gridDim.x; }
__device__ __forceinline__ int vcu_id() { const int G = (int)gridDim.x, bx = (int)blockIdx.x; return (G % 8 == 0) ? (bx % 8) * (G / 8) + bx / 8 : bx; }
__device__ __forceinline__ int fresh_tid() { int t = threadIdx.x; asm volatile("" : "+v"(t)); return t; }

__device__ __forceinline__ void tr_store(LAS float* scr, bf16* WT, int K, int dstrow0, int k0, int lane) {
    LDS_WAIT(); asm volatile("" ::: "memory");
    const int c = lane & 7;
#pragma unroll
    for (int j = 0; j < 4; ++j) { const int n = (lane >> 3) + 8 * j; const LAS float* s = scr + (8 * c) * 33 + n;
        v4u o; o.x = pk2(s[0 * 33], s[1 * 33]); o.y = pk2(s[2 * 33], s[3 * 33]); o.z = pk2(s[4 * 33], s[5 * 33]); o.w = pk2(s[6 * 33], s[7 * 33]);
        *(GAS v4u*)(WT + (size_t)(dstrow0 + n) * K + k0 + 8 * c) = o; }
    LDS_WAIT(); asm volatile("" ::: "memory");
}
__device__ __forceinline__ void tr_item(const float* W, int ld, int K, int srccol0, bf16* WT, int dstrow0, int k0, LAS float* scr, int lane, const float* gk) {
#pragma unroll 16
    for (int i = 0; i < 32; ++i) { const int kk = 2 * i + (lane >> 5); float v = W[(size_t)(k0 + kk) * ld + srccol0 + (lane & 31)]; if (gk) v *= gk[k0 + kk]; scr[kk * 33 + (lane & 31)] = v; }
    tr_store(scr, WT, K, dstrow0, k0, lane);
}
__device__ __forceinline__ void tr_item_z(const float* Win, const float* a2, int n0z, bf16* WT, int k0, LAS float* scr, int lane, const float* gk) {
    float av[16];
#pragma unroll
    for (int r = 0; r < 16; ++r) av[r] = a2[r * 256 + n0z + (lane & 31)];
#pragma unroll 8
    for (int i = 0; i < 32; ++i) { const int kk = 2 * i + (lane >> 5); const float* wr_ = Win + (size_t)(k0 + kk) * WIN_ORIG + 1536; float s = 0.f;
#pragma unroll
        for (int r = 0; r < 16; ++r) s = fmaf(wr_[r], av[r], s);
        scr[kk * 33 + (lane & 31)] = s * gk[k0 + kk]; }
    tr_store(scr, WT, DM, 512 + n0z, k0, lane);
}

struct Args { const float* in[18]; float* out; unsigned char* ws; };
constexpr int PTAB_OFF = MISC_OFF + 128;
__device__ __forceinline__ const float* inp(const Frame& F, int i) {
    const volatile LAS unsigned* t = (const volatile LAS unsigned*)(F.lds + PTAB_OFF) + 2 * i;
    const unsigned lo = __builtin_amdgcn_readfirstlane(t[0]), hi = __builtin_amdgcn_readfirstlane(t[1]);
    return (const float*)(((unsigned long long)hi << 32) | lo);
}
__device__ __forceinline__ float* outp(const Frame& F) { return (float*)inp(F, 18); }
__device__ __forceinline__ unsigned char* wsp(const Frame& F) { return (unsigned char*)inp(F, 19); }

__device__ __forceinline__ void p0_prologue(Frame& F) {
    const int tid_ = fresh_tid(), lane_ = tid_ & 63, wave_ = __builtin_amdgcn_readfirstlane(tid_ >> 6);
    LAS float* scr = (LAS float*)(F.lds + RING_OFF + wave_ * 16384);
    const int gw = vcu_id() * NWAVES + wave_, NGW = grid_n() * NWAVES;
    constexpr int I_IN = 16 * 104, I_OUT = 16 * 32, I_F1 = 16 * 176, I_F2 = 44 * 32, I_L = I_IN + I_OUT + I_F1 + I_F2;
    for (int it = gw; it < DEPTH * I_L; it += NGW) {
        const int l = it / I_L; int r = it % I_L;
        unsigned char* wl = wsp(F) + WS_W + (size_t)l * W_LAYER;
        if (r < I_IN) { const int kb = r / 104, nb = r % 104, n0 = 32 * nb; const float* W = inp(F, 5) + (size_t)l * DM * WIN_ORIG;
            if (n0 >= 512 && n0 < 768) tr_item_z(W, inp(F, 6) + (size_t)l * 16 * 256, n0 - 512, (bf16*)(wl + WO_IN), 64 * kb, scr, lane_, inp(F, 12) + (size_t)l * DM);
            else { const int src = n0 < 512 ? n0 : (n0 < 1792 ? n0 - 256 : n0 - 240); tr_item(W, WIN_ORIG, DM, src, (bf16*)(wl + WO_IN), n0, 64 * kb, scr, lane_, inp(F, 12) + (size_t)l * DM); }
            continue; }
        r -= I_IN;
        if (r < I_OUT) { const int kb = r / 32, nb = r % 32; tr_item(inp(F, 11) + (size_t)l * DM * DM, DM, DM, 32 * nb, (bf16*)(wl + WO_OUT), 32 * nb, 64 * kb, scr, lane_, nullptr); continue; }
        r -= I_OUT;
        if (r < I_F1) { const int kb = r / 176, nb = r % 176, n0 = 32 * nb, pn = n0 >> 8, j = n0 & 255; const int src = j < 128 ? 128 * pn + j : DFF + 128 * pn + (j - 128);
            tr_item(inp(F, 14) + (size_t)l * DM * NF1, NF1, DM, src, (bf16*)(wl + WO_F1), n0, 64 * kb, scr, lane_, inp(F, 13) + (size_t)l * DM); continue; }
        r -= I_F1;
        { const int kb = r / 32, nb = r % 32; tr_item(inp(F, 15) + (size_t)l * DFF * DM, DM, DFF, 32 * nb, (bf16*)(wl + WO_F2), 32 * nb, 64 * kb, scr, lane_, nullptr); }
    }
}

__device__ __forceinline__ void rows_to_bf16_sq(Frame& F, const float* srcp, const float* srcs, bf16* XB, float* rowsq) {
    const int tid_ = fresh_tid(), lane_ = tid_ & 63, wave_ = __builtin_amdgcn_readfirstlane(tid_ >> 6);
    const int gw = vcu_id() * NWAVES + wave_, NGW = grid_n() * NWAVES;
    for (int m = gw; m < M; m += NGW) {
        const float* xrow = m < SEQ ? srcp + (size_t)m * DM : srcs + (size_t)(m - SEQ) * DM;
        const GAS f32x4* xr = (const GAS f32x4*)xrow + lane_;
        f32x4 v[4]; float s = 0.f;
#pragma unroll
        for (int j = 0; j < 4; ++j) { v[j] = xr[64 * j]; s += (v[j].x * v[j].x + v[j].y * v[j].y) + (v[j].z * v[j].z + v[j].w * v[j].w); }
        s = wave_sum(s);
        GAS unsigned long long* o8 = (GAS unsigned long long*)(XB + (size_t)m * DM) + lane_;
#pragma unroll
        for (int j = 0; j < 4; ++j) o8[64 * j] = (unsigned long long)pk2(v[j].x, v[j].y) | ((unsigned long long)pk2(v[j].z, v[j].w) << 32);
        if (lane_ < 16) rowsq[(size_t)m * 16 + lane_] = lane_ == 0 ? s : 0.f;
    }
}
__device__ __forceinline__ void norm_rows_f32(Frame& F, const float* src, const float* g, float* out) {
    const int tid_ = fresh_tid(), lane_ = tid_ & 63, wave_ = __builtin_amdgcn_readfirstlane(tid_ >> 6);
    const int gw = vcu_id() * NWAVES + wave_, NGW = grid_n() * NWAVES;
    f32x4 gv[4];
#pragma unroll
    for (int j = 0; j < 4; ++j) gv[j] = ((const GAS f32x4*)g)[lane_ + 64 * j];
    for (int m = gw; m < M; m += NGW) {
        const GAS f32x4* xr = (const GAS f32x4*)(src + (size_t)m * DM) + lane_;
        f32x4 v[4]; float s = 0.f;
#pragma unroll
        for (int j = 0; j < 4; ++j) { v[j] = xr[64 * j]; s += (v[j].x * v[j].x + v[j].y * v[j].y) + (v[j].z * v[j].z + v[j].w * v[j].w); }
        const float rstd = 1.f / sqrtf(wave_sum(s) * (1.f / DM) + RMS_EPS);
        GAS f32x4* o = (GAS f32x4*)(out + (size_t)m * DM) + lane_;
#pragma unroll
        for (int j = 0; j < 4; ++j) o[64 * j] = v[j] * rstd * gv[j];
    }
}

constexpr int RSTD_OFF = MISC_OFF + 512;
static_assert(RSTD_OFF + 8 * 256 * 4 <= LDS_BYTES, "rstd table");
__device__ __forceinline__ void rstd_prepass(Frame& F, const pg8::StaticOrder& S, const float* rsq) {
    const int tid_ = fresh_tid(); LAS float* tab = (LAS float*)(F.lds + RSTD_OFF);
    for (int idx = tid_; idx < 8 * 256; idx += NWAVES * 64) { pg8::Unit u; if (!S.next(idx >> 8, u)) break; tab[idx] = pg8::row_rstd(rsq, u.pm * 256 + (idx & 255)); }
    __syncthreads();
}

namespace att {
typedef float f32x8 __attribute__((ext_vector_type(8)));
typedef unsigned u32x4 __attribute__((ext_vector_type(4)));
constexpr float SCALE = 0.125f, THR = 8.f;
constexpr int SHM_V = 16384, SHM_K = 16384;
constexpr int OFF_V = 0, OFF_K = 2 * SHM_V;
constexpr int RK = 0, RV = 3 * SHM_K;
constexpr int OFF_WS = 6 * SHM_K, OFF_TAB = OFF_WS + 2048, TAB_N = 384, OFF_LAM = OFF_TAB + 4 * TAB_N * 4, OFF_G3 = OFF_LAM + 256, OFF_END = OFF_G3 + 1024;
static_assert(OFF_END <= RING_BYTES, "attention LDS map");
#define KSWZ(row, colB) ((row) * 256 + ((colB) ^ (((row) & 7) << 4)))
#define SBAR() __builtin_amdgcn_sched_barrier(0)
__device__ __forceinline__ int crow(int r, int hi) { return (r & 3) + 8 * (r >> 2) + 4 * hi; }
__device__ __forceinline__ unsigned cvtpk(float lo, float hi) { unsigned r; asm volatile("v_cvt_pk_bf16_f32 %0, %1, %2" : "=v"(r) : "v"(lo), "v"(hi)); return r; }
template <bool F32> struct Stage;
template <> struct Stage<false> { using E = bf16; using T = bf16x8;
  __device__ static __forceinline__ T ld8(const E* p) { return *reinterpret_cast<const bf16x8*>(p); }
  __device__ static __forceinline__ bf16x8 tobf(T x) { return x; } };
template <> struct Stage<true> { using E = float; using T = f32x8;
  __device__ static __forceinline__ T ld8(const E* p) { return *reinterpret_cast<const f32x8*>(p); }
  __device__ static __forceinline__ bf16x8 tobf(T x) { u32x4 w = {cvtpk(x[0], x[1]), cvtpk(x[2], x[3]), cvtpk(x[4], x[5]), cvtpk(x[6], x[7])}; return __builtin_bit_cast(bf16x8, w); } };

__device__ __forceinline__ void partialSM(f32x16& p0, f32x16& p1, float& m_reg, float& mn, float& alpha) {
  constexpr float C = SCALE * 1.4426950408889634f;
  float pmax = p0[0];
#pragma unroll
  for (int r = 1; r < 16; ++r) pmax = fmaxf(pmax, p0[r]);
#pragma unroll
  for (int r = 0; r < 16; ++r) pmax = fmaxf(pmax, p1[r]);
  { auto rr = __builtin_amdgcn_permlane32_swap(__float_as_uint(pmax), __float_as_uint(pmax), false, false);
    pmax = fmaxf(__uint_as_float(rr[0]), __uint_as_float(rr[1])); }
  if (__builtin_expect(__all(pmax - m_reg <= THR / SCALE), 1)) { mn = m_reg; alpha = 1.f; }
  else { mn = fmaxf(m_reg, pmax); alpha = __builtin_amdgcn_exp2f((m_reg - mn) * C); m_reg = mn; }
  float mnC = -mn * C;
#pragma unroll
  for (int r = 0; r < 16; ++r) p0[r] = fmaf(p0[r], C, mnC);
#pragma unroll
  for (int r = 0; r < 16; ++r) p1[r] = fmaf(p1[r], C, mnC);
#pragma unroll
  for (int r = 0; r < 16; ++r) p0[r] = __builtin_amdgcn_exp2f(p0[r]);
}
__device__ __forceinline__ void finishSM(f32x16& p0, f32x16& p1, float alpha, float& l_reg, bf16x8& pa0, bf16x8& pa1, bf16x8& pa2, bf16x8& pa3) {
#pragma unroll
  for (int r = 0; r < 16; ++r) p1[r] = __builtin_amdgcn_exp2f(p1[r]);
  float ps = 0;
#pragma unroll
  for (int r = 0; r < 16; ++r) ps += p0[r];
#pragma unroll
  for (int r = 0; r < 16; ++r) ps += p1[r];
  { auto rr = __builtin_amdgcn_permlane32_swap(__float_as_uint(ps), __float_as_uint(ps), false, false);
    ps = __uint_as_float(rr[0]) + __uint_as_float(rr[1]); }
  l_reg = l_reg * alpha + ps;
#define PK4(P, BASE, OUT) do { unsigned a0 = cvtpk(P[BASE + 0], P[BASE + 1]), a1 = cvtpk(P[BASE + 2], P[BASE + 3]);   \
    unsigned b0 = cvtpk(P[BASE + 4], P[BASE + 5]), b1 = cvtpk(P[BASE + 6], P[BASE + 7]);                              \
    auto r0 = __builtin_amdgcn_permlane32_swap(a0, b0, false, false); auto r1 = __builtin_amdgcn_permlane32_swap(a1, b1, false, false); \
    u32x4 w = {r0[0], r1[0], r0[1], r1[1]}; OUT = __builtin_bit_cast(bf16x8, w); } while (0)
  PK4(p0, 0, pa0); PK4(p0, 8, pa1); PK4(p1, 0, pa2); PK4(p1, 8, pa3);
#undef PK4
}
template <bool QL>
__device__ __forceinline__ void qkt(f32x16& p0, f32x16& p1, const LAS char* Ks, const bf16x8* qr, const LAS char* ql, int r32, int hi, int g) {
  p0 = f32x16{}; p1 = f32x16{};
#pragma unroll
  for (int d0 = 0; d0 < 4; ++d0) { const int cb = ((g * 4 + d0) * 16 + hi * 8) * 2;
    const bf16x8 b0 = *(const LAS bf16x8*)(Ks + KSWZ(r32, cb));
    const bf16x8 b1 = *(const LAS bf16x8*)(Ks + KSWZ(32 + r32, cb));
    bf16x8 q; if constexpr (QL) q = *(const LAS bf16x8*)(ql + d0 * 1024); else q = qr[d0];
    p0 = __builtin_amdgcn_mfma_f32_32x32x16_bf16(b0, q, p0, 0, 0, 0);
    p1 = __builtin_amdgcn_mfma_f32_32x32x16_bf16(b1, q, p1, 0, 0, 0); }
}
__device__ __forceinline__ int v_st(int k, int c) { const int kk = (k & ~0xC) | ((k & 4) << 1) | ((k & 8) >> 1); return ((kk >> 3) * 4 + (c >> 5)) * 512 + ((kk & 7) * 32 + (c & 31)) * 2; }
__device__ __forceinline__ int v_rd_base(int lane) { return ((lane & 3) << 3) | (((lane >> 2) & 3) << 6) | (((lane >> 4) & 1) << 5) | (((lane >> 5) & 1) << 8); }
constexpr int v_rd_off(int d0, int ks, int half) { return d0 * 512 + ks * 4096 + half * 2048; }
typedef short v4i16_t __attribute__((ext_vector_type(4)));
template <int OFF> __device__ __forceinline__ s16x4 tr_read(const LAS char* vb) {
  return __builtin_bit_cast(s16x4, __builtin_amdgcn_ds_read_tr16_b64_v4i16((LAS v4i16_t*)(vb + OFF)));
}
template <int D0> __device__ __forceinline__ void pv_one(f32x16& od, const LAS char* vb, bf16x8 pa0, bf16x8 pa1, bf16x8 pa2, bf16x8 pa3) {
  const s16x4 l0 = tr_read<v_rd_off(D0, 0, 0)>(vb), h0 = tr_read<v_rd_off(D0, 0, 1)>(vb), l1 = tr_read<v_rd_off(D0, 1, 0)>(vb), h1 = tr_read<v_rd_off(D0, 1, 1)>(vb);
  const s16x4 l2 = tr_read<v_rd_off(D0, 2, 0)>(vb), h2 = tr_read<v_rd_off(D0, 2, 1)>(vb), l3 = tr_read<v_rd_off(D0, 3, 0)>(vb), h3 = tr_read<v_rd_off(D0, 3, 1)>(vb);
#define PK(L, H) (bf16x8){L[0], L[1], L[2], L[3], H[0], H[1], H[2], H[3]}
  od = __builtin_amdgcn_mfma_f32_32x32x16_bf16(pa0, PK(l0, h0), od, 0, 0, 0);
  od = __builtin_amdgcn_mfma_f32_32x32x16_bf16(pa1, PK(l1, h1), od, 0, 0, 0);
  od = __builtin_amdgcn_mfma_f32_32x32x16_bf16(pa2, PK(l2, h2), od, 0, 0, 0);
  od = __builtin_amdgcn_mfma_f32_32x32x16_bf16(pa3, PK(l3, h3), od, 0, 0, 0);
#undef PK
}
__device__ __forceinline__ void pv_d0(f32x16* o, const LAS char* vb, bf16x8 pa0, bf16x8 pa1, bf16x8 pa2, bf16x8 pa3) {
  pv_one<0>(o[0], vb, pa0, pa1, pa2, pa3); pv_one<1>(o[1], vb, pa0, pa1, pa2, pa3); pv_one<2>(o[2], vb, pa0, pa1, pa2, pa3); pv_one<3>(o[3], vb, pa0, pa1, pa2, pa3);
}

__device__ __forceinline__ int t5_bucket(int rel) {
  const int ret = rel > 0 ? 16 : 0; const int n = rel < 0 ? -rel : rel;
  if (n < 8) return ret + n;
  int large = 8 + (31 - __builtin_clz((unsigned)(n * n))) - 6; if (large > 15) large = 15;
  return ret + large;
}
__device__ __forceinline__ void attn_setup(LAS unsigned char* lds, const float* rel_bias, const float* lamp  , int layer) {
  const int tid = fresh_tid();
  LAS float* tab = (LAS float*)(lds + OFF_TAB);
  for (int e = tid; e < 4 * TAB_N; e += 512) { const int h = e / TAB_N, idx = e % TAB_N, rel = idx - 255;
    tab[e] = (rel_bias[t5_bucket(rel) * 4 + h] - rel_bias[15 * 4 + h]) * (1.f / SCALE); }
  if (tid < 64) { const float a = lamp[tid] * lamp[64 + tid], b = lamp[128 + tid] * lamp[192 + tid];
    const float sa = wave_sum(a), sb = wave_sum(b);
    if (tid == 0) { const float lam_init = 0.8f - 0.6f * expf(-0.3f * (float)layer);
      ((LAS float*)(lds + OFF_LAM))[0] = expf(sa) - expf(sb) + lam_init; ((LAS float*)(lds + OFF_LAM))[1] = 1.f - lam_init; } }
  __syncthreads();
}


__device__ __forceinline__ void glds16(const void* gsrc, unsigned lds_dst) { unsigned keep;
  asm volatile("s_mov_b32 %0, m0\n\ts_mov_b32 m0, %2\n\ts_nop 0\n\tglobal_load_lds_dwordx4 %1, off\n\ts_mov_b32 m0, %0" : "=&s"(keep) : "v"(gsrc), "s"(lds_dst) : "memory"); }
__device__ __forceinline__ void attn_unit_prompt(LAS unsigned char* lds, const bf16* Kg, const bf16* Vg, const bf16* Qrow0, bf16* Orow0, int NT, int qpos0, int h, const float* gnorm) {
  constexpr int LDK = 3328;
  const int tid = fresh_tid(), wid = __builtin_amdgcn_readfirstlane(tid >> 6), lane = tid & 63, r32 = lane & 31, hi = lane >> 5;
  const int g = wid >> 2, rb = wid & 3;
  LAS char* K_lds = (LAS char*)lds + RK; LAS char* V_lds = (LAS char*)lds + RV;
  LAS float* wsf = (LAS float*)(lds + OFF_WS) + wid * 64; LAS float* li_l = wsf; LAS float* al_l = wsf + 32;
  const LAS float* tab = (const LAS float*)(lds + OFF_TAB) + h * TAB_N;
  float m_reg = -1e30f, l_reg = 0; f32x16 o[4] = {}; bf16x8 qr[4];
  const bf16* Qw = Qrow0 + (size_t)(rb * 32 + r32) * 3328 + g * 64 + hi * 8;
#pragma unroll
  for (int d0 = 0; d0 < 4; ++d0) qr[d0] = *reinterpret_cast<const bf16x8*>(Qw + d0 * 16);
  const int qpos = qpos0 + rb * 32 + r32;
  unsigned kso[2], vso[2];
#pragma unroll
  for (int p = 0; p < 2; ++p) { const int row = 8 * wid + 4 * p + (lane >> 4); kso[p] = (unsigned)(row * LDK * 2 + (((lane & 15) ^ (row & 7)) << 4));
    const int kk = wid * 8 + ((lane & 31) >> 2), k = (kk & ~0xC) | ((kk & 4) << 1) | ((kk & 8) >> 1), c = (2 * p + (lane >> 5)) * 32 + (lane & 3) * 8; vso[p] = (unsigned)((k * LDK + c) * 2); }
  const int pw = wid * 2048; const unsigned kl0 = (unsigned)(uintptr_t)K_lds, vl0 = (unsigned)(uintptr_t)V_lds;
#define DMA_K(t, so) do { const char* kb_ = (const char*)(Kg + (size_t)(t) * 64 * LDK); _Pragma("unroll") for (int p_ = 0; p_ < 2; ++p_) \
    glds16(kb_ + kso[p_], (unsigned)__builtin_amdgcn_readfirstlane((int)(kl0 + (unsigned)((so) + pw + p_ * 1024)))); } while (0)
#define DMA_V(t, so) do { const char* vb_ = (const char*)(Vg + (size_t)(t) * 64 * LDK); _Pragma("unroll") for (int p_ = 0; p_ < 2; ++p_) \
    glds16(vb_ + vso[p_], (unsigned)__builtin_amdgcn_readfirstlane((int)(vl0 + (unsigned)((so) + pw + p_ * 1024)))); } while (0)
#define WAITBAR(j) do { if ((j) + 2 < NT) asm volatile("s_waitcnt vmcnt(4)\n\ts_barrier" ::: "memory"); else asm volatile("s_waitcnt vmcnt(0)\n\ts_barrier" ::: "memory"); } while (0)
#define RESC(a) do { if (__any((a) < 1.f)) { if (hi == 0) al_l[r32] = (a); asm volatile("s_waitcnt lgkmcnt(0)" ::: "memory"); \
    _Pragma("unroll") for (int d = 0; d < 4; ++d) _Pragma("unroll") for (int r = 0; r < 16; ++r) o[d][r] *= al_l[crow(r, hi)]; } } while (0)
#define BIASMASK(P0, P1, j) do { if ((j) >= NT - 4) { const bool msk_ = ((j) == NT - 1 && rb < 2); \
    if (msk_) { _Pragma("unroll") for (int r = 0; r < 16; ++r) { P0[r] = -1e30f; P1[r] = -1e30f; } } \
    else { const int base_ = 64 * (j) - qpos + 255 + 4 * hi; \
      _Pragma("unroll") for (int r = 0; r < 16; ++r) { const int i0_ = base_ + (r & 3) + 8 * (r >> 2); P0[r] += tab[i0_]; P1[r] += tab[i0_ + 32]; } } } } while (0)
#define ROT() do { const int t_ = s0; s0 = s1; s1 = s2; s2 = t_; } while (0)
  const LAS char* vrd = V_lds + v_rd_base(lane);
  f32x16 pA0, pA1, pB0, pB1; float mnA, mnB, alA = 1.f, alB = 1.f; bf16x8 pa0, pa1, pa2, pa3;
  int s0 = 2 * SHM_K, s1 = 0, s2 = SHM_K;
  asm volatile("s_waitcnt vmcnt(0)" ::: "memory");
  DMA_K(0, 0); DMA_K(1, SHM_K); DMA_V(0, 0);
  WAITBAR(0); DMA_K(2, s0); DMA_V(1, s2);
  qkt<false>(pA0, pA1, K_lds + s1, qr, nullptr, r32, hi, g); BIASMASK(pA0, pA1, 0); partialSM(pA0, pA1, m_reg, mnA, alA);
  ROT();
  for (int j = 1; j + 1 < NT; j += 2) {
    WAITBAR(j); if (j + 2 < NT) DMA_K(j + 2, s0); DMA_V(j + 1, s2);
    qkt<false>(pB0, pB1, K_lds + s1, qr, nullptr, r32, hi, g); finishSM(pA0, pA1, alA, l_reg, pa0, pa1, pa2, pa3);
    pv_d0(o, vrd + s0, pa0, pa1, pa2, pa3); BIASMASK(pB0, pB1, j); partialSM(pB0, pB1, m_reg, mnB, alB); RESC(alB);
    ROT();
    WAITBAR(j + 1); if (j + 3 < NT) DMA_K(j + 3, s0); if (j + 2 < NT) DMA_V(j + 2, s2);
    qkt<false>(pA0, pA1, K_lds + s1, qr, nullptr, r32, hi, g); finishSM(pB0, pB1, alB, l_reg, pa0, pa1, pa2, pa3);
    pv_d0(o, vrd + s0, pa0, pa1, pa2, pa3); BIASMASK(pA0, pA1, j + 1); partialSM(pA0, pA1, m_reg, mnA, alA); RESC(alA);
    ROT();
  }
  WAITBAR(NT - 1);
  qkt<false>(pB0, pB1, K_lds + s1, qr, nullptr, r32, hi, g); finishSM(pA0, pA1, alA, l_reg, pa0, pa1, pa2, pa3);
  pv_d0(o, vrd + s0, pa0, pa1, pa2, pa3); BIASMASK(pB0, pB1, NT - 1); partialSM(pB0, pB1, m_reg, mnB, alB); RESC(alB);
  finishSM(pB0, pB1, alB, l_reg, pa0, pa1, pa2, pa3);
  pv_d0(o, vrd + s1, pa0, pa1, pa2, pa3);
#undef DMA_K
#undef DMA_V
#undef WAITBAR
#undef RESC
#undef BIASMASK
#undef ROT
  if (hi == 0) li_l[r32] = l_reg;
  asm volatile("s_waitcnt lgkmcnt(0)" ::: "memory");
  float rli[16];
#pragma unroll
  for (int r = 0; r < 16; ++r) rli[r] = __builtin_amdgcn_rcpf(li_l[crow(r, hi)]);
  __syncthreads();
  LAS float* X = (LAS float*)lds + rb * 4096 + lane;
  if (g == 1) {
#pragma unroll
    for (int r = 0; r < 16; ++r)
#pragma unroll
      for (int d0 = 0; d0 < 4; ++d0) X[(r * 4 + d0) * 64] = o[d0][r] * rli[r];
  }
  __syncthreads();
  if (g == 0) {
    const float lam = ((const LAS float*)(lds + OFF_LAM))[0], osc = ((const LAS float*)(lds + OFF_LAM))[1];
    float ss[16];
#pragma unroll
    for (int r = 0; r < 16; ++r) { float s = 0.f;
#pragma unroll
      for (int d0 = 0; d0 < 4; ++d0) { const float od = o[d0][r] * rli[r] - lam * X[(r * 4 + d0) * 64]; o[d0][r] = od; s += od * od; }
      ss[r] = s; }
#pragma unroll
    for (int r = 0; r < 16; ++r) { float s = ss[r]; s += __shfl_xor(s, 1); s += __shfl_xor(s, 2); s += __shfl_xor(s, 4); s += __shfl_xor(s, 8); s += __shfl_xor(s, 16);
      ss[r] = osc / sqrtf(s * (1.f / 128.f) + RMS_EPS); }
    float gn[4];
#pragma unroll
    for (int d0 = 0; d0 < 4; ++d0) gn[d0] = gnorm[d0 * 32 + r32];
    bf16* Ow = Orow0 + (size_t)(rb * 32) * 1024 + r32;
#pragma unroll
    for (int r = 0; r < 16; ++r) { const int orow = crow(r, hi);
#pragma unroll
      for (int d0 = 0; d0 < 4; ++d0) Ow[(size_t)orow * 1024 + d0 * 32] = (bf16)f2bf(o[d0][r] * ss[r] * gn[d0]); }
  }
  __syncthreads();
}

__device__ __forceinline__ void attn_unit_sample(LAS unsigned char* lds, const float* Kg, const float* Vg, const float* Kl, const float* Vl, const bf16* Qrow0, bf16* Orow0,
                                                 int qpos0, int h, const float* gnorm) {
  using St = Stage<true>; constexpr int LDK = 512, NT = 65;
  const int tid = fresh_tid(), wid = __builtin_amdgcn_readfirstlane(tid >> 6), lane = tid & 63, r32 = lane & 31, hi = lane >> 5;
  const int g = wid & 1, rb = (wid >> 1) & 1; const bool live = wid < 4;
  LAS char* V_lds = (LAS char*)lds + OFF_V; LAS char* K_lds = (LAS char*)lds + OFF_K;
  LAS float* wsf = (LAS float*)(lds + OFF_WS) + wid * 64; LAS float* li_l = wsf; LAS float* al_l = wsf + 32;
  const LAS float* tab = (const LAS float*)(lds + OFF_TAB) + h * TAB_N;
  float m_reg = -1e30f, l_reg = 0; f32x16 o[4] = {}; bf16x8 qr[4];
  const bf16* Qw = Qrow0 + (size_t)(rb * 32 + r32) * 3328 + g * 64 + hi * 8;
#pragma unroll
  for (int d0 = 0; d0 < 4; ++d0) qr[d0] = *reinterpret_cast<const bf16x8*>(Qw + d0 * 16);
  const int qpos = qpos0 + rb * 32 + r32;
  const int sr = tid >> 4, sc = (tid & 15) * 8, vst0 = v_st(sr, sc), vst1 = v_st(32 + sr, sc);
  const LAS char* vb0 = V_lds + v_rd_base(lane);
  typename St::T vs0, vs1, ks0, ks1;
#define SLOAD1(t) do { const float* kb_ = (t) < 64 ? Kg + (size_t)(t) * 64 * LDK : Kl; const float* vb_ = (t) < 64 ? Vg + (size_t)(t) * 64 * LDK : Vl; \
    vs0 = St::ld8(vb_ + (size_t)sr * LDK + sc); vs1 = St::ld8(vb_ + (size_t)(32 + sr) * LDK + sc); ks0 = St::ld8(kb_ + (size_t)sr * LDK + sc); ks1 = St::ld8(kb_ + (size_t)(32 + sr) * LDK + sc); } while (0)
#define SWRITE1(b) do { *(LAS bf16x8*)(V_lds + (b) * SHM_V + vst0) = St::tobf(vs0); *(LAS bf16x8*)(V_lds + (b) * SHM_V + vst1) = St::tobf(vs1); const int kc = sc * 2; \
    *(LAS bf16x8*)(K_lds + (b) * SHM_K + KSWZ(sr, kc)) = St::tobf(ks0); *(LAS bf16x8*)(K_lds + (b) * SHM_K + KSWZ(32 + sr, kc)) = St::tobf(ks1); } while (0)
  SLOAD1(0); asm volatile("s_waitcnt vmcnt(0)" ::: "memory"); SWRITE1(0); __syncthreads();
  for (int j = 0; j < NT; ++j) {
    const int bsel = j & 1;
    if (j + 1 < NT) SLOAD1(j + 1);
    SBAR();
    if (live) { f32x16 p0, p1; float mn, al; bf16x8 pa0, pa1, pa2, pa3;
      qkt<false>(p0, p1, K_lds + bsel * SHM_K, qr, nullptr, r32, hi, g);
      if (j >= NT - 3) { const int base_ = 64 * j - qpos + 255 + 4 * hi;
#pragma unroll
        for (int r = 0; r < 16; ++r) { const int i0_ = base_ + (r & 3) + 8 * (r >> 2); p0[r] += tab[i0_]; p1[r] += tab[i0_ + 32]; } }
      partialSM(p0, p1, m_reg, mn, al);
      if (__any(al < 1.f)) { if (hi == 0) al_l[r32] = al; asm volatile("s_waitcnt lgkmcnt(0)" ::: "memory");
#pragma unroll
        for (int d = 0; d < 4; ++d)
#pragma unroll
          for (int r = 0; r < 16; ++r) o[d][r] *= al_l[crow(r, hi)]; }
      finishSM(p0, p1, al, l_reg, pa0, pa1, pa2, pa3); SBAR();
      pv_d0(o, vb0 + bsel * SHM_V, pa0, pa1, pa2, pa3); }
    SBAR();
    if (j + 1 < NT) { asm volatile("s_waitcnt vmcnt(0)" ::: "memory"); SWRITE1(bsel ^ 1); }
    __syncthreads();
  }
#undef SLOAD1
#undef SWRITE1
  if (hi == 0) li_l[r32] = l_reg;
  asm volatile("s_waitcnt lgkmcnt(0)" ::: "memory");
  float rli[16];
#pragma unroll
  for (int r = 0; r < 16; ++r) rli[r] = __builtin_amdgcn_rcpf(li_l[crow(r, hi)]);
  LAS float* X = (LAS float*)lds + rb * 4096 + lane;
  if (live && g == 1) {
#pragma unroll
    for (int r = 0; r < 16; ++r)
#pragma unroll
      for (int d0 = 0; d0 < 4; ++d0) X[(r * 4 + d0) * 64] = o[d0][r] * rli[r];
  }
  __syncthreads();
  if (live && g == 0) {
    const float lam = ((const LAS float*)(lds + OFF_LAM))[0], osc = ((const LAS float*)(lds + OFF_LAM))[1];
    float ss[16];
#pragma unroll
    for (int r = 0; r < 16; ++r) { float s = 0.f;
#pragma unroll
      for (int d0 = 0; d0 < 4; ++d0) { const float od = o[d0][r] * rli[r] - lam * X[(r * 4 + d0) * 64]; o[d0][r] = od; s += od * od; }
      ss[r] = s; }
#pragma unroll
    for (int r = 0; r < 16; ++r) { float s = ss[r]; s += __shfl_xor(s, 1); s += __shfl_xor(s, 2); s += __shfl_xor(s, 4); s += __shfl_xor(s, 8); s += __shfl_xor(s, 16);
      ss[r] = osc / sqrtf(s * (1.f / 128.f) + RMS_EPS); }
    float gn[4];
#pragma unroll
    for (int d0 = 0; d0 < 4; ++d0) gn[d0] = gnorm[d0 * 32 + r32];
    bf16* Ow = Orow0 + (size_t)(rb * 32) * 1024 + r32;
#pragma unroll
    for (int r = 0; r < 16; ++r) { const int orow = crow(r, hi);
#pragma unroll
      for (int d0 = 0; d0 < 4; ++d0) Ow[(size_t)orow * 1024 + d0 * 32] = (bf16)f2bf(o[d0][r] * ss[r] * gn[d0]); }
  }
  __syncthreads();
}
#undef KSWZ
#undef SBAR
}

namespace gla {
constexpr int P72 = 72;
constexpr int L_TOT = 0, L_DL = 2048, L_QT = 4096, L_KT = L_QT + 64 * P72 * 2, L_KDT = L_KT + 64 * P72 * 2, L_A = L_KDT + 64 * P72 * 2, L_VT = L_A + 64 * P72 * 2, L_END = L_VT + 128 * P72 * 2;
static_assert(L_END <= RING_BYTES, "gla LDS map");
__device__ __forceinline__ int crow(int r, int hi) { return (r & 3) + 8 * (r >> 2) + 4 * hi; }
__device__ __forceinline__ float logsig(float z) { return fminf(z, 0.f) - __logf(1.f + __expf(-fabsf(z))); }
__device__ __forceinline__ bf16x8 ldsfrag(const LAS unsigned char* img, int row, int k0) { return *(const LAS bf16x8*)(img + (row * P72 + k0) * 2); }

#define G1IN_DECL(p) float p##z[8]; unsigned p##qk[8]; bf16x8 p##v0, p##v1; float p##bal
#define G1IN_ARGS(p) p##z, p##qk, p##v0, p##v1, p##bal
__device__ __forceinline__ void g1_load(float (&z)[8], unsigned (&qk)[8], bf16x8& v0, bf16x8& v1, float& bal, int c, int h, const bf16* ACT, const float* LOGA, const float* balpha) {
    const int tid = fresh_tid(), lane = tid & 63, t0 = 8 * (tid >> 6), row0 = 64 * c;
    bal = balpha[h * 64 + lane];
#pragma unroll
    for (int i = 0; i < 8; ++i) z[i] = LOGA[(size_t)(row0 + t0 + i) * 256 + h * 64 + lane];
#pragma unroll
    for (int i = 0; i < 8; ++i) { const bf16* ap = ACT + (size_t)(row0 + t0 + i) * NIN + h * 64 + lane; qk[i] = (unsigned)ap[0] | ((unsigned)ap[256] << 16); }
    { const int s = tid >> 4, jc = (tid & 15) * 8; v0 = *(const bf16x8*)(ACT + (size_t)(row0 + s) * NIN + 768 + h * 128 + jc); v1 = *(const bf16x8*)(ACT + (size_t)(row0 + 32 + s) * NIN + 768 + h * 128 + jc); }
}
__device__ __forceinline__ void g1_unit(LAS unsigned char* lds, const float (&inz)[8], const unsigned (&inqk)[8], const bf16x8& inv0, const bf16x8& inv1, const float& inbal, int c, int h, int layer,
                                        float* UT, float* Dw, float* OI, bf16* QT, bf16* SCT, const float* state_in  , float* state_out  ) {
    const int tid = fresh_tid(), wid = __builtin_amdgcn_readfirstlane(tid >> 6), lane = tid & 63, r = lane & 31, hh = lane >> 5;
    const int row0 = 64 * c;
    LAS float* TOT = (LAS float*)(lds + L_TOT); LAS float* DL = (LAS float*)(lds + L_DL);
    LAS unsigned char* Qi = lds + L_QT; LAS unsigned char* Ki = lds + L_KT; LAS unsigned char* KDi = lds + L_KDT; LAS unsigned char* Ai = lds + L_A; LAS unsigned char* Vi = lds + L_VT;
    { const int d = lane, tg = wid, t0 = 8 * tg;
      const float bal = inbal;
      float cs[8]; float run = 0.f;
#pragma unroll
      for (int i = 0; i < 8; ++i) { const float z = inz[i] + bal; run += logsig(z) * 0.0625f; cs[i] = run; }
      float qv[8], kv[8];
#pragma unroll
      for (int i = 0; i < 8; ++i) { qv[i] = bf2f((unsigned short)(inqk[i] & 0xffffu)); kv[i] = bf2f((unsigned short)(inqk[i] >> 16)); }
      TOT[tg * 64 + d] = run;
#pragma unroll
      for (int k = 0; k < 2; ++k) { const int ci = tid + 512 * k, s = ci >> 4, jc = (ci & 15) * 8;
        const bf16x8 v = k ? inv1 : inv0;
#pragma unroll
        for (int e = 0; e < 8; ++e) *(LAS short*)(Vi + ((jc + e) * P72 + s) * 2) = v[e]; }
      __syncthreads();
      float off = 0.f, blast = 0.f;
#pragma unroll
      for (int g2 = 0; g2 < 8; ++g2) { const float tv = TOT[g2 * 64 + d]; blast += tv; if (g2 < tg) off += tv; }
      unsigned kd[4];
      float kdf[8];
#pragma unroll
      for (int i = 0; i < 8; ++i) { const float b = off + cs[i]; const float eb = __expf(b);
        const float qt = qv[i] * 0.125f * eb, kt = kv[i] * __expf(-b); kdf[i] = kv[i] * __expf(blast - b);
        const unsigned short qb = (unsigned short)f2bf(qt);
        *(LAS unsigned short*)(Qi + ((t0 + i) * P72 + d) * 2) = qb; *(LAS unsigned short*)(Ki + ((t0 + i) * P72 + d) * 2) = (unsigned short)f2bf(kt);
        QT[(size_t)(row0 + t0 + i) * 256 + h * 64 + d] = qb; }
#pragma unroll
      for (int i = 0; i < 4; ++i) kd[i] = pk2(kdf[2 * i], kdf[2 * i + 1]);
      *(LAS v4u*)(KDi + (d * P72 + t0) * 2) = (v4u){kd[0], kd[1], kd[2], kd[3]};
      if (tg == 0) { const float Dd = __expf(blast); DL[d] = Dd; Dw[(size_t)(c * 4 + h) * 64 + d] = Dd; }
    }
    __syncthreads();
    if (wid < 3) { const int sb = (wid == 2), tb = (wid >= 1); f32x16 acc = {};
#pragma unroll
      for (int kk = 0; kk < 4; ++kk) acc = __builtin_amdgcn_mfma_f32_32x32x16_bf16(ldsfrag(Ki, sb * 32 + r, kk * 16 + 8 * hh), ldsfrag(Qi, tb * 32 + r, kk * 16 + 8 * hh), acc, 0, 0, 0);
      const int t = tb * 32 + r;
#pragma unroll
      for (int q = 0; q < 4; ++q) { const int s0 = sb * 32 + 8 * q + 4 * hh; float v[4];
#pragma unroll
        for (int e = 0; e < 4; ++e) v[e] = (s0 + e <= t) ? acc[4 * q + e] : 0.f;
        *(LAS v2u*)(Ai + (t * P72 + s0) * 2) = (v2u){pk2(v[0], v[1]), pk2(v[2], v[3])}; }
    } else if (wid == 3) {
#pragma unroll
      for (int q = 0; q < 4; ++q) *(LAS v2u*)(Ai + (r * P72 + 32 + 8 * q + 4 * hh) * 2) = (v2u){0u, 0u};
    } else {
      const int jb = wid - 4, j = jb * 32 + r;
#pragma unroll
      for (int db = 0; db < 2; ++db) { f32x16 acc = {};
#pragma unroll
        for (int kk = 0; kk < 4; ++kk) acc = __builtin_amdgcn_mfma_f32_32x32x16_bf16(ldsfrag(KDi, db * 32 + r, kk * 16 + 8 * hh), ldsfrag(Vi, j, kk * 16 + 8 * hh), acc, 0, 0, 0);
        if (c < NPCH) {
#pragma unroll
          for (int q = 0; q < 4; ++q) { const int d0 = db * 32 + 8 * q + 4 * hh;
            *(f32x4*)(UT + ((size_t)(c * 4 + h) * 128 + j) * 64 + d0) = (f32x4){acc[4 * q], acc[4 * q + 1], acc[4 * q + 2], acc[4 * q + 3]}; }
        } else { const int b = c - NPCH; const size_t sbase = (size_t)(b * 4 + h) * 8192;
#pragma unroll
          for (int q = 0; q < 4; ++q) { const int d0 = db * 32 + 8 * q + 4 * hh; float si[4];
#pragma unroll
            for (int e = 0; e < 4; ++e) { si[e] = state_in[sbase + (size_t)(d0 + e) * 128 + j]; state_out[sbase + (size_t)(d0 + e) * 128 + j] = DL[d0 + e] * si[e] + acc[4 * q + e]; }
            *(v2u*)(SCT + ((size_t)(c * 4 + h) * 128 + j) * 64 + d0) = (v2u){pk2(si[0], si[1]), pk2(si[2], si[3])}; }
        }
      }
    }
    __syncthreads();
    { const int jb = wid >> 1, tb = wid & 1; f32x16 acc = {};
#pragma unroll
      for (int kk = 0; kk < 4; ++kk) acc = __builtin_amdgcn_mfma_f32_32x32x16_bf16(ldsfrag(Vi, jb * 32 + r, kk * 16 + 8 * hh), ldsfrag(Ai, tb * 32 + r, kk * 16 + 8 * hh), acc, 0, 0, 0);
      float* op = OI + (size_t)(row0 + tb * 32 + r) * 512 + h * 128 + jb * 32 + 4 * hh;
#pragma unroll
      for (int q = 0; q < 4; ++q) *(f32x4*)(op + 8 * q) = (f32x4){acc[4 * q], acc[4 * q + 1], acc[4 * q + 2], acc[4 * q + 3]}; }
    __syncthreads();
}

__device__ __forceinline__ void g2_group(LAS unsigned char* lds, int eg, const float* UT, const float* Dw, bf16* SCT, float* gout  ) {
    const int tid = fresh_tid(); const int el = tid & 127, seg = tid >> 7; const int e = eg * 128 + el; const int h = e >> 13, j = (e >> 6) & 127, d = e & 63;
    LAS float* PL = (LAS float*)lds;
    const size_t ustride = 4 * 128 * 64, dstride = 4 * 64;
    const float* up = UT + ((size_t)h * 128 + j) * 64 + d + (size_t)(64 * seg) * ustride; const float* dp = Dw + h * 64 + d + (size_t)(64 * seg) * dstride;
    float P = 1.f, L = 0.f;
#pragma unroll 32
    for (int cc = 0; cc < 64; ++cc) { const float Dv = dp[(size_t)cc * dstride], Uv = up[(size_t)cc * ustride]; L = fmaf(Dv, L, Uv); P *= Dv; }
    PL[(seg * 128 + el) * 2] = P; PL[(seg * 128 + el) * 2 + 1] = L;
    __syncthreads();
    float S = 0.f;
    for (int s2 = 0; s2 < seg; ++s2) S = fmaf(PL[(s2 * 128 + el) * 2], S, PL[(s2 * 128 + el) * 2 + 1]);
    bf16* sp = SCT + ((size_t)h * 128 + j) * 64 + d + (size_t)(64 * seg) * ustride;
#pragma unroll 32
    for (int cc = 0; cc < 64; ++cc) { const float Dv = dp[(size_t)cc * dstride], Uv = up[(size_t)cc * ustride]; sp[(size_t)cc * ustride] = (bf16)f2bf(S); S = fmaf(Dv, S, Uv); }
    if (seg == 3) gout[((size_t)h * 64 + d) * 128 + j] = S;
    __syncthreads();
}

__device__ __forceinline__ void g3_unit(LAS float* part, int c, int h, const bf16* ACT, const float* OI, const bf16* QT, const bf16* SCT, const float* gnorm  , bf16* MIX) {
    const int tid = fresh_tid(), wid = __builtin_amdgcn_readfirstlane(tid >> 6), lane = tid & 63, r = lane & 31, hh = lane >> 5;
    const int jb = wid >> 1, tb = wid & 1; const int row = 64 * c + tb * 32 + r;
    f32x16 acc = {};
    const bf16* ap = SCT + ((size_t)(c * 4 + h) * 128 + jb * 32 + r) * 64 + 8 * hh; const bf16* bp = QT + (size_t)row * 256 + h * 64 + 8 * hh;
#pragma unroll
    for (int kk = 0; kk < 4; ++kk) acc = __builtin_amdgcn_mfma_f32_32x32x16_bf16(*(const bf16x8*)(ap + kk * 16), *(const bf16x8*)(bp + kk * 16), acc, 0, 0, 0);
    const int j0 = jb * 32 + 4 * hh;
    const float* oip = OI + (size_t)row * 512 + h * 128 + j0;
    float ss = 0.f;
#pragma unroll
    for (int q = 0; q < 4; ++q) { const f32x4 oi = *(const f32x4*)(oip + 8 * q);
#pragma unroll
      for (int e = 0; e < 4; ++e) { acc[4 * q + e] += oi[e]; ss += acc[4 * q + e] * acc[4 * q + e]; } }
    ss += __shfl_xor(ss, 32);
    if (hh == 0) part[wid * 32 + r] = ss;
    __syncthreads();
    const float tot = part[tb * 32 + r] + part[(tb + 2) * 32 + r] + part[(tb + 4) * 32 + r] + part[(tb + 6) * 32 + r];
    const float rstd = 1.f / sqrtf(tot * (1.f / 128.f) + RMS_EPS);
    const bf16* gp = ACT + (size_t)row * NIN + 1280 + h * 128 + j0; bf16* mp = MIX + (size_t)row * 1024 + h * 128 + j0;
#pragma unroll
    for (int q = 0; q < 4; ++q) { const v2u gg = *(const v2u*)(gp + 8 * q); const f32x4 gn = *(const f32x4*)(gnorm + j0 + 8 * q);
      float gv[4] = {bf2f((unsigned short)(gg.x & 0xffffu)), bf2f((unsigned short)(gg.x >> 16)), bf2f((unsigned short)(gg.y & 0xffffu)), bf2f((unsigned short)(gg.y >> 16))}; float y[4];
#pragma unroll
      for (int e = 0; e < 4; ++e) { const float sg = gv[e] / (1.f + __expf(-gv[e])); y[e] = acc[4 * q + e] * rstd * gn[e] * sg; }
      *(v2u*)(mp + 8 * q) = (v2u){pk2(y[0], y[1]), pk2(y[2], y[3])}; }
    __syncthreads();
}
}

namespace mini {
__device__ __forceinline__ int crow(int r, int hi) { return (r & 3) + 8 * (r >> 2) + 4 * hi; }
template <int K>
__device__ __forceinline__ void piece(LAS unsigned char* lds, int p, const bf16* A  , const bf16* Bt, const float* src  , float* dst  , bf16* xb  , float* rowsq  ) {
    const int tid = fresh_tid(), wid = __builtin_amdgcn_readfirstlane(tid >> 6), lane = tid & 63, r = lane & 31, hh = lane >> 5;
    const int r0 = (p >> 4) * 64, c0 = (p & 15) * 64;
    constexpr int KW = K / 8, NS = KW / 16;
    static_assert(KW % 16 == 0, "K / 8 must be a multiple of 16");
    const bf16* ap = A + (size_t)(r0 + r) * K + wid * KW + 8 * hh; const bf16* bp = Bt + (size_t)(c0 + r) * K + wid * KW + 8 * hh;
    f32x16 acc[2][2] = {};
    constexpr int U = (NS % 11 == 0) ? 11 : 8;
    static_assert(NS % U == 0, "batching");
    for (int kb = 0; kb < NS; kb += U) {
        bf16x8 a0[U], a1[U], b0[U], b1[U];
#pragma unroll
        for (int u = 0; u < U; ++u) { a0[u] = *(const bf16x8*)(ap + (kb + u) * 16); a1[u] = *(const bf16x8*)(ap + (size_t)32 * K + (kb + u) * 16);
                                      b0[u] = *(const bf16x8*)(bp + (kb + u) * 16); b1[u] = *(const bf16x8*)(bp + (size_t)32 * K + (kb + u) * 16); }
#pragma unroll
        for (int u = 0; u < U; ++u) {
            acc[0][0] = __builtin_amdgcn_mfma_f32_32x32x16_bf16(a0[u], b0[u], acc[0][0], 0, 0, 0); acc[0][1] = __builtin_amdgcn_mfma_f32_32x32x16_bf16(a0[u], b1[u], acc[0][1], 0, 0, 0);
            acc[1][0] = __builtin_amdgcn_mfma_f32_32x32x16_bf16(a1[u], b0[u], acc[1][0], 0, 0, 0); acc[1][1] = __builtin_amdgcn_mfma_f32_32x32x16_bf16(a1[u], b1[u], acc[1][1], 0, 0, 0); }
    }
    LAS float* P = (LAS float*)lds;
#pragma unroll
    for (int i = 0; i < 2; ++i)
#pragma unroll
        for (int j = 0; j < 2; ++j)
#pragma unroll
            for (int q = 0; q < 16; ++q) P[(((wid * 2 + i) * 2 + j) * 16 + q) * 64 + lane] = acc[i][j][q];
    __syncthreads();
    float vv[8];
#pragma unroll
    for (int q = 0; q < 8; ++q) { const int e = tid + 512 * q;
        float s = 0.f;
#pragma unroll
        for (int w = 0; w < 8; ++w) s += P[w * 4096 + e];
        const int ln = e & 63, reg = (e >> 6) & 15, j = (e >> 10) & 1, i = e >> 11;
        const int row = r0 + 32 * i + crow(reg, ln >> 5), col = c0 + 32 * j + (ln & 31);
        const float v = src[(size_t)row * 1024 + col] + s;
        dst[(size_t)row * 1024 + col] = v; xb[(size_t)row * 1024 + col] = (bf16)f2bf(v); vv[q] = v; }
#pragma unroll
    for (int q = 0; q < 8; ++q) { if (q & 2) continue;
        float sq = vv[q] * vv[q] + vv[q + 2] * vv[q + 2]; sq += __shfl_xor(sq, 1); sq += __shfl_xor(sq, 2); sq += __shfl_xor(sq, 4); sq += __shfl_xor(sq, 8); sq += __shfl_xor(sq, 16);
        const int e = tid + 512 * q, ln = e & 63, reg = (e >> 6) & 15, i = e >> 11; const int row = r0 + 32 * i + crow(reg, ln >> 5);
        if ((ln & 31) == 0) rowsq[(size_t)row * 16 + (p & 15)] = sq; }
    __syncthreads();
}
}

__global__ void __launch_bounds__(NWAVES * 64, 2) hymba_fwd(Args args) {
    extern __shared__ __attribute__((aligned(16))) unsigned char lds[];
    Frame F;
    F.lds = (LAS unsigned char*)lds;
    for (int u = threadIdx.x; u < (LDS_BYTES - LDSCTL_OFF) / 4; u += NWAVES * 64) ((LAS unsigned*)(F.lds + LDSCTL_OFF))[u] = 0u;
    __syncthreads();
    if (threadIdx.x == 0) { LAS unsigned long long* t = (LAS unsigned long long*)(F.lds + PTAB_OFF);
#pragma unroll
        for (int i = 0; i < 18; ++i) t[i] = (unsigned long long)args.in[i];
        t[18] = (unsigned long long)args.out; t[19] = (unsigned long long)args.ws; }
    __syncthreads();
#define CTL_ ((gu32*)(wsp(F) + WS_CTL))
    (void)xcd_barrier_post((unsigned*)(CTL_ + CW_BAR), (volatile LAS unsigned*)(F.lds + MISC_OFF) + 8);
#define GRID_BAR() do { XcdBarrier b_; b_.bar = (unsigned*)(CTL_ + CW_BAR); b_.x = xb_xcc_id(); b_.st = (volatile LAS unsigned*)(F.lds + MISC_OFF) + 8; xcd_barrier(b_); } while (0)

#define WSB(off) (wsp(F) + (off))
#define X_ ((float*)WSB(WS_X))
#define XN_ ((bf16*)WSB(WS_XN))
#define ACT_ ((bf16*)WSB(WS_ACT))
#define MIX_ ((bf16*)WSB(WS_MIX))
#define HB_ ((bf16*)WSB(WS_H))
#define LOGA_ ((float*)WSB(WS_LOGA))

#ifndef SKIP_P0
    p0_prologue(F);
#endif
    rows_to_bf16_sq(F, inp(F, 0), inp(F, 1), XN_, (float*)WSB(WS_RSQ));
    GRID_BAR();

    for (int l = 0; l < DEPTH; ++l) {
#define WL_ (WSB(WS_W) + (size_t)l * W_LAYER)
#define SRCP_ (l == 0 ? inp(F, 0) : (const float*)X_)
#define SRCS_ (l == 0 ? inp(F, 1) : (const float*)X_ + (size_t)SEQ * DM)
#ifndef SKIP_IN
        { pg8::Gemm g{XN_, (const bf16*)(WL_ + WO_IN), M, NIN, DM}; pg8::StaticOrder S; S.init(M, NIN, grid_n(), (int)blockIdx.x);
          rstd_prepass(F, S, (const float*)WSB(WS_RSQ) + (size_t)(2 * l) * M * 16);
          pg8::EpiIn E{wsp(F), outp(F), l, WS_ACT, WS_LOGA, (const LAS float*)(F.lds + RSTD_OFF)};
          pg8::gemm_phase<pg8::EpiIn, pg8::StaticOrder, true, true>(F.lds + RING_OFF, g, S, E);
#if defined(PROBE_DUP_GEMM) || defined(PROBE_DUP_IN)
          __syncthreads(); pg8::gemm_phase<pg8::EpiIn, pg8::StaticOrder, true, true>(F.lds + RING_OFF, g, S, E);
#endif
        }
#endif
        GRID_BAR();
#ifndef SKIP_G1
        { G1IN_DECL(gA); G1IN_DECL(gB); const int G_ = grid_n(); int u = blockIdx.x; constexpr int NU = NCHUNK * 4;
#define G1_LOAD(gx, uu) gla::g1_load(G1IN_ARGS(gx), (uu) >> 2, (uu) & 3, ACT_, LOGA_, inp(F, 7) + (size_t)l * 256)
#define G1_RUN(gx, uu) gla::g1_unit(F.lds + RING_OFF, G1IN_ARGS(gx), (uu) >> 2, (uu) & 3, l, (float*)WSB(WS_U), (float*)WSB(WS_D), (float*)WSB(WS_OI), (bf16*)WSB(WS_QT), (bf16*)WSB(WS_SC), \
                         inp(F, 4) + (size_t)l * DECB * 4 * 8192, outp(F) + OG_S + (size_t)l * DECB * 4 * 8192)
#define CLAMPU(x) ((x) < NU ? (x) : NU - 1)
          G1_LOAD(gA, CLAMPU(u));
          for (; u < NU; u += 2 * G_) {
            G1_LOAD(gB, CLAMPU(u + G_));
            G1_RUN(gA, u);
            if (u + G_ < NU) { G1_LOAD(gA, CLAMPU(u + 2 * G_)); G1_RUN(gB, u + G_); } }
#undef CLAMPU
#undef G1_LOAD
#undef G1_RUN
        }
#endif
        GRID_BAR();
#ifdef PROBE_DUP_GLA
        for (int rep_ = 0; rep_ < 2; ++rep_)
#endif
        for (int eg = blockIdx.x; eg < 256; eg += grid_n())
#ifndef SKIP_G2
            gla::g2_group(F.lds + RING_OFF, eg, (const float*)WSB(WS_U), (const float*)WSB(WS_D), (bf16*)WSB(WS_SC), outp(F) + OG_P + (size_t)l * 4 * 8192);
#endif
            ;
        GRID_BAR();
        att::attn_setup(F.lds + RING_OFF, inp(F, 17), inp(F, 9) + (size_t)l * 256, l);
#ifdef PROBE_DUP_ATT
        for (int rep = 0; rep < 2; ++rep)
#else
        const int rep = 0;
#endif
        for (int it = 0;; ++it) {
            if (it == 0) __syncthreads();
            volatile LAS int* slot = (volatile LAS int*)(F.lds + MISC_OFF) + 16 + (it & 1);
            if (threadIdx.x == 0) *slot = (int)__hip_atomic_fetch_add((unsigned*)(CTL_ + CW_QUEUE + 64 * (l + 4 * rep)), 1u, __ATOMIC_RELAXED, __HIP_MEMORY_SCOPE_AGENT);
            __syncthreads();
            const int idx = __builtin_amdgcn_readfirstlane(*slot);
            if (idx >= 64 + 512 + NCHUNK * 4) break;
            if (idx < 64) { const int b = idx >> 2, h = idx & 3;
                const float* kc = inp(F, 2) + ((size_t)(l * DECB + b) * PAST) * 512 + h * 128; const float* vc = inp(F, 3) + ((size_t)(l * DECB + b) * PAST) * 512 + h * 128;
                const float* kn = outp(F) + OK_S + ((size_t)(l * DECB + b) * 64) * 512 + h * 128; const float* vn = outp(F) + OV_S + ((size_t)(l * DECB + b) * 64) * 512 + h * 128;
#ifndef SKIP_AS
                att::attn_unit_sample(F.lds + RING_OFF, kc, vc, kn, vn, ACT_ + (size_t)(SEQ + 64 * b) * NIN + 1792 + h * 128, MIX_ + (size_t)(SEQ + 64 * b) * DM + 512 + h * 128,
                                      PAST, h, inp(F, 10) + (size_t)l * 128);
#endif
            } else if (idx < 576) { const int i = idx - 64, u = 127 - (i >> 2), h = i & 3;
#ifndef SKIP_AP
                att::attn_unit_prompt(F.lds + RING_OFF, ACT_ + 2304 + h * 128, ACT_ + 2816 + h * 128, ACT_ + (size_t)(128 * u) * NIN + 1792 + h * 128,
                                      MIX_ + (size_t)(128 * u) * DM + 512 + h * 128, 2 * u + 2, 128 * u, h, inp(F, 10) + (size_t)l * 128);
#endif
            } else { const int i = idx - 576;
#ifndef SKIP_G3
                gla::g3_unit((LAS float*)(F.lds + RING_OFF + att::OFF_G3), i >> 2, i & 3, ACT_, (const float*)WSB(WS_OI), (const bf16*)WSB(WS_QT), (const bf16*)WSB(WS_SC), inp(F, 8) + (size_t)l * 128, MIX_);
#endif
            }
        }
        GRID_BAR();
#ifndef SKIP_OUT
        { pg8::Gemm g{MIX_, (const bf16*)(WL_ + WO_OUT), SEQ, DM, DM}; pg8::StaticOrder S; S.init(SEQ, DM, grid_n(), (int)blockIdx.x);
          pg8::EpiRes E{SRCP_, SRCS_, X_, XN_, (float*)WSB(WS_RSQ) + (size_t)(1 + 2 * l) * M * 16};
          pg8::gemm_phase<pg8::EpiRes, pg8::StaticOrder, true, true>(F.lds + RING_OFF, g, S, E);
#ifdef PROBE_DUP_GEMM
          __syncthreads(); pg8::EpiRes E2{SRCP_, SRCS_, (float*)WSB(WS_H), XN_, (float*)WSB(WS_OI)}; pg8::gemm_phase<pg8::EpiRes, pg8::StaticOrder, true, true>(F.lds + RING_OFF, g, S, E2);
#endif
          __syncthreads();
          for (int p = blockIdx.x; p < 256; p += grid_n())
              mini::piece<DM>(F.lds + RING_OFF, p, MIX_ + (size_t)SEQ * DM, (const bf16*)(WL_ + WO_OUT), SRCS_, X_ + (size_t)SEQ * DM, XN_ + (size_t)SEQ * DM, (float*)WSB(WS_RSQ) + ((size_t)(1 + 2 * l) * M + SEQ) * 16);
        }
#endif
        GRID_BAR();
#ifndef SKIP_F1
        { pg8::Gemm g{XN_, (const bf16*)(WL_ + WO_F1), M, NF1, DM}; pg8::StaticOrder S; S.init(M, NF1, grid_n(), (int)blockIdx.x);
          rstd_prepass(F, S, (const float*)WSB(WS_RSQ) + (size_t)(1 + 2 * l) * M * 16);
          pg8::EpiSwi E{HB_, DFF, (const LAS float*)(F.lds + RSTD_OFF)};
          pg8::gemm_phase<pg8::EpiSwi, pg8::StaticOrder, true, true>(F.lds + RING_OFF, g, S, E);
#if defined(PROBE_DUP_GEMM) || defined(PROBE_DUP_F1)
          __syncthreads(); pg8::gemm_phase<pg8::EpiSwi, pg8::StaticOrder, true, true>(F.lds + RING_OFF, g, S, E);
#endif
        }
#endif
        GRID_BAR();
#ifndef SKIP_F2
        { pg8::Gemm g{HB_, (const bf16*)(WL_ + WO_F2), SEQ, DM, DFF}; pg8::StaticOrder S; S.init(SEQ, DM, grid_n(), (int)blockIdx.x);
          pg8::EpiRes E{X_, X_ + (size_t)SEQ * DM, X_, XN_, (float*)WSB(WS_RSQ) + (size_t)(2 + 2 * l) * M * 16};
#ifdef PROBE_DUP_GEMM
          { pg8::EpiRes E2{X_, X_ + (size_t)SEQ * DM, (float*)WSB(WS_ACT), XN_, (float*)WSB(WS_OI)}; pg8::gemm_phase<pg8::EpiRes, pg8::StaticOrder, true, true>(F.lds + RING_OFF, g, S, E2); __syncthreads(); }
#endif
          pg8::gemm_phase<pg8::EpiRes, pg8::StaticOrder, true, true>(F.lds + RING_OFF, g, S, E);
          __syncthreads();
          for (int p = blockIdx.x; p < 256; p += grid_n())
              mini::piece<DFF>(F.lds + RING_OFF, p, HB_ + (size_t)SEQ * DFF, (const bf16*)(WL_ + WO_F2), X_ + (size_t)SEQ * DM, X_ + (size_t)SEQ * DM, XN_ + (size_t)SEQ * DM, (float*)WSB(WS_RSQ) + ((size_t)(2 + 2 * l) * M + SEQ) * 16);
        }
#endif
        GRID_BAR();
    }
    norm_rows_f32(F, X_, inp(F, 16), outp(F) + OY);
}

extern "C" void kernel_launch(void* const* d_in, const int* in_sizes, int n_in, void* d_out, int out_size, void* d_ws, size_t ws_size, hipStream_t stream) {
    static int grid = 0;
    if (grid == 0) {
        if (n_in != 18 || (size_t)out_size != OUT_TOTAL || ws_size < WS_END) { fprintf(stderr, "kernel_launch: shape mismatch n_in %d out %d ws %zu\n", n_in, out_size, ws_size); grid = -1; return; }
        int dev = 0, cus = 0, per_cu = 0;
        if (hipGetDevice(&dev) != hipSuccess || hipDeviceGetAttribute(&cus, hipDeviceAttributeMultiprocessorCount, dev) != hipSuccess) { grid = -1; return; }
        if (hipFuncSetAttribute((const void*)hymba_fwd, hipFuncAttributeMaxDynamicSharedMemorySize, LDS_BYTES) != hipSuccess) { fprintf(stderr, "kernel_launch: hipFuncSetAttribute failed\n"); grid = -1; return; }
        if (hipOccupancyMaxActiveBlocksPerMultiprocessor(&per_cu, (const void*)hymba_fwd, NWAVES * 64, LDS_BYTES) != hipSuccess || per_cu < 1)
            fprintf(stderr, "kernel_launch: occupancy query reports %d\n", per_cu);
        (void)hipGetLastError();
        grid = cus;
    }
    if (grid < 0) return;
    if (hipMemsetAsync((char*)d_ws + WS_CTL, 0, CTL_ZERO_BYTES, stream) != hipSuccess) return;
    Args a{};
    for (int i = 0; i < 18; ++i) a.in[i] = (const float*)d_in[i];
    a.out = (float*)d_out; a.ws = (unsigned char*)d_ws;
    hipLaunchKernelGGL(hymba_fwd, dim3(grid), dim3(NWAVES * 64), LDS_BYTES, stream, a);
    const hipError_t le = hipPeekAtLastError();
    if (le != hipSuccess) fprintf(stderr, "kernel_launch: launch failed: %s\n", hipGetErrorName(le));
}
```

```cpp
#include <hip/hip_runtime.h>
#include <cstdio>
#include <cstdint>
namespace pg8 {
#define PG8_LAS __attribute__((address_space(3)))
typedef unsigned short bf16_t;
typedef short bf16x8 __attribute__((ext_vector_type(8)));
typedef float f32x4 __attribute__((ext_vector_type(4)));
typedef unsigned u32x4 __attribute__((ext_vector_type(4)));
constexpr int BM = 256, BK = 64, HALF = 128, HTB = HALF * BK * 2  , STAGE_BYTES = 8 * HTB, NXCD = 8, WGM = 8;

__host__ __device__ __forceinline__ int lds_byte(int r, int c) { const int st = (r >> 4) * 2 + (c >> 5), rr = r & 15, cc = c & 31, ob = rr * 64 + cc * 2; return st * 1024 + (ob ^ (((ob >> 9) & 1) << 5)); }
__host__ __device__ __forceinline__ void stage_rc(int b, int& R, int& C) { const int st = b / 1024, sb = b % 1024, swz = sb ^ (((sb >> 9) & 1) << 5); R = (st >> 1) * 16 + swz / 64; C = (st & 1) * 32 + (swz % 64) / 2; }
__host__ __device__ __forceinline__ int perm32(int rho) { const int n = rho >> 4, i = rho & 15; return 8 * (i >> 2) + 4 * n + (i & 3); }

struct Unit { int pm, pn; };
struct Gemm { const bf16_t* A; const bf16_t* Bt; int M, N, K; };

struct StaticOrder {
    int nM, nN, nwg, G, c;
    __host__ __device__ void init(int M, int N, int G_, int c_) { nM = M / BM; nN = N / BM; nwg = nM * nN; G = G_; c = c_; }
    __host__ __device__ bool next(int i, Unit& u) const {
        const long L = (long)i * G + c; if (L >= nwg) return false;
        int wgid = (int)L; { const int q = nwg / NXCD, r = nwg % NXCD, xcd = wgid % NXCD, off = wgid / NXCD; wgid = (xcd < r ? xcd * (q + 1) : r * (q + 1) + (xcd - r) * q) + off; }
        const int nig = WGM * nN, gid = wgid / nig, fm = gid * WGM, gsz = (nM - fm) < WGM ? (nM - fm) : WGM;
        u.pm = fm + ((wgid % nig) % gsz); u.pn = (wgid % nig) / gsz; return true;
    }
    __device__ __forceinline__ void a_ready(const Unit&) const {}
    __device__ __forceinline__ void done(const Unit&) const {}
};

__device__ __forceinline__ unsigned cvt_pk_bf16(float lo, float hi) { unsigned r; asm volatile("v_cvt_pk_bf16_f32 %0, %1, %2" : "=v"(r) : "v"(lo), "v"(hi)); return r; }
__device__ __forceinline__ float silu_f(float v) { return v * __builtin_amdgcn_rcpf(1.f + __expf(-v)); }
__device__ __forceinline__ float logsig_f(float z) { return fminf(z, 0.f) - log1pf(__expf(-fabsf(z))); }

__device__ __forceinline__ float row_rstd(const float* rsq, int row) {
    const f32x4* p = (const f32x4*)(rsq + (size_t)row * 16); const f32x4 a = p[0], b = p[1], c = p[2], d = p[3];
    const float s = ((a[0] + a[1]) + (a[2] + a[3])) + ((b[0] + b[1]) + (b[2] + b[3])) + (((c[0] + c[1]) + (c[2] + c[3])) + ((d[0] + d[1]) + (d[2] + d[3])));
    return 1.f / sqrtf(s * (1.f / 1024.f) + 1e-6f);
}
constexpr int IN_N = 3328;
constexpr int PROMPT_ROWS = 16384;

struct EpiIn {
    static constexpr bool PERM = true, AFTER_DRAIN = false;
    unsigned char* ws; float* out; int layer;
    size_t act_off, loga_off;
    const PG8_LAS float* rstd;
    __device__ __forceinline__ void operator()(const f32x4 (&acc)[2][2][4][2], const Unit& u, int wr, int wc, int fr, int fq, int ui) const {
        const int row0 = u.pm * BM + wr * 64 + fr; const int pn = u.pn; const int cl0 = wc * 32 + 8 * fq;
        float* fo = nullptr; int fld = 512;
        if (pn == 2) { fo = (float*)(ws + loga_off) + (size_t)row0 * 256 + cl0; fld = 256; }
        else if (pn >= 9) { const bool samp = (u.pm >= PROMPT_ROWS / BM); const bool isv = (pn >= 11);
            const size_t b = samp ? (isv ? (size_t)87162880 : (size_t)85065728) + (size_t)layer * 524288 : (isv ? (size_t)51380224 : (size_t)17825792) + (size_t)layer * 8388608;
            fo = out + b + (size_t)(row0 - (samp ? PROMPT_ROWS : 0)) * 512 + ((pn - 9) & 1) * 256 + cl0; }
        bf16_t* ab = (bf16_t*)(ws + act_off) + (size_t)row0 * IN_N + pn * BM + cl0;
        const float qsc = (pn == 7 || pn == 8) ? 0.18033688011112042f : 1.f;
#pragma unroll
        for (int ai = 0; ai < 2; ++ai)
#pragma unroll
            for (int m = 0; m < 4; ++m) { const size_t ro = (size_t)(ai * HALF + m * 16);
                const float rs = rstd[ui * BM + wr * 64 + fr + ai * HALF + m * 16] * qsc;
#pragma unroll
                for (int bj = 0; bj < 2; ++bj) { f32x4 v0 = acc[ai][bj][m][0] * rs, v1 = acc[ai][bj][m][1] * rs;
                    u32x4 w; w.x = cvt_pk_bf16(v0[0], v0[1]); w.y = cvt_pk_bf16(v0[2], v0[3]); w.z = cvt_pk_bf16(v1[0], v1[1]); w.w = cvt_pk_bf16(v1[2], v1[3]);
                    *(u32x4*)(ab + ro * IN_N + bj * HALF) = w;
                    if (fo) { *(f32x4*)(fo + ro * fld + bj * HALF) = v0; *(f32x4*)(fo + ro * fld + bj * HALF + 4) = v1; } } }
    }
};

struct EpiSwi {
    static constexpr bool PERM = true, AFTER_DRAIN = false;
    bf16_t* H; int ldh; const PG8_LAS float* rstd;
    __device__ __forceinline__ void operator()(const f32x4 (&acc)[2][2][4][2], const Unit& u, int wr, int wc, int fr, int fq, int ui) const {
        const int row0 = u.pm * BM + wr * 64 + fr; bf16_t* hb = H + (size_t)row0 * ldh + u.pn * HALF + wc * 32 + 8 * fq;
#pragma unroll
        for (int ai = 0; ai < 2; ++ai)
#pragma unroll
            for (int m = 0; m < 4; ++m) { const float rs = rstd[ui * BM + wr * 64 + fr + ai * HALF + m * 16];
                const f32x4 g0 = acc[ai][0][m][0] * rs, g1 = acc[ai][0][m][1] * rs, u0 = acc[ai][1][m][0] * rs, u1 = acc[ai][1][m][1] * rs;
                u32x4 w; w.x = cvt_pk_bf16(silu_f(g0[0]) * u0[0], silu_f(g0[1]) * u0[1]); w.y = cvt_pk_bf16(silu_f(g0[2]) * u0[2], silu_f(g0[3]) * u0[3]);
                w.z = cvt_pk_bf16(silu_f(g1[0]) * u1[0], silu_f(g1[1]) * u1[1]); w.w = cvt_pk_bf16(silu_f(g1[2]) * u1[2], silu_f(g1[3]) * u1[3]);
                *(u32x4*)(hb + (size_t)(ai * HALF + m * 16) * ldh) = w; }
    }
};

struct EpiRes {
    static constexpr bool PERM = true, AFTER_DRAIN = false;
    const float* srcp; const float* srcs; float* dst; bf16_t* xb; float* rowsq;
    __device__ __forceinline__ void operator()(const f32x4 (&acc)[2][2][4][2], const Unit& u, int wr, int wc, int fr, int fq, int ui) const {
        const int row0 = u.pm * BM + wr * 64 + fr; const int c0 = u.pn * BM + wc * 32 + 8 * fq;
        const bool samp = (u.pm >= PROMPT_ROWS / BM);
        const float* sb = (samp ? srcs + (size_t)(row0 - PROMPT_ROWS) * 1024 : srcp + (size_t)row0 * 1024) + c0;
        float* db = dst + (size_t)row0 * 1024 + c0; bf16_t* xbb = xb + (size_t)row0 * 1024 + c0;
#pragma unroll
        for (int ai = 0; ai < 2; ++ai)
#pragma unroll
            for (int m = 0; m < 4; ++m) { const size_t ro = (size_t)(ai * HALF + m * 16) * 1024; float sq = 0.f;
#pragma unroll
                for (int bj = 0; bj < 2; ++bj) { const f32x4 s0 = *(const f32x4*)(sb + ro + bj * HALF), s1 = *(const f32x4*)(sb + ro + bj * HALF + 4);
                    const f32x4 v0 = s0 + acc[ai][bj][m][0], v1 = s1 + acc[ai][bj][m][1];
                    *(f32x4*)(db + ro + bj * HALF) = v0; *(f32x4*)(db + ro + bj * HALF + 4) = v1;
                    sq += (v0[0] * v0[0] + v0[1] * v0[1]) + (v0[2] * v0[2] + v0[3] * v0[3]) + (v1[0] * v1[0] + v1[1] * v1[1]) + (v1[2] * v1[2] + v1[3] * v1[3]);
                    u32x4 w; w.x = cvt_pk_bf16(v0[0], v0[1]); w.y = cvt_pk_bf16(v0[2], v0[3]); w.z = cvt_pk_bf16(v1[0], v1[1]); w.w = cvt_pk_bf16(v1[2], v1[3]);
                    *(u32x4*)(xbb + ro + bj * HALF) = w; }
                sq += __shfl_xor(sq, 16); sq += __shfl_xor(sq, 32);
                if (fq == 0) rowsq[(size_t)(row0 + ai * HALF + m * 16) * 16 + u.pn * 4 + wc] = sq;
                if (m & 1) asm volatile("" ::: "memory"); }
    }
};
template <class Epi, class Sched, bool ALIGN_EPI = false, bool SP2 = false>
__device__ __forceinline__ void gemm_phase(PG8_LAS unsigned char* lds, const Gemm g, const Sched& S, const Epi& E) {
    int tid_ = threadIdx.x; asm volatile("" : "+v"(tid_));
    const int tid = tid_, wid = __builtin_amdgcn_readfirstlane(tid >> 6), lane = tid & 63, wr = wid >> 2, wc = wid & 3, fr = lane & 15, fq = lane >> 4;
    const int K = g.K, nt = K / BK;
    unsigned voffA[2], voffB[2];
#pragma unroll
    for (int i = 0; i < 2; ++i) { int R, C; stage_rc(tid * 16 + i * 8192, R, C); const int Rb = Epi::PERM ? ((R & ~31) + perm32(R & 31)) : R;
        voffA[i] = (unsigned)(R * K + C) * 2u; voffB[i] = (unsigned)(Rb * K + C) * 2u; }
    const size_t kstep = (size_t)(BK * 2);
    const size_t hstep = (size_t)HALF * K * 2;
    const size_t tstep = 2 * hstep;
    const unsigned ldsw = (unsigned)wid * 1024u;
    const int aoff = lds_byte(wr * 64 + fr, fq * 8), boff = lds_byte(wc * 32 + fr, fq * 8);
#define PG8_SA(b, h) (((b) * 2 + (h)) * HTB)
#define PG8_SB(b, h) ((4 + (b) * 2 + (h)) * HTB)
#define PG8_STAGE(bufoff, gbase, voff) do { _Pragma("unroll") for (int _i = 0; _i < 2; ++_i) \
        __builtin_amdgcn_global_load_lds((const unsigned*)((const char*)(gbase) + (voff)[_i]), (PG8_LAS unsigned*)(lds + (bufoff) + ldsw + _i * 8192), 16, 0, 0); } while (0)
#define PG8_LDA(dst, b, h) do { _Pragma("unroll") for (int m = 0; m < 4; ++m) _Pragma("unroll") for (int k = 0; k < 2; ++k) dst[m][k] = *(const PG8_LAS bf16x8*)(lds + PG8_SA(b, h) + aoff + m * 2048 + k * 1024); } while (0)
#define PG8_LDB(dst, b, h) do { _Pragma("unroll") for (int n = 0; n < 2; ++n) _Pragma("unroll") for (int k = 0; k < 2; ++k) dst[n][k] = *(const PG8_LAS bf16x8*)(lds + PG8_SB(b, h) + boff + n * 2048 + k * 1024); } while (0)
#define PG8_MMA(ai, bj, At, Bt) do { __builtin_amdgcn_s_setprio(1); _Pragma("unroll") for (int m = 0; m < 4; ++m) _Pragma("unroll") for (int n = 0; n < 2; ++n) _Pragma("unroll") for (int k = 0; k < 2; ++k) \
        acc[ai][bj][m][n] = __builtin_amdgcn_mfma_f32_16x16x32_bf16(Bt[n][k], At[m][k], acc[ai][bj][m][n], 0, 0, 0); __builtin_amdgcn_s_setprio(0); } while (0)
#define PG8_WAIT_V(n) asm volatile("s_waitcnt vmcnt(" #n ")" ::: "memory")
#define PG8_WAIT_L(n) asm volatile("s_waitcnt lgkmcnt(" #n ")" ::: "memory")
#define PG8_BAR __builtin_amdgcn_s_barrier()
#define PG8_SCHED __builtin_amdgcn_sched_barrier(0)
    Unit cur, nxt; int ui = 0;
    if (!S.next(0, cur)) return;
    f32x4 acc[2][2][4][2];
#pragma unroll
    for (int a = 0; a < 2; ++a)
#pragma unroll
        for (int b = 0; b < 2; ++b)
#pragma unroll
            for (int m = 0; m < 4; ++m)
#pragma unroll
                for (int n = 0; n < 2; ++n) acc[a][b][m][n] = (f32x4){0.f, 0.f, 0.f, 0.f};
    bf16x8 At[4][2], B0[2][2], B1[2][2];
    const char* cA = (const char*)g.A + (size_t)cur.pm * tstep; const char* cB = (const char*)g.Bt + (size_t)cur.pn * tstep;
    S.a_ready(cur);
    if constexpr (SP2) {
        PG8_STAGE(PG8_SB(0, 0), cB, voffB); PG8_STAGE(PG8_SB(0, 1), cB + hstep, voffB); PG8_STAGE(PG8_SA(0, 0), cA, voffA); PG8_STAGE(PG8_SA(0, 1), cA + hstep, voffA);
        if (wr == 1) PG8_BAR;
        PG8_WAIT_V(2); PG8_BAR;
        PG8_STAGE(PG8_SB(1, 0), cB + kstep, voffB); PG8_STAGE(PG8_SA(1, 0), cA + kstep, voffA); PG8_STAGE(PG8_SB(1, 1), cB + hstep + kstep, voffB);
        PG8_WAIT_V(6); PG8_BAR;
    } else {
        PG8_STAGE(PG8_SB(0, 0), cB, voffB); PG8_STAGE(PG8_SA(0, 0), cA, voffA); PG8_STAGE(PG8_SB(0, 1), cB + hstep, voffB); PG8_STAGE(PG8_SA(0, 1), cA + hstep, voffA);
        if (wr == 1) PG8_BAR;
        PG8_WAIT_V(4); PG8_BAR;
        PG8_STAGE(PG8_SB(1, 0), cB + kstep, voffB); PG8_STAGE(PG8_SA(1, 0), cA + kstep, voffA); PG8_STAGE(PG8_SB(1, 1), cB + hstep + kstep, voffB);
        PG8_WAIT_V(6); PG8_BAR;
    }
    for (;;) {
        const bool has_next = S.next(ui + 1, nxt);
        const char* nA = has_next ? (const char*)g.A + (size_t)nxt.pm * tstep : cA; const char* nB = has_next ? (const char*)g.Bt + (size_t)nxt.pn * tstep : cB;
        for (int t = 0; t < nt; t += 2) {
            const bool last = (t == nt - 2);
            const char* a1 = cA + (size_t)(t + 1) * kstep;
            const char* a2 = last ? nA : cA + (size_t)(t + 2) * kstep; const char* b2 = last ? nB : cB + (size_t)(t + 2) * kstep;
            const char* a3 = a2 + kstep; const char* b3 = b2 + kstep;
            if (last && has_next) S.a_ready(nxt);
            if constexpr (SP2) {
            PG8_LDB(B0, 0, 0); PG8_LDB(B1, 0, 1); PG8_SCHED; PG8_LDA(At, 0, 0); PG8_STAGE(PG8_SA(1, 1), a1 + hstep, voffA);
            PG8_WAIT_V(8); PG8_WAIT_L(0); PG8_BAR; PG8_MMA(0, 0, At, B0); PG8_MMA(0, 1, At, B1); PG8_BAR; PG8_SCHED;
            PG8_LDA(At, 0, 1); PG8_STAGE(PG8_SB(0, 0), b2, voffB); PG8_STAGE(PG8_SB(0, 1), b2 + hstep, voffB); PG8_STAGE(PG8_SA(0, 0), a2, voffA);
            PG8_WAIT_V(8); PG8_WAIT_L(0); PG8_BAR; PG8_MMA(1, 0, At, B0); PG8_MMA(1, 1, At, B1); PG8_BAR; PG8_SCHED;
            PG8_LDB(B0, 1, 0); PG8_LDB(B1, 1, 1); PG8_SCHED; PG8_LDA(At, 1, 0); PG8_STAGE(PG8_SA(0, 1), a2 + hstep, voffA);
            PG8_WAIT_V(8); PG8_WAIT_L(0); PG8_BAR; PG8_MMA(0, 0, At, B0); PG8_MMA(0, 1, At, B1); PG8_BAR; PG8_SCHED;
            PG8_LDA(At, 1, 1); PG8_STAGE(PG8_SB(1, 0), b3, voffB); PG8_STAGE(PG8_SB(1, 1), b3 + hstep, voffB); PG8_STAGE(PG8_SA(1, 0), a3, voffA);
            PG8_WAIT_V(8); PG8_WAIT_L(0); PG8_BAR; PG8_MMA(1, 0, At, B0); PG8_MMA(1, 1, At, B1); PG8_BAR; PG8_SCHED;
            } else {
            PG8_LDB(B0, 0, 0); PG8_SCHED; PG8_LDA(At, 0, 0); PG8_STAGE(PG8_SA(1, 1), a1 + hstep, voffA);
            PG8_WAIT_L(8); PG8_BAR; PG8_WAIT_L(0); PG8_MMA(0, 0, At, B0); PG8_BAR; PG8_SCHED;
            PG8_LDB(B1, 0, 1); PG8_STAGE(PG8_SB(0, 0), b2, voffB);
            PG8_BAR; PG8_WAIT_L(0); PG8_MMA(0, 1, At, B1); PG8_BAR;
            PG8_LDA(At, 0, 1); PG8_STAGE(PG8_SA(0, 0), a2, voffA);
            PG8_BAR; PG8_WAIT_L(0); PG8_MMA(1, 0, At, B0); PG8_BAR; PG8_SCHED;
            PG8_STAGE(PG8_SB(0, 1), b2 + hstep, voffB);
            PG8_WAIT_V(6); PG8_BAR; PG8_MMA(1, 1, At, B1); PG8_BAR;
            PG8_LDB(B0, 1, 0); PG8_SCHED; PG8_LDA(At, 1, 0); PG8_STAGE(PG8_SA(0, 1), a2 + hstep, voffA);
            PG8_WAIT_L(8); PG8_BAR; PG8_WAIT_L(0); PG8_MMA(0, 0, At, B0); PG8_BAR; PG8_SCHED;
            PG8_LDB(B1, 1, 1); PG8_STAGE(PG8_SB(1, 0), b3, voffB);
            PG8_BAR; PG8_WAIT_L(0); PG8_MMA(0, 1, At, B1); PG8_BAR;
            PG8_LDA(At, 1, 1); PG8_STAGE(PG8_SA(1, 0), a3, voffA);
            PG8_BAR; PG8_WAIT_L(0); PG8_MMA(1, 0, At, B0); PG8_BAR; PG8_SCHED;
            PG8_STAGE(PG8_SB(1, 1), b3 + hstep, voffB);
            PG8_WAIT_V(6); PG8_BAR; PG8_MMA(1, 1, At, B1); PG8_BAR;
            }
        }
        if constexpr (ALIGN_EPI) { if (wr == 0) PG8_BAR; }
        if constexpr (!Epi::AFTER_DRAIN) { E(acc, cur, wr, wc, fr, fq, ui); S.done(cur); }
        if (!has_next) break;
#pragma unroll
        for (int a = 0; a < 2; ++a)
#pragma unroll
            for (int b = 0; b < 2; ++b)
#pragma unroll
                for (int m = 0; m < 4; ++m)
#pragma unroll
                    for (int n = 0; n < 2; ++n) acc[a][b][m][n] = (f32x4){0.f, 0.f, 0.f, 0.f};
        cur = nxt; cA = nA; cB = nB; ++ui;
        if constexpr (ALIGN_EPI) { if (wr == 1) PG8_BAR; }
    }
    PG8_WAIT_V(0);
    if constexpr (!ALIGN_EPI) { if (wr == 0) PG8_BAR; }
    PG8_BAR;
    if constexpr (Epi::AFTER_DRAIN) { E.fused(acc, cur, wr, wc, fr, fq, lds, wid, lane); S.done(cur); }
#undef PG8_SA
#undef PG8_SB
#undef PG8_STAGE
#undef PG8_LDA
#undef PG8_LDB
#undef PG8_MMA
#undef PG8_WAIT_V
#undef PG8_WAIT_L
#undef PG8_BAR
#undef PG8_SCHED
}
}
constexpr int NWAVES = 8;
constexpr int DM = 1024, SEQ = 16384, DEPTH = 4, DECB = 16, DECS = 64, PAST = 4096;
constexpr int M = SEQ + DECB * DECS;
constexpr int NIN = pg8::IN_N;
constexpr int DFF = 2816, NF1 = 2 * DFF;
constexpr int WIN_ORIG = 3088;
constexpr int NCHUNK = M / 64;
constexpr int NPCH = SEQ / 64;
constexpr float RMS_EPS = 1e-6f;
constexpr size_t OY = 0, OK_P = 17825792, OV_P = 51380224, OG_P = 84934656, OK_S = 85065728, OV_S = 87162880, OG_S = 89260032, OUT_TOTAL = 91357184;

constexpr size_t MiB = 1u << 20;
constexpr size_t WS_CTL = 0, CTL_ZERO_BYTES = 1 * MiB;
constexpr size_t WS_W = 2 * MiB, W_LAYER = 25 * MiB;
constexpr size_t WO_IN = 0, WO_OUT = 6815744, WO_F1 = WO_OUT + 2 * MiB, WO_F2 = WO_F1 + 11 * MiB;
static_assert(WO_F2 + (size_t)DM * DFF * 2 == W_LAYER, "weight map");
constexpr size_t WS_X = 104 * MiB;
constexpr size_t WS_XN = 172 * MiB;
constexpr size_t WS_ACT = 206 * MiB;
constexpr size_t WS_MIX = 317 * MiB;
constexpr size_t WS_H = 351 * MiB;
constexpr size_t WS_LOGA = 445 * MiB;
constexpr size_t WS_U = 462 * MiB;
constexpr size_t WS_D = 496 * MiB;
constexpr size_t WS_SC = 497 * MiB;
constexpr size_t WS_OI = 529 * MiB;
constexpr size_t WS_QT = 563 * MiB;
constexpr size_t WS_RSQ = 576 * MiB;
constexpr size_t WS_END = 588 * MiB;
static_assert(WS_X + (size_t)M * DM * 4 <= WS_XN && WS_XN + (size_t)M * DM * 2 <= WS_ACT && WS_ACT + (size_t)M * NIN * 2 <= WS_MIX && WS_MIX + (size_t)M * DM * 2 <= WS_H &&
              WS_H + (size_t)M * DFF * 2 <= WS_LOGA && WS_LOGA + (size_t)M * 256 * 4 <= WS_U && WS_U + (size_t)NCHUNK * 4 * 64 * 128 * 4 <= WS_D && WS_D + (size_t)NCHUNK * 4 * 64 * 4 <= WS_SC &&
              WS_SC + (size_t)NPCH * 4 * 64 * 128 * 4 <= WS_OI && WS_OI + (size_t)M * 512 * 4 <= WS_QT && WS_QT + (size_t)M * 256 * 2 <= WS_RSQ && WS_RSQ + (size_t)9 * M * 64 <= WS_END, "d_ws map");
constexpr int CW_TMO = 0, CW_CODE = 1;
constexpr int CW_BAR = 4096;
constexpr int CW_QUEUE = 16384;

constexpr int RING_OFF = 0, RING_BYTES = 131072;
constexpr int LDSCTL_OFF = RING_BYTES, MISC_OFF = LDSCTL_OFF + 320;
constexpr int LDS_BYTES = 147456;

#define GAS __attribute__((address_space(1)))
#define LAS __attribute__((address_space(3)))
typedef unsigned short bf16;
typedef unsigned v4u __attribute__((ext_vector_type(4)));
typedef unsigned v2u __attribute__((ext_vector_type(2)));
typedef float f32x4 __attribute__((ext_vector_type(4)));
typedef float f32x16 __attribute__((ext_vector_type(16)));
typedef short bf16x8 __attribute__((ext_vector_type(8)));
typedef short s16x4 __attribute__((ext_vector_type(4)));
typedef GAS unsigned gu32;
#define RLX_AGENT __ATOMIC_RELAXED, __HIP_MEMORY_SCOPE_AGENT
#define LDS_WAIT() asm volatile("s_waitcnt lgkmcnt(0)" ::: "memory")
#define VM_WAIT() asm volatile("s_waitcnt vmcnt(0)" ::: "memory")
__device__ __forceinline__ unsigned f2bf(float f) { unsigned u = __builtin_bit_cast(unsigned, f); return (u + 0x7fffu + ((u >> 16) & 1u)) >> 16; }
__device__ __forceinline__ unsigned pk2(float lo, float hi) { return f2bf(lo) | (f2bf(hi) << 16); }
__device__ __forceinline__ float bf2f(unsigned short b) { return __builtin_bit_cast(float, (unsigned)b << 16); }
__device__ __forceinline__ float wave_sum(float v) {
#pragma unroll
    for (int o = 1; o < 64; o <<= 1) v += __shfl_xor(v, o);
    return v;
}
#define XB_TMO      128
#define XB_XCNT(j)  (256  + 64 * (j))
#define XB_XSUB(j)  (1280 + 64 * (j))
#define XB_XGEN(j)  (2304 + 64 * (j))
#define XB_TOP      3328
#define XB_TOPGEN   3392
#define XCD_BAR_WORDS 3456
#define XB_SPIN_CAP (1u << 18)

__device__ __forceinline__ unsigned xb_ld(unsigned* p)              { return __hip_atomic_load(p, __ATOMIC_RELAXED, __HIP_MEMORY_SCOPE_AGENT); }
__device__ __forceinline__ unsigned xb_add(unsigned* p, unsigned v) { return __hip_atomic_fetch_add(p, v, __ATOMIC_RELAXED, __HIP_MEMORY_SCOPE_AGENT); }
__device__ __forceinline__ unsigned xb_xcc_id() { return (unsigned)__builtin_amdgcn_s_getreg((3 << 11) | 20) & 0xFu; }
#define XB_SPIN(cond, bar) do { unsigned _sp = 0; while (cond) { __builtin_amdgcn_s_sleep(1); \
    if ((++_sp & 255u) == 0u) { if (xb_ld(&(bar)[XB_TMO])) break; if (_sp > XB_SPIN_CAP) { atomicAdd(&(bar)[XB_TMO], 1u); break; } } } } while (0)

struct XcdBarrier {
    unsigned* bar; unsigned x;
    volatile LAS unsigned* st;
};

__device__ __forceinline__ XcdBarrier xcd_barrier_post(unsigned* bar, volatile LAS unsigned* st) {
    XcdBarrier b; b.bar = bar; b.x = xb_xcc_id(); b.st = st;
    if (threadIdx.x == 0) (void)xb_add(&bar[XB_XCNT(b.x)], 1u);
    return b;
}
__device__ __forceinline__ void xcd_barrier_complete(unsigned* bar, unsigned x, unsigned& nloc, unsigned& nx) {
    const unsigned G = gridDim.x * gridDim.y * gridDim.z;
    unsigned sum, cnt, mine, sp = 0u;
    for (;;) {
        sum = 0u; cnt = 0u; mine = 0u;
#pragma unroll
        for (unsigned j = 0; j < 16; ++j) { const unsigned c = xb_ld(&bar[XB_XCNT(j)]); sum += c; cnt += (c > 0u) ? 1u : 0u; mine = (j == x) ? c : mine; }
        if (sum == G) break;
        __builtin_amdgcn_s_sleep(1);
        if ((++sp & 255u) == 0u) { if (xb_ld(&bar[XB_TMO])) break; if (sp > XB_SPIN_CAP) { atomicAdd(&bar[XB_TMO], 1u); break; } }
    }
    nloc = mine > 0u ? mine : 1u; nx = cnt > 0u ? cnt : 1u;
}

__device__ __forceinline__ void xcd_barrier(const XcdBarrier& b) {
    asm volatile("s_waitcnt vmcnt(0)" ::: "memory");
    __syncthreads();
    if (threadIdx.x == 0) {
        unsigned* bar = b.bar;
        __builtin_amdgcn_s_waitcnt(0);
        unsigned nloc = b.st[0], nx = b.st[1];
        if (nloc == 0u) { xcd_barrier_complete(bar, b.x, nloc, nx); b.st[0] = nloc; b.st[1] = nx; }
        const unsigned old = xb_add(&bar[XB_XSUB(b.x)], 1u);
        const unsigned gen = old / nloc;
        if (old + 1u == (gen + 1u) * nloc) {
            __builtin_amdgcn_fence(__ATOMIC_RELEASE, "agent");
            asm volatile("s_waitcnt vmcnt(0)" ::: "memory");
            const unsigned og = xb_add(&bar[XB_TOP], 1u);
            const unsigned tg = og / nx;
            if (og + 1u == (tg + 1u) * nx) xb_add(&bar[XB_TOPGEN], 1u);
            else XB_SPIN(xb_ld(&bar[XB_TOPGEN]) == tg, bar);
            __builtin_amdgcn_fence(__ATOMIC_ACQUIRE, "agent");
            xb_add(&bar[XB_XGEN(b.x)], 1u);
            asm volatile("s_waitcnt vmcnt(0)" ::: "memory");
        } else {
            XB_SPIN(xb_ld(&bar[XB_XGEN(b.x)]) == gen, bar);
            __builtin_amdgcn_fence(__ATOMIC_ACQUIRE, "agent");
            asm volatile("s_waitcnt vmcnt(0)" ::: "memory");
        }
    }
    __syncthreads();
}
struct Frame {
    LAS unsigned char* lds;
};
__device__ __forceinline__ int grid_n() { return (int)gridDim.x; }
__device__ __forceinline__ int vcu_id() { const int G = (int)gridDim.x, bx = (int)blockIdx.x; return (G % 8 == 0) ? (bx % 8) * (G / 8) + bx / 8 : bx; }
__device__ __forceinline__ int fresh_tid() { int t = threadIdx.x; asm volatile("" : "+v"(t)); return t; }

__device__ __forceinline__ void tr_store(LAS float* scr, bf16* WT, int K, int dstrow0, int k0, int lane) {
    LDS_WAIT(); asm volatile("" ::: "memory");
    const int c = lane & 7;
#pragma unroll
    for (int j = 0; j < 4; ++j) { const int n = (lane >> 3) + 8 * j; const LAS float* s = scr + (8 * c) * 33 + n;
        v4u o; o.x = pk2(s[0 * 33], s[1 * 33]); o.y = pk2(s[2 * 33], s[3 * 33]); o.z = pk2(s[4 * 33], s[5 * 33]); o.w = pk2(s[6 * 33], s[7 * 33]);
        *(GAS v4u*)(WT + (size_t)(dstrow0 + n) * K + k0 + 8 * c) = o; }
    LDS_WAIT(); asm volatile("" ::: "memory");
}
__device__ __forceinline__ void tr_item(const float* W, int ld, int K, int srccol0, bf16* WT, int dstrow0, int k0, LAS float* scr, int lane, const float* gk) {
    const int ks = lane >> 3, nq = (lane & 7) * 4; f32x4 v[8];
#pragma unroll
    for (int i = 0; i < 8; ++i) v[i] = *(const f32x4*)(W + (size_t)(k0 + 8 * i + ks) * ld + srccol0 + nq);
#pragma unroll
    for (int i = 0; i < 8; ++i) { const int kk = 8 * i + ks; f32x4 x = v[i]; if (gk) x = x * gk[k0 + kk];
        LAS float* d = scr + kk * 33 + nq; d[0] = x[0]; d[1] = x[1]; d[2] = x[2]; d[3] = x[3]; }
    tr_store(scr, WT, K, dstrow0, k0, lane);
}
__device__ __forceinline__ void tr_item_z(const float* Win, const float* a2, int n0z, bf16* WT, int k0, LAS float* scr, int lane, const float* gk) {
    float av[16];
#pragma unroll
    for (int r = 0; r < 16; ++r) av[r] = a2[r * 256 + n0z + (lane & 31)];
#pragma unroll 8
    for (int i = 0; i < 32; ++i) { const int kk = 2 * i + (lane >> 5); const float* wr_ = Win + (size_t)(k0 + kk) * WIN_ORIG + 1536; float s = 0.f;
#pragma unroll
        for (int r = 0; r < 16; ++r) s = fmaf(wr_[r], av[r], s);
        scr[kk * 33 + (lane & 31)] = s * gk[k0 + kk]; }
    tr_store(scr, WT, DM, 512 + n0z, k0, lane);
}

struct Args { const float* in[18]; float* out; unsigned char* ws; };
constexpr int PTAB_OFF = MISC_OFF + 128;
__device__ __forceinline__ const float* inp(const Frame& F, int i) {
    unsigned off = (unsigned)(PTAB_OFF + 8 * i); asm volatile("" : "+v"(off));
    const volatile LAS unsigned* t = (const volatile LAS unsigned*)(F.lds + off);
    const unsigned lo = __builtin_amdgcn_readfirstlane(t[0]), hi = __builtin_amdgcn_readfirstlane(t[1]);
    return (const float*)(((unsigned long long)hi << 32) | lo);
}
__device__ __forceinline__ float* outp(const Frame& F) { return (float*)inp(F, 18); }
__device__ __forceinline__ unsigned char* wsp(const Frame& F) { return (unsigned char*)inp(F, 19); }

__device__ __forceinline__ void p0_prologue(Frame& F) {
    const int tid_ = fresh_tid(), lane_ = tid_ & 63, wave_ = __builtin_amdgcn_readfirstlane(tid_ >> 6);
    LAS float* scr = (LAS float*)(F.lds + RING_OFF + wave_ * 16384);
    const int gw = vcu_id() * NWAVES + wave_, NGW = grid_n() * NWAVES;
    constexpr int I_IN = 16 * 104, I_OUT = 16 * 32, I_F1 = 16 * 176, I_F2 = 44 * 32, I_L = I_IN + I_OUT + I_F1 + I_F2;
    for (int it = gw; it < DEPTH * I_L; it += NGW) {
        const int l = it / I_L; int r = it % I_L;
        unsigned char* wl = wsp(F) + WS_W + (size_t)l * W_LAYER;
        if (r < I_IN) { const int kb = r / 104, nb = r % 104, n0 = 32 * nb; const float* W = inp(F, 5) + (size_t)l * DM * WIN_ORIG;
            if (n0 >= 512 && n0 < 768) tr_item_z(W, inp(F, 6) + (size_t)l * 16 * 256, n0 - 512, (bf16*)(wl + WO_IN), 64 * kb, scr, lane_, inp(F, 12) + (size_t)l * DM);
            else { const int src = n0 < 512 ? n0 : (n0 < 1792 ? n0 - 256 : n0 - 240); tr_item(W, WIN_ORIG, DM, src, (bf16*)(wl + WO_IN), n0, 64 * kb, scr, lane_, inp(F, 12) + (size_t)l * DM); }
            continue; }
        r -= I_IN;
        if (r < I_OUT) { const int kb = r / 32, nb = r % 32; tr_item(inp(F, 11) + (size_t)l * DM * DM, DM, DM, 32 * nb, (bf16*)(wl + WO_OUT), 32 * nb, 64 * kb, scr, lane_, nullptr); continue; }
        r -= I_OUT;
        if (r < I_F1) { const int kb = r / 176, nb = r % 176, n0 = 32 * nb, pn = n0 >> 8, j = n0 & 255; const int src = j < 128 ? 128 * pn + j : DFF + 128 * pn + (j - 128);
            tr_item(inp(F, 14) + (size_t)l * DM * NF1, NF1, DM, src, (bf16*)(wl + WO_F1), n0, 64 * kb, scr, lane_, inp(F, 13) + (size_t)l * DM); continue; }
        r -= I_F1;
        { const int kb = r / 32, nb = r % 32; tr_item(inp(F, 15) + (size_t)l * DFF * DM, DM, DFF, 32 * nb, (bf16*)(wl + WO_F2), 32 * nb, 64 * kb, scr, lane_, nullptr); }
    }
}

__device__ __forceinline__ void rows_to_bf16_sq(Frame& F, const float* srcp, const float* srcs, bf16* XB, float* rowsq) {
    const int tid_ = fresh_tid(), lane_ = tid_ & 63, wave_ = __builtin_amdgcn_readfirstlane(tid_ >> 6);
    const int gw = vcu_id() * NWAVES + wave_, NGW = grid_n() * NWAVES;
    for (int m = gw; m < M; m += NGW) {
        const float* xrow = m < SEQ ? srcp + (size_t)m * DM : srcs + (size_t)(m - SEQ) * DM;
        const GAS f32x4* xr = (const GAS f32x4*)xrow + lane_;
        f32x4 v[4]; float s = 0.f;
#pragma unroll
        for (int j = 0; j < 4; ++j) { v[j] = xr[64 * j]; s += (v[j].x * v[j].x + v[j].y * v[j].y) + (v[j].z * v[j].z + v[j].w * v[j].w); }
        s = wave_sum(s);
        GAS unsigned long long* o8 = (GAS unsigned long long*)(XB + (size_t)m * DM) + lane_;
#pragma unroll
        for (int j = 0; j < 4; ++j) o8[64 * j] = (unsigned long long)pk2(v[j].x, v[j].y) | ((unsigned long long)pk2(v[j].z, v[j].w) << 32);
        if (lane_ < 16) rowsq[(size_t)m * 16 + lane_] = lane_ == 0 ? s : 0.f;
    }
}
__device__ __forceinline__ void norm_rows_f32(Frame& F, const float* src, const float* g, float* out) {
    const int tid_ = fresh_tid(), lane_ = tid_ & 63, wave_ = __builtin_amdgcn_readfirstlane(tid_ >> 6);
    const int gw = vcu_id() * NWAVES + wave_, NGW = grid_n() * NWAVES;
    f32x4 gv[4];
#pragma unroll
    for (int j = 0; j < 4; ++j) gv[j] = ((const GAS f32x4*)g)[lane_ + 64 * j];
    for (int m = gw; m < M; m += NGW) {
        const GAS f32x4* xr = (const GAS f32x4*)(src + (size_t)m * DM) + lane_;
        f32x4 v[4]; float s = 0.f;
#pragma unroll
        for (int j = 0; j < 4; ++j) { v[j] = xr[64 * j]; s += (v[j].x * v[j].x + v[j].y * v[j].y) + (v[j].z * v[j].z + v[j].w * v[j].w); }
        const float rstd = 1.f / sqrtf(wave_sum(s) * (1.f / DM) + RMS_EPS);
        GAS f32x4* o = (GAS f32x4*)(out + (size_t)m * DM) + lane_;
#pragma unroll
        for (int j = 0; j < 4; ++j) o[64 * j] = v[j] * rstd * gv[j];
    }
}

constexpr int RSTD_OFF = MISC_OFF + 512;
static_assert(RSTD_OFF + 8 * 256 * 4 <= LDS_BYTES, "rstd table");
__device__ __forceinline__ void rstd_prepass(Frame& F, const pg8::StaticOrder& S, const float* rsq) {
    const int tid_ = fresh_tid(); LAS float* tab = (LAS float*)(F.lds + RSTD_OFF);
    for (int idx = tid_; idx < 8 * 256; idx += NWAVES * 64) { pg8::Unit u; if (!S.next(idx >> 8, u)) break; tab[idx] = pg8::row_rstd(rsq, u.pm * 256 + (idx & 255)); }
    __syncthreads();
}

namespace att {
typedef float f32x8 __attribute__((ext_vector_type(8)));
typedef unsigned u32x4 __attribute__((ext_vector_type(4)));
constexpr float THRL = 8.f * 1.4426950408889634f;
constexpr int SHM_V = 16384, SHM_K = 16384;
constexpr int OFF_V = 0, OFF_K = 2 * SHM_V;
constexpr int RK = 0, RV = 3 * SHM_K;
constexpr int OFF_WS = 6 * SHM_K, OFF_TAB = OFF_WS + 2048, TAB_N = 384, OFF_LAM = OFF_TAB + 4 * TAB_N * 4, OFF_G3 = OFF_LAM + 256, OFF_QL = OFF_G3 + 1024, OFF_END = OFF_QL + 4 * 4096;
static_assert(OFF_END <= RING_BYTES, "attention LDS map");
#define KSWZ(row, colB) ((row) * 256 + ((colB) ^ (((row) & 7) << 4)))
#define SBAR() __builtin_amdgcn_sched_barrier(0)
__device__ __forceinline__ int crow(int r, int hi) { return (r & 3) + 8 * (r >> 2) + 4 * hi; }
__device__ __forceinline__ unsigned cvtpk(float lo, float hi) { unsigned r; asm volatile("v_cvt_pk_bf16_f32 %0, %1, %2" : "=v"(r) : "v"(lo), "v"(hi)); return r; }
template <bool F32> struct Stage;
template <> struct Stage<false> { using E = bf16; using T = bf16x8;
  __device__ static __forceinline__ T ld8(const E* p) { return *reinterpret_cast<const bf16x8*>(p); }
  __device__ static __forceinline__ bf16x8 tobf(T x) { return x; } };
template <> struct Stage<true> { using E = float; using T = f32x8;
  __device__ static __forceinline__ T ld8(const E* p) { return *reinterpret_cast<const f32x8*>(p); }
  __device__ static __forceinline__ bf16x8 tobf(T x) { u32x4 w = {cvtpk(x[0], x[1]), cvtpk(x[2], x[3]), cvtpk(x[4], x[5]), cvtpk(x[6], x[7])}; return __builtin_bit_cast(bf16x8, w); } };

__device__ __forceinline__ float rowmax32(const f32x16& p0, const f32x16& p1) {
  float pmax = p0[0];
#pragma unroll
  for (int r = 1; r < 16; ++r) pmax = fmaxf(pmax, p0[r]);
#pragma unroll
  for (int r = 0; r < 16; ++r) pmax = fmaxf(pmax, p1[r]);
  auto rr = __builtin_amdgcn_permlane32_swap(__float_as_uint(pmax), __float_as_uint(pmax), false, false);
  return fmaxf(__uint_as_float(rr[0]), __uint_as_float(rr[1]));
}
__device__ __forceinline__ void partialSM(f32x16& p0, f32x16& p1, float& m_reg, float& mn, float& alpha) {
  const float pmax = rowmax32(p0, p1);
  if (__builtin_expect(__all(pmax - m_reg <= THRL), 1)) { mn = m_reg; alpha = 1.f; }
  else { mn = fmaxf(m_reg, pmax); alpha = __builtin_amdgcn_exp2f(m_reg - mn); m_reg = mn; }
#pragma unroll
  for (int r = 0; r < 16; ++r) p0[r] -= mn;
#pragma unroll
  for (int r = 0; r < 16; ++r) p1[r] -= mn;
#pragma unroll
  for (int r = 0; r < 16; ++r) p0[r] = __builtin_amdgcn_exp2f(p0[r]);
}
__device__ __forceinline__ void finishSM(f32x16& p0, f32x16& p1, float alpha, float& l_reg, bf16x8& pa0, bf16x8& pa1, bf16x8& pa2, bf16x8& pa3) {
#pragma unroll
  for (int r = 0; r < 16; ++r) p1[r] = __builtin_amdgcn_exp2f(p1[r]);
  float ps = 0;
#pragma unroll
  for (int r = 0; r < 16; ++r) ps += p0[r];
#pragma unroll
  for (int r = 0; r < 16; ++r) ps += p1[r];
  { auto rr = __builtin_amdgcn_permlane32_swap(__float_as_uint(ps), __float_as_uint(ps), false, false);
    ps = __uint_as_float(rr[0]) + __uint_as_float(rr[1]); }
  l_reg = l_reg * alpha + ps;
#define PK4(P, BASE, OUT) do { unsigned a0 = cvtpk(P[BASE + 0], P[BASE + 1]), a1 = cvtpk(P[BASE + 2], P[BASE + 3]);   \
    unsigned b0 = cvtpk(P[BASE + 4], P[BASE + 5]), b1 = cvtpk(P[BASE + 6], P[BASE + 7]);                              \
    auto r0 = __builtin_amdgcn_permlane32_swap(a0, b0, false, false); auto r1 = __builtin_amdgcn_permlane32_swap(a1, b1, false, false); \
    u32x4 w = {r0[0], r1[0], r0[1], r1[1]}; OUT = __builtin_bit_cast(bf16x8, w); } while (0)
  PK4(p0, 0, pa0); PK4(p0, 8, pa1); PK4(p1, 0, pa2); PK4(p1, 8, pa3);
#undef PK4
}
template <bool QL>
__device__ __forceinline__ void qkt(f32x16& p0, f32x16& p1, const LAS char* Ks, const bf16x8* qr, const LAS char* ql, int r32, int hi, int g) {
  p0 = f32x16{}; p1 = f32x16{};
#pragma unroll
  for (int d0 = 0; d0 < 4; ++d0) { const int cb = ((g * 4 + d0) * 16 + hi * 8) * 2;
    const bf16x8 b0 = *(const LAS bf16x8*)(Ks + KSWZ(r32, cb));
    const bf16x8 b1 = *(const LAS bf16x8*)(Ks + KSWZ(32 + r32, cb));
    bf16x8 q; if constexpr (QL) q = *(const LAS bf16x8*)(ql + d0 * 1024); else q = qr[d0];
    p0 = __builtin_amdgcn_mfma_f32_32x32x16_bf16(b0, q, p0, 0, 0, 0);
    p1 = __builtin_amdgcn_mfma_f32_32x32x16_bf16(b1, q, p1, 0, 0, 0); }
}
__device__ __forceinline__ int v_st(int k, int c) { const int kk = (k & ~0xC) | ((k & 4) << 1) | ((k & 8) >> 1); return ((kk >> 3) * 4 + (c >> 5)) * 512 + ((kk & 7) * 32 + (c & 31)) * 2; }
__device__ __forceinline__ int v_rd_base(int lane) { return ((lane & 3) << 3) | (((lane >> 2) & 3) << 6) | (((lane >> 4) & 1) << 5) | (((lane >> 5) & 1) << 8); }
constexpr int v_rd_off(int d0, int ks, int half) { return d0 * 512 + ks * 4096 + half * 2048; }
typedef short v4i16_t __attribute__((ext_vector_type(4)));
template <int OFF> __device__ __forceinline__ s16x4 tr_read(const LAS char* vb) {
  return __builtin_bit_cast(s16x4, __builtin_amdgcn_ds_read_tr16_b64_v4i16((LAS v4i16_t*)(vb + OFF)));
}
template <int D0> __device__ __forceinline__ void pv_one(f32x16& od, const LAS char* vb, bf16x8 pa0, bf16x8 pa1, bf16x8 pa2, bf16x8 pa3) {
  const s16x4 l0 = tr_read<v_rd_off(D0, 0, 0)>(vb), h0 = tr_read<v_rd_off(D0, 0, 1)>(vb), l1 = tr_read<v_rd_off(D0, 1, 0)>(vb), h1 = tr_read<v_rd_off(D0, 1, 1)>(vb);
  const s16x4 l2 = tr_read<v_rd_off(D0, 2, 0)>(vb), h2 = tr_read<v_rd_off(D0, 2, 1)>(vb), l3 = tr_read<v_rd_off(D0, 3, 0)>(vb), h3 = tr_read<v_rd_off(D0, 3, 1)>(vb);
#define PK(L, H) (bf16x8){L[0], L[1], L[2], L[3], H[0], H[1], H[2], H[3]}
  od = __builtin_amdgcn_mfma_f32_32x32x16_bf16(pa0, PK(l0, h0), od, 0, 0, 0);
  od = __builtin_amdgcn_mfma_f32_32x32x16_bf16(pa1, PK(l1, h1), od, 0, 0, 0);
  od = __builtin_amdgcn_mfma_f32_32x32x16_bf16(pa2, PK(l2, h2), od, 0, 0, 0);
  od = __builtin_amdgcn_mfma_f32_32x32x16_bf16(pa3, PK(l3, h3), od, 0, 0, 0);
#undef PK
}
__device__ __forceinline__ void pv_d0(f32x16* o, const LAS char* vb, bf16x8 pa0, bf16x8 pa1, bf16x8 pa2, bf16x8 pa3) {
  pv_one<0>(o[0], vb, pa0, pa1, pa2, pa3); pv_one<1>(o[1], vb, pa0, pa1, pa2, pa3); pv_one<2>(o[2], vb, pa0, pa1, pa2, pa3); pv_one<3>(o[3], vb, pa0, pa1, pa2, pa3);
}

__device__ __forceinline__ int t5_bucket(int rel) {
  const int ret = rel > 0 ? 16 : 0; const int n = rel < 0 ? -rel : rel;
  if (n < 8) return ret + n;
  int large = 8 + (31 - __builtin_clz((unsigned)(n * n))) - 6; if (large > 15) large = 15;
  return ret + large;
}
__device__ __forceinline__ void attn_setup(LAS unsigned char* lds, const float* rel_bias, const float* lamp  , int layer) {
  const int tid = fresh_tid();
  LAS float* tab = (LAS float*)(lds + OFF_TAB);
  for (int e = tid; e < 4 * TAB_N; e += 512) { const int h = e / TAB_N, idx = e % TAB_N, rel = idx - 255;
    tab[e] = (rel_bias[t5_bucket(rel) * 4 + h] - rel_bias[15 * 4 + h]) * 1.4426950408889634f; }
  if (tid < 64) { const float a = lamp[tid] * lamp[64 + tid], b = lamp[128 + tid] * lamp[192 + tid];
    const float sa = wave_sum(a), sb = wave_sum(b);
    if (tid == 0) { const float lam_init = 0.8f - 0.6f * expf(-0.3f * (float)layer);
      ((LAS float*)(lds + OFF_LAM))[0] = expf(sa) - expf(sb) + lam_init; ((LAS float*)(lds + OFF_LAM))[1] = 1.f - lam_init; } }
  __syncthreads();
}


__device__ __forceinline__ void glds16(const void* gsrc, unsigned lds_dst) { unsigned keep;
  asm volatile("s_mov_b32 %0, m0\n\ts_mov_b32 m0, %2\n\ts_nop 0\n\tglobal_load_lds_dwordx4 %1, off\n\ts_mov_b32 m0, %0" : "=&s"(keep) : "v"(gsrc), "s"(lds_dst) : "memory"); }
__device__ __forceinline__ void attn_unit_prompt(LAS unsigned char* lds, const bf16* Kg, const bf16* Vg, const bf16* Qrow0, bf16* Orow0, int NT, int qpos0, int h, const float* gnorm) {
  constexpr int LDK = 3328;
  const int tid = fresh_tid(), wid = __builtin_amdgcn_readfirstlane(tid >> 6), lane = tid & 63, r32 = lane & 31, hi = lane >> 5;
  const int g = wid >> 2, rb = wid & 3;
  LAS char* K_lds = (LAS char*)lds + RK; LAS char* V_lds = (LAS char*)lds + RV;
  LAS float* wsf = (LAS float*)(lds + OFF_WS) + wid * 64; LAS float* li_l = wsf; LAS float* al_l = wsf + 32;
  const LAS float* tab = (const LAS float*)(lds + OFF_TAB) + h * TAB_N;
  float mhat = 0.f, l_reg = 0.f; f32x16 o[4] = {}; bf16x8 qr[4];
  f32x16 negm = {};
  const bf16* Qw = Qrow0 + (size_t)(rb * 32 + r32) * 3328 + g * 64 + hi * 8;
#pragma unroll
  for (int d0 = 0; d0 < 4; ++d0) qr[d0] = *reinterpret_cast<const bf16x8*>(Qw + d0 * 16);
  const int qpos = qpos0 + rb * 32 + r32;
  unsigned kso0, vso0;
  { const int row = 8 * wid + (lane >> 4); kso0 = (unsigned)(row * LDK * 2 + (((lane & 15) ^ (row & 7)) << 4));
    const int kk = wid * 8 + ((lane & 31) >> 2), k = (kk & ~0xC) | ((kk & 4) << 1) | ((kk & 8) >> 1), c = (lane >> 5) * 32 + (lane & 3) * 8; vso0 = (unsigned)((k * LDK + c) * 2); }
#define KSO(p_) ((p_) == 0 ? kso0 : kso0 + (unsigned)(4 * LDK * 2) + ((kso0 & 64u) ? (unsigned)-64 : 64u))
#define VSO(p_) (vso0 + (unsigned)((p_) * 128))
  const int pw = wid * 2048; const unsigned kl0 = (unsigned)(uintptr_t)K_lds, vl0 = (unsigned)(uintptr_t)V_lds;
#define DMA_K(t, so) do { const char* kb_ = (const char*)(Kg + (size_t)(t) * 64 * LDK); _Pragma("unroll") for (int p_ = 0; p_ < 2; ++p_) \
    glds16(kb_ + KSO(p_), (unsigned)__builtin_amdgcn_readfirstlane((int)(kl0 + (unsigned)((so) + pw + p_ * 1024)))); } while (0)
#define DMA_V(t, so) do { const char* vb_ = (const char*)(Vg + (size_t)(t) * 64 * LDK); _Pragma("unroll") for (int p_ = 0; p_ < 2; ++p_) \
    glds16(vb_ + VSO(p_), (unsigned)__builtin_amdgcn_readfirstlane((int)(vl0 + (unsigned)((so) + pw + p_ * 1024)))); } while (0)
#define WAITBAR(j) do { if ((j) + 2 < NT) asm volatile("s_waitcnt vmcnt(4)\n\ts_barrier" ::: "memory"); else asm volatile("s_waitcnt vmcnt(0)\n\ts_barrier" ::: "memory"); } while (0)
#define RESC(a) do { if (__any((a) < 1.f)) { if (hi == 0) al_l[r32] = (a); asm volatile("s_waitcnt lgkmcnt(0)" ::: "memory"); \
    _Pragma("unroll") for (int d = 0; d < 4; ++d) _Pragma("unroll") for (int r = 0; r < 16; ++r) o[d][r] *= al_l[crow(r, hi)]; } } while (0)
#define QKT(P0, P1, Ks) do { const LAS char* ks_ = (Ks); _Pragma("unroll") for (int d0 = 0; d0 < 4; ++d0) { const int cb = ((g * 4 + d0) * 16 + hi * 8) * 2; \
      const bf16x8 b0 = *(const LAS bf16x8*)(ks_ + KSWZ(r32, cb)); const bf16x8 b1 = *(const LAS bf16x8*)(ks_ + KSWZ(32 + r32, cb)); \
      if (d0 == 0) { P0 = __builtin_amdgcn_mfma_f32_32x32x16_bf16(b0, qr[0], negm, 0, 0, 0); P1 = __builtin_amdgcn_mfma_f32_32x32x16_bf16(b1, qr[0], negm, 0, 0, 0); } \
      else { P0 = __builtin_amdgcn_mfma_f32_32x32x16_bf16(b0, qr[d0], P0, 0, 0, 0); P1 = __builtin_amdgcn_mfma_f32_32x32x16_bf16(b1, qr[d0], P1, 0, 0, 0); } } } while (0)
#define PARTIAL(P0, P1, AL, FIRST) do { const float rm_ = rowmax32(P0, P1); AL = 1.f; \
    if ((FIRST) || __any(rm_ > THRL)) { const float dl_ = (FIRST) ? rm_ : fmaxf(rm_, 0.f); mhat += dl_; \
      _Pragma("unroll") for (int r = 0; r < 16; ++r) { P0[r] -= dl_; P1[r] -= dl_; } \
      _Pragma("unroll") for (int r = 0; r < 16; ++r) negm[r] = -mhat; \
      if (!(FIRST)) { AL = __builtin_amdgcn_exp2f(-dl_); l_reg *= AL; } } \
    _Pragma("unroll") for (int r = 0; r < 16; ++r) P0[r] = __builtin_amdgcn_exp2f(P0[r]); } while (0)
#define FINISH(P0, P1) do { _Pragma("unroll") for (int r = 0; r < 16; ++r) P1[r] = __builtin_amdgcn_exp2f(P1[r]); \
    { float ps_ = 0.f; _Pragma("unroll") for (int r = 0; r < 16; ++r) ps_ += P0[r]; _Pragma("unroll") for (int r = 0; r < 16; ++r) ps_ += P1[r]; \
      auto rr_ = __builtin_amdgcn_permlane32_swap(__float_as_uint(ps_), __float_as_uint(ps_), false, false); l_reg += __uint_as_float(rr_[0]) + __uint_as_float(rr_[1]); } \
    PK4_(P0, 0, pa0); PK4_(P0, 8, pa1); PK4_(P1, 0, pa2); PK4_(P1, 8, pa3); } while (0)
#define PK4_(P, BASE, OUT) do { unsigned a0 = cvtpk(P[BASE + 0], P[BASE + 1]), a1 = cvtpk(P[BASE + 2], P[BASE + 3]);   \
    unsigned b0 = cvtpk(P[BASE + 4], P[BASE + 5]), b1 = cvtpk(P[BASE + 6], P[BASE + 7]);                              \
    auto r0 = __builtin_amdgcn_permlane32_swap(a0, b0, false, false); auto r1 = __builtin_amdgcn_permlane32_swap(a1, b1, false, false); \
    u32x4 w = {r0[0], r1[0], r0[1], r1[1]}; OUT = __builtin_bit_cast(bf16x8, w); } while (0)
#define PV(vp) do { const LAS char* vp_ = (vp); pv_d0(o, vp_, pa0, pa1, pa2, pa3); } while (0)
#define BIASMASK(P0, P1, j) do { if ((j) >= NT - 4) { const bool msk_ = ((j) == NT - 1 && rb < 2); \
    if (msk_) { _Pragma("unroll") for (int r = 0; r < 16; ++r) { P0[r] = -1e30f; P1[r] = -1e30f; } } \
    else { const int base_ = 64 * (j) - qpos + 255 + 4 * hi; \
      _Pragma("unroll") for (int r = 0; r < 16; ++r) { const int i0_ = base_ + (r & 3) + 8 * (r >> 2); P0[r] += tab[i0_]; P1[r] += tab[i0_ + 32]; } } } } while (0)
#define ROT() do { const int t_ = s0; s0 = s1; s1 = s2; s2 = t_; } while (0)
  const LAS char* vrd = V_lds + v_rd_base(lane);
  f32x16 pA0, pA1, pB0, pB1; float alA = 1.f, alB = 1.f; bf16x8 pa0, pa1, pa2, pa3;
  int s0 = 2 * SHM_K, s1 = 0, s2 = SHM_K;
  asm volatile("s_waitcnt vmcnt(0)" ::: "memory");
  DMA_K(0, 0); DMA_K(1, SHM_K); DMA_V(0, 0);
  WAITBAR(0); DMA_K(2, s0); DMA_V(1, s2);
  QKT(pA0, pA1, K_lds + s1); BIASMASK(pA0, pA1, 0); PARTIAL(pA0, pA1, alA, true);
  ROT();
  for (int j = 1; j + 1 < NT; j += 2) {
    WAITBAR(j); if (j + 2 < NT) DMA_K(j + 2, s0); DMA_V(j + 1, s2);
    QKT(pB0, pB1, K_lds + s1); FINISH(pA0, pA1);
    PV(vrd + s0); BIASMASK(pB0, pB1, j); PARTIAL(pB0, pB1, alB, false); RESC(alB);
    ROT();
    WAITBAR(j + 1); if (j + 3 < NT) DMA_K(j + 3, s0); if (j + 2 < NT) DMA_V(j + 2, s2);
    QKT(pA0, pA1, K_lds + s1); FINISH(pB0, pB1);
    PV(vrd + s0); BIASMASK(pA0, pA1, j + 1); PARTIAL(pA0, pA1, alA, false); RESC(alA);
    ROT();
  }
  WAITBAR(NT - 1);
  QKT(pB0, pB1, K_lds + s1); FINISH(pA0, pA1);
  PV(vrd + s0); BIASMASK(pB0, pB1, NT - 1); PARTIAL(pB0, pB1, alB, false); RESC(alB);
  FINISH(pB0, pB1);
  PV(vrd + s1);
#undef DMA_K
#undef DMA_V
#undef KSO
#undef VSO
#undef WAITBAR
#undef RESC
#undef BIASMASK
#undef ROT
#undef QKT
#undef PARTIAL
#undef FINISH
#undef PK4_
#undef PV
  if (hi == 0) li_l[r32] = l_reg;
  asm volatile("s_waitcnt lgkmcnt(0)" ::: "memory");
  float rli[16];
#pragma unroll
  for (int r = 0; r < 16; ++r) rli[r] = __builtin_amdgcn_rcpf(li_l[crow(r, hi)]);
  __syncthreads();
  LAS float* X = (LAS float*)lds + rb * 4096 + lane;
  if (g == 1) {
#pragma unroll
    for (int r = 0; r < 16; ++r)
#pragma unroll
      for (int d0 = 0; d0 < 4; ++d0) X[(r * 4 + d0) * 64] = o[d0][r] * rli[r];
  }
  __syncthreads();
  if (g == 0) {
    const float lam = ((const LAS float*)(lds + OFF_LAM))[0], osc = ((const LAS float*)(lds + OFF_LAM))[1];
    float ss[16];
#pragma unroll
    for (int r = 0; r < 16; ++r) { float s = 0.f;
#pragma unroll
      for (int d0 = 0; d0 < 4; ++d0) { const float od = o[d0][r] * rli[r] - lam * X[(r * 4 + d0) * 64]; o[d0][r] = od; s += od * od; }
      ss[r] = s; }
#pragma unroll
    for (int r = 0; r < 16; ++r) { float s = ss[r]; s += __shfl_xor(s, 1); s += __shfl_xor(s, 2); s += __shfl_xor(s, 4); s += __shfl_xor(s, 8); s += __shfl_xor(s, 16);
      ss[r] = osc / sqrtf(s * (1.f / 128.f) + RMS_EPS); }
    float gn[4];
#pragma unroll
    for (int d0 = 0; d0 < 4; ++d0) gn[d0] = gnorm[d0 * 32 + r32];
    bf16* Ow = Orow0 + (size_t)(rb * 32) * 1024 + r32;
#pragma unroll
    for (int r = 0; r < 16; ++r) { const int orow = crow(r, hi);
#pragma unroll
      for (int d0 = 0; d0 < 4; ++d0) Ow[(size_t)orow * 1024 + d0 * 32] = (bf16)f2bf(o[d0][r] * ss[r] * gn[d0]); }
  }
  __syncthreads();
}

__device__ __forceinline__ void attn_unit_sample(LAS unsigned char* lds, const float* Kg, const float* Vg, const float* Kl, const float* Vl, const bf16* Qrow0, bf16* Orow0,
                                                 int qpos0, int h, const float* gnorm) {
  using St = Stage<true>; constexpr int LDK = 512, NT = 65;
  const int tid = fresh_tid(), wid = __builtin_amdgcn_readfirstlane(tid >> 6), lane = tid & 63, r32 = lane & 31, hi = lane >> 5;
  const int g = wid & 1, rb = (wid >> 1) & 1; const bool live = wid < 4;
  LAS char* V_lds = (LAS char*)lds + OFF_V; LAS char* K_lds = (LAS char*)lds + OFF_K;
  LAS float* wsf = (LAS float*)(lds + OFF_WS) + wid * 64; LAS float* li_l = wsf; LAS float* al_l = wsf + 32;
  const LAS float* tab = (const LAS float*)(lds + OFF_TAB) + h * TAB_N;
  float l_reg = 0; f32x16 o[4] = {};
#define BARRIER1() asm volatile("s_waitcnt lgkmcnt(0)\n\ts_barrier" ::: "memory")
  if (!live) {
    const int lt = tid - 256, sr = lt >> 4, sc = (lt & 15) * 8;
    typename St::T A[8], B[8];
#define LLOAD(X, t) do { const float* kb_ = (t) < 64 ? Kg + (size_t)(t) * 64 * LDK : Kl; const float* vb_ = (t) < 64 ? Vg + (size_t)(t) * 64 * LDK : Vl; \
      _Pragma("unroll") for (int i_ = 0; i_ < 4; ++i_) { X[i_] = St::ld8(vb_ + (size_t)(sr + 16 * i_) * LDK + sc); X[4 + i_] = St::ld8(kb_ + (size_t)(sr + 16 * i_) * LDK + sc); } } while (0)
#define LWRITE(X, b) do { _Pragma("unroll") for (int i_ = 0; i_ < 4; ++i_) { *(LAS bf16x8*)(V_lds + (b) * SHM_V + v_st(sr + 16 * i_, sc)) = St::tobf(X[i_]); \
      *(LAS bf16x8*)(K_lds + (b) * SHM_K + KSWZ(sr + 16 * i_, sc * 2)) = St::tobf(X[4 + i_]); } } while (0)
    LLOAD(A, 0); LLOAD(B, 1);
    asm volatile("s_waitcnt vmcnt(16)" ::: "memory"); LWRITE(A, 0); BARRIER1();
    for (int t = 0; t < NT; t += 2) {
      if (t + 2 < NT) LLOAD(A, t + 2);
      if (t + 1 < NT) { if (t + 2 < NT) asm volatile("s_waitcnt vmcnt(16)" ::: "memory"); else asm volatile("s_waitcnt vmcnt(0)" ::: "memory"); LWRITE(B, 1); }
      BARRIER1();
      if (t + 1 >= NT) break;
      if (t + 3 < NT) LLOAD(B, t + 3);
      if (t + 2 < NT) { if (t + 3 < NT) asm volatile("s_waitcnt vmcnt(16)" ::: "memory"); else asm volatile("s_waitcnt vmcnt(0)" ::: "memory"); LWRITE(A, 0); }
      BARRIER1();
    }
#undef LLOAD
#undef LWRITE
  } else {
    float m_reg = -1e30f; bf16x8 qr[4];
    const bf16* Qw = Qrow0 + (size_t)(rb * 32 + r32) * 3328 + g * 64 + hi * 8;
#pragma unroll
    for (int d0 = 0; d0 < 4; ++d0) qr[d0] = *reinterpret_cast<const bf16x8*>(Qw + d0 * 16);
    const int qpos = qpos0 + rb * 32 + r32;
    const LAS char* vb0 = V_lds + v_rd_base(lane);
    BARRIER1();
    for (int j = 0; j < NT; ++j) { const int bsel = j & 1;
      f32x16 p0, p1; float mn, al; bf16x8 pa0, pa1, pa2, pa3;
      qkt<false>(p0, p1, K_lds + bsel * SHM_K, qr, nullptr, r32, hi, g);
      if (j >= NT - 3) { const int base_ = 64 * j - qpos + 255 + 4 * hi;
#pragma unroll
        for (int r = 0; r < 16; ++r) { const int i0_ = base_ + (r & 3) + 8 * (r >> 2); p0[r] += tab[i0_]; p1[r] += tab[i0_ + 32]; } }
      partialSM(p0, p1, m_reg, mn, al);
      if (__any(al < 1.f)) { if (hi == 0) al_l[r32] = al; asm volatile("s_waitcnt lgkmcnt(0)" ::: "memory");
#pragma unroll
        for (int d = 0; d < 4; ++d)
#pragma unroll
          for (int r = 0; r < 16; ++r) o[d][r] *= al_l[crow(r, hi)]; }
      finishSM(p0, p1, al, l_reg, pa0, pa1, pa2, pa3);
      pv_d0(o, vb0 + bsel * SHM_V, pa0, pa1, pa2, pa3);
      BARRIER1(); }
  }
#undef BARRIER1
  __syncthreads();
  if (hi == 0) li_l[r32] = l_reg;
  asm volatile("s_waitcnt lgkmcnt(0)" ::: "memory");
  float rli[16];
#pragma unroll
  for (int r = 0; r < 16; ++r) rli[r] = __builtin_amdgcn_rcpf(li_l[crow(r, hi)]);
  LAS float* X = (LAS float*)lds + rb * 4096 + lane;
  if (live && g == 1) {
#pragma unroll
    for (int r = 0; r < 16; ++r)
#pragma unroll
      for (int d0 = 0; d0 < 4; ++d0) X[(r * 4 + d0) * 64] = o[d0][r] * rli[r];
  }
  __syncthreads();
  if (live && g == 0) {
    const float lam = ((const LAS float*)(lds + OFF_LAM))[0], osc = ((const LAS float*)(lds + OFF_LAM))[1];
    float ss[16];
#pragma unroll
    for (int r = 0; r < 16; ++r) { float s = 0.f;
#pragma unroll
      for (int d0 = 0; d0 < 4; ++d0) { const float od = o[d0][r] * rli[r] - lam * X[(r * 4 + d0) * 64]; o[d0][r] = od; s += od * od; }
      ss[r] = s; }
#pragma unroll
    for (int r = 0; r < 16; ++r) { float s = ss[r]; s += __shfl_xor(s, 1); s += __shfl_xor(s, 2); s += __shfl_xor(s, 4); s += __shfl_xor(s, 8); s += __shfl_xor(s, 16);
      ss[r] = osc / sqrtf(s * (1.f / 128.f) + RMS_EPS); }
    float gn[4];
#pragma unroll
    for (int d0 = 0; d0 < 4; ++d0) gn[d0] = gnorm[d0 * 32 + r32];
    bf16* Ow = Orow0 + (size_t)(rb * 32) * 1024 + r32;
#pragma unroll
    for (int r = 0; r < 16; ++r) { const int orow = crow(r, hi);
#pragma unroll
      for (int d0 = 0; d0 < 4; ++d0) Ow[(size_t)orow * 1024 + d0 * 32] = (bf16)f2bf(o[d0][r] * ss[r] * gn[d0]); }
  }
  __syncthreads();
}
#undef KSWZ
#undef SBAR
}

namespace gla {
constexpr int P72 = 72;
constexpr int L_TOT = 0, L_DL = 2048, L_QT = 4096, L_KT = L_QT + 64 * P72 * 2, L_KDT = L_KT + 64 * P72 * 2, L_A = L_KDT + 64 * P72 * 2, L_VT = L_A + 64 * P72 * 2, L_END = L_VT + 128 * P72 * 2;
static_assert(L_END <= RING_BYTES, "gla LDS map");
__device__ __forceinline__ int crow(int r, int hi) { return (r & 3) + 8 * (r >> 2) + 4 * hi; }
__device__ __forceinline__ float logsig(float z) { return fminf(z, 0.f) - __logf(1.f + __expf(-fabsf(z))); }
__device__ __forceinline__ bf16x8 ldsfrag(const LAS unsigned char* img, int row, int k0) { return *(const LAS bf16x8*)(img + (row * P72 + k0) * 2); }

#define G1IN_DECL(p) float p##z[8]; unsigned p##qk[8]; bf16x8 p##v0, p##v1; float p##bal
#define G1IN_ARGS(p) p##z, p##qk, p##v0, p##v1, p##bal
__device__ __forceinline__ void g1_load(float (&z)[8], unsigned (&qk)[8], bf16x8& v0, bf16x8& v1, float& bal, int c, int h, const bf16* ACT, const float* LOGA, const float* balpha) {
    const int tid = fresh_tid(), lane = tid & 63, t0 = 8 * (tid >> 6), row0 = 64 * c;
    bal = balpha[h * 64 + lane];
#pragma unroll
    for (int i = 0; i < 8; ++i) z[i] = LOGA[(size_t)(row0 + t0 + i) * 256 + h * 64 + lane];
#pragma unroll
    for (int i = 0; i < 8; ++i) { const bf16* ap = ACT + (size_t)(row0 + t0 + i) * NIN + h * 64 + lane; qk[i] = (unsigned)ap[0] | ((unsigned)ap[256] << 16); }
    { const int s = tid >> 4, jc = (tid & 15) * 8; v0 = *(const bf16x8*)(ACT + (size_t)(row0 + s) * NIN + 768 + h * 128 + jc); v1 = *(const bf16x8*)(ACT + (size_t)(row0 + 32 + s) * NIN + 768 + h * 128 + jc); }
}
__device__ __forceinline__ void g1_unit(LAS unsigned char* lds, const float (&inz)[8], const unsigned (&inqk)[8], const bf16x8& inv0, const bf16x8& inv1, const float& inbal, int c, int h, int layer,
                                        float* UT, float* Dw, float* OI, bf16* QT, bf16* SCT, const float* state_in  , float* state_out  ) {
    const int tid = fresh_tid(), wid = __builtin_amdgcn_readfirstlane(tid >> 6), lane = tid & 63, r = lane & 31, hh = lane >> 5;
    const int row0 = 64 * c;
    LAS float* TOT = (LAS float*)(lds + L_TOT); LAS float* DL = (LAS float*)(lds + L_DL);
    LAS unsigned char* Qi = lds + L_QT; LAS unsigned char* Ki = lds + L_KT; LAS unsigned char* KDi = lds + L_KDT; LAS unsigned char* Ai = lds + L_A; LAS unsigned char* Vi = lds + L_VT;
    { const int d = lane, tg = wid, t0 = 8 * tg;
      const float bal = inbal;
      float cs[8]; float run = 0.f;
#pragma unroll
      for (int i = 0; i < 8; ++i) { const float z = inz[i] + bal; run += logsig(z) * 0.0625f; cs[i] = run; }
      float qv[8], kv[8];
#pragma unroll
      for (int i = 0; i < 8; ++i) { qv[i] = bf2f((unsigned short)(inqk[i] & 0xffffu)); kv[i] = bf2f((unsigned short)(inqk[i] >> 16)); }
      TOT[tg * 64 + d] = run;
#pragma unroll
      for (int k = 0; k < 2; ++k) { const int ci = tid + 512 * k, s = ci >> 4, jc = (ci & 15) * 8;
        const bf16x8 v = k ? inv1 : inv0;
#pragma unroll
        for (int e = 0; e < 8; ++e) *(LAS short*)(Vi + ((jc + e) * P72 + s) * 2) = v[e]; }
      __syncthreads();
      float off = 0.f, blast = 0.f;
#pragma unroll
      for (int g2 = 0; g2 < 8; ++g2) { const float tv = TOT[g2 * 64 + d]; blast += tv; if (g2 < tg) off += tv; }
      unsigned kd[4];
      float kdf[8];
#pragma unroll
      for (int i = 0; i < 8; ++i) { const float b = off + cs[i]; const float eb = __expf(b);
        const float qt = qv[i] * 0.125f * eb, kt = kv[i] * __expf(-b); kdf[i] = kv[i] * __expf(blast - b);
        const unsigned short qb = (unsigned short)f2bf(qt);
        *(LAS unsigned short*)(Qi + ((t0 + i) * P72 + d) * 2) = qb; *(LAS unsigned short*)(Ki + ((t0 + i) * P72 + d) * 2) = (unsigned short)f2bf(kt);
        QT[(size_t)(row0 + t0 + i) * 256 + h * 64 + d] = qb; }
#pragma unroll
      for (int i = 0; i < 4; ++i) kd[i] = pk2(kdf[2 * i], kdf[2 * i + 1]);
      *(LAS v4u*)(KDi + (d * P72 + t0) * 2) = (v4u){kd[0], kd[1], kd[2], kd[3]};
      if (tg == 0) { const float Dd = __expf(blast); DL[d] = Dd; Dw[(size_t)(c * 4 + h) * 64 + d] = Dd; }
    }
    __syncthreads();
    if (wid < 3) { const int sb = (wid == 2), tb = (wid >= 1); f32x16 acc = {};
#pragma unroll
      for (int kk = 0; kk < 4; ++kk) acc = __builtin_amdgcn_mfma_f32_32x32x16_bf16(ldsfrag(Ki, sb * 32 + r, kk * 16 + 8 * hh), ldsfrag(Qi, tb * 32 + r, kk * 16 + 8 * hh), acc, 0, 0, 0);
      const int t = tb * 32 + r;
#pragma unroll
      for (int q = 0; q < 4; ++q) { const int s0 = sb * 32 + 8 * q + 4 * hh; float v[4];
#pragma unroll
        for (int e = 0; e < 4; ++e) v[e] = (s0 + e <= t) ? acc[4 * q + e] : 0.f;
        *(LAS v2u*)(Ai + (t * P72 + s0) * 2) = (v2u){pk2(v[0], v[1]), pk2(v[2], v[3])}; }
    } else if (wid == 3) {
#pragma unroll
      for (int q = 0; q < 4; ++q) *(LAS v2u*)(Ai + (r * P72 + 32 + 8 * q + 4 * hh) * 2) = (v2u){0u, 0u};
    } else {
      const int jb = wid - 4, j = jb * 32 + r;
#pragma unroll
      for (int db = 0; db < 2; ++db) { f32x16 acc = {};
#pragma unroll
        for (int kk = 0; kk < 4; ++kk) acc = __builtin_amdgcn_mfma_f32_32x32x16_bf16(ldsfrag(KDi, db * 32 + r, kk * 16 + 8 * hh), ldsfrag(Vi, j, kk * 16 + 8 * hh), acc, 0, 0, 0);
        if (c < NPCH) {
#pragma unroll
          for (int q = 0; q < 4; ++q) { const int d0 = db * 32 + 8 * q + 4 * hh;
            *(f32x4*)(UT + ((size_t)(c * 4 + h) * 128 + j) * 64 + d0) = (f32x4){acc[4 * q], acc[4 * q + 1], acc[4 * q + 2], acc[4 * q + 3]}; }
        } else { const int b = c - NPCH; const size_t sbase = (size_t)(b * 4 + h) * 8192;
#pragma unroll
          for (int q = 0; q < 4; ++q) { const int d0 = db * 32 + 8 * q + 4 * hh; float si[4];
#pragma unroll
            for (int e = 0; e < 4; ++e) { si[e] = state_in[sbase + (size_t)(d0 + e) * 128 + j]; state_out[sbase + (size_t)(d0 + e) * 128 + j] = DL[d0 + e] * si[e] + acc[4 * q + e]; }
            *(v2u*)(SCT + ((size_t)(c * 4 + h) * 128 + j) * 64 + d0) = (v2u){pk2(si[0], si[1]), pk2(si[2], si[3])}; }
        }
      }
    }
    __syncthreads();
    { const int jb = wid >> 1, tb = wid & 1; f32x16 acc = {};
#pragma unroll
      for (int kk = 0; kk < 4; ++kk) acc = __builtin_amdgcn_mfma_f32_32x32x16_bf16(ldsfrag(Vi, jb * 32 + r, kk * 16 + 8 * hh), ldsfrag(Ai, tb * 32 + r, kk * 16 + 8 * hh), acc, 0, 0, 0);
      float* op = OI + (size_t)(row0 + tb * 32 + r) * 512 + h * 128 + jb * 32 + 4 * hh;
#pragma unroll
      for (int q = 0; q < 4; ++q) *(f32x4*)(op + 8 * q) = (f32x4){acc[4 * q], acc[4 * q + 1], acc[4 * q + 2], acc[4 * q + 3]}; }
    __syncthreads();
}

__device__ __forceinline__ void g2_group(LAS unsigned char* lds, int eg, const float* UT, const float* Dw, bf16* SCT, float* gout  ) {
    const int tid = fresh_tid(); const int el = tid & 127, seg = tid >> 7; const int e = eg * 128 + el; const int h = e >> 13, j = (e >> 6) & 127, d = e & 63;
    LAS float* PL = (LAS float*)lds;
    const size_t ustride = 4 * 128 * 64, dstride = 4 * 64;
    const float* up = UT + ((size_t)h * 128 + j) * 64 + d + (size_t)(64 * seg) * ustride; const float* dp = Dw + h * 64 + d + (size_t)(64 * seg) * dstride;
    float P = 1.f, L = 0.f;
#pragma unroll 32
    for (int cc = 0; cc < 64; ++cc) { const float Dv = dp[(size_t)cc * dstride], Uv = up[(size_t)cc * ustride]; L = fmaf(Dv, L, Uv); P *= Dv; }
    PL[(seg * 128 + el) * 2] = P; PL[(seg * 128 + el) * 2 + 1] = L;
    __syncthreads();
    float S = 0.f;
    for (int s2 = 0; s2 < seg; ++s2) S = fmaf(PL[(s2 * 128 + el) * 2], S, PL[(s2 * 128 + el) * 2 + 1]);
    bf16* sp = SCT + ((size_t)h * 128 + j) * 64 + d + (size_t)(64 * seg) * ustride;
#pragma unroll 32
    for (int cc = 0; cc < 64; ++cc) { const float Dv = dp[(size_t)cc * dstride], Uv = up[(size_t)cc * ustride]; sp[(size_t)cc * ustride] = (bf16)f2bf(S); S = fmaf(Dv, S, Uv); }
    if (seg == 3) gout[((size_t)h * 64 + d) * 128 + j] = S;
    __syncthreads();
}

__device__ __forceinline__ void g3_unit(LAS float* part, int c, int h, const bf16* ACT, const float* OI, const bf16* QT, const bf16* SCT, const float* gnorm  , bf16* MIX) {
    const int tid = fresh_tid(), wid = __builtin_amdgcn_readfirstlane(tid >> 6), lane = tid & 63, r = lane & 31, hh = lane >> 5;
    const int jb = wid >> 1, tb = wid & 1; const int row = 64 * c + tb * 32 + r;
    f32x16 acc = {};
    const bf16* ap = SCT + ((size_t)(c * 4 + h) * 128 + jb * 32 + r) * 64 + 8 * hh; const bf16* bp = QT + (size_t)row * 256 + h * 64 + 8 * hh;
#pragma unroll
    for (int kk = 0; kk < 4; ++kk) acc = __builtin_amdgcn_mfma_f32_32x32x16_bf16(*(const bf16x8*)(ap + kk * 16), *(const bf16x8*)(bp + kk * 16), acc, 0, 0, 0);
    const int j0 = jb * 32 + 4 * hh;
    const float* oip = OI + (size_t)row * 512 + h * 128 + j0;
    float ss = 0.f;
#pragma unroll
    for (int q = 0; q < 4; ++q) { const f32x4 oi = *(const f32x4*)(oip + 8 * q);
#pragma unroll
      for (int e = 0; e < 4; ++e) { acc[4 * q + e] += oi[e]; ss += acc[4 * q + e] * acc[4 * q + e]; } }
    ss += __shfl_xor(ss, 32);
    if (hh == 0) part[wid * 32 + r] = ss;
    __syncthreads();
    const float tot = part[tb * 32 + r] + part[(tb + 2) * 32 + r] + part[(tb + 4) * 32 + r] + part[(tb + 6) * 32 + r];
    const float rstd = 1.f / sqrtf(tot * (1.f / 128.f) + RMS_EPS);
    const bf16* gp = ACT + (size_t)row * NIN + 1280 + h * 128 + j0; bf16* mp = MIX + (size_t)row * 1024 + h * 128 + j0;
#pragma unroll
    for (int q = 0; q < 4; ++q) { const v2u gg = *(const v2u*)(gp + 8 * q); const f32x4 gn = *(const f32x4*)(gnorm + j0 + 8 * q);
      float gv[4] = {bf2f((unsigned short)(gg.x & 0xffffu)), bf2f((unsigned short)(gg.x >> 16)), bf2f((unsigned short)(gg.y & 0xffffu)), bf2f((unsigned short)(gg.y >> 16))}; float y[4];
#pragma unroll
      for (int e = 0; e < 4; ++e) { const float sg = gv[e] / (1.f + __expf(-gv[e])); y[e] = acc[4 * q + e] * rstd * gn[e] * sg; }
      *(v2u*)(mp + 8 * q) = (v2u){pk2(y[0], y[1]), pk2(y[2], y[3])}; }
    __syncthreads();
}
}

namespace mini {
__device__ __forceinline__ int crow(int r, int hi) { return (r & 3) + 8 * (r >> 2) + 4 * hi; }
template <int K>
__device__ __forceinline__ void piece(LAS unsigned char* lds, int p, const bf16* A  , const bf16* Bt, const float* src  , float* dst  , bf16* xb  , float* rowsq  ) {
    const int tid = fresh_tid(), wid = __builtin_amdgcn_readfirstlane(tid >> 6), lane = tid & 63, r = lane & 31, hh = lane >> 5;
    const int r0 = (p >> 4) * 64, c0 = (p & 15) * 64;
    constexpr int KW = K / 8, NS = KW / 16;
    static_assert(KW % 16 == 0, "K / 8 must be a multiple of 16");
    const bf16* ap = A + (size_t)(r0 + r) * K + wid * KW + 8 * hh; const bf16* bp = Bt + (size_t)(c0 + r) * K + wid * KW + 8 * hh;
    f32x16 acc[2][2] = {};
    constexpr int U = (NS % 11 == 0) ? 11 : 8;
    static_assert(NS % U == 0, "batching");
    for (int kb = 0; kb < NS; kb += U) {
        bf16x8 a0[U], a1[U], b0[U], b1[U];
#pragma unroll
        for (int u = 0; u < U; ++u) { a0[u] = *(const bf16x8*)(ap + (kb + u) * 16); a1[u] = *(const bf16x8*)(ap + (size_t)32 * K + (kb + u) * 16);
                                      b0[u] = *(const bf16x8*)(bp + (kb + u) * 16); b1[u] = *(const bf16x8*)(bp + (size_t)32 * K + (kb + u) * 16); }
#pragma unroll
        for (int u = 0; u < U; ++u) {
            acc[0][0] = __builtin_amdgcn_mfma_f32_32x32x16_bf16(a0[u], b0[u], acc[0][0], 0, 0, 0); acc[0][1] = __builtin_amdgcn_mfma_f32_32x32x16_bf16(a0[u], b1[u], acc[0][1], 0, 0, 0);
            acc[1][0] = __builtin_amdgcn_mfma_f32_32x32x16_bf16(a1[u], b0[u], acc[1][0], 0, 0, 0); acc[1][1] = __builtin_amdgcn_mfma_f32_32x32x16_bf16(a1[u], b1[u], acc[1][1], 0, 0, 0); }
    }
    LAS float* P = (LAS float*)lds;
#pragma unroll
    for (int i = 0; i < 2; ++i)
#pragma unroll
        for (int j = 0; j < 2; ++j)
#pragma unroll
            for (int q = 0; q < 16; ++q) P[(((wid * 2 + i) * 2 + j) * 16 + q) * 64 + lane] = acc[i][j][q];
    __syncthreads();
    float vv[8];
#pragma unroll
    for (int q = 0; q < 8; ++q) { const int e = tid + 512 * q;
        float s = 0.f;
#pragma unroll
        for (int w = 0; w < 8; ++w) s += P[w * 4096 + e];
        const int ln = e & 63, reg = (e >> 6) & 15, j = (e >> 10) & 1, i = e >> 11;
        const int row = r0 + 32 * i + crow(reg, ln >> 5), col = c0 + 32 * j + (ln & 31);
        const float v = src[(size_t)row * 1024 + col] + s;
        dst[(size_t)row * 1024 + col] = v; xb[(size_t)row * 1024 + col] = (bf16)f2bf(v); vv[q] = v; }
#pragma unroll
    for (int q = 0; q < 8; ++q) { if (q & 2) continue;
        float sq = vv[q] * vv[q] + vv[q + 2] * vv[q + 2]; sq += __shfl_xor(sq, 1); sq += __shfl_xor(sq, 2); sq += __shfl_xor(sq, 4); sq += __shfl_xor(sq, 8); sq += __shfl_xor(sq, 16);
        const int e = tid + 512 * q, ln = e & 63, reg = (e >> 6) & 15, i = e >> 11; const int row = r0 + 32 * i + crow(reg, ln >> 5);
        if ((ln & 31) == 0) rowsq[(size_t)row * 16 + (p & 15)] = sq; }
    __syncthreads();
}
}

__global__ void __launch_bounds__(NWAVES * 64, 2) hymba_fwd(Args args) {
    extern __shared__ __attribute__((aligned(16))) unsigned char lds[];
    Frame F;
    F.lds = (LAS unsigned char*)lds;
    for (int u = threadIdx.x; u < (LDS_BYTES - LDSCTL_OFF) / 4; u += NWAVES * 64) ((LAS unsigned*)(F.lds + LDSCTL_OFF))[u] = 0u;
    __syncthreads();
    if (threadIdx.x == 0) { LAS unsigned long long* t = (LAS unsigned long long*)(F.lds + PTAB_OFF);
#pragma unroll
        for (int i = 0; i < 18; ++i) t[i] = (unsigned long long)args.in[i];
        t[18] = (unsigned long long)args.out; t[19] = (unsigned long long)args.ws; }
    __syncthreads();
#define CTL_ ((gu32*)(wsp(F) + WS_CTL))
    (void)xcd_barrier_post((unsigned*)(CTL_ + CW_BAR), (volatile LAS unsigned*)(F.lds + MISC_OFF) + 8);
#define GRID_BAR() do { XcdBarrier b_; b_.bar = (unsigned*)(CTL_ + CW_BAR); b_.x = xb_xcc_id(); b_.st = (volatile LAS unsigned*)(F.lds + MISC_OFF) + 8; xcd_barrier(b_); } while (0)

#define WSB(off) (wsp(F) + (off))
#define X_ ((float*)WSB(WS_X))
#define XN_ ((bf16*)WSB(WS_XN))
#define ACT_ ((bf16*)WSB(WS_ACT))
#define MIX_ ((bf16*)WSB(WS_MIX))
#define HB_ ((bf16*)WSB(WS_H))
#define LOGA_ ((float*)WSB(WS_LOGA))

#ifndef SKIP_P0
    p0_prologue(F);
#endif
    rows_to_bf16_sq(F, inp(F, 0), inp(F, 1), XN_, (float*)WSB(WS_RSQ));
    GRID_BAR();

    for (int l = 0; l < DEPTH; ++l) {
#define WL_ (WSB(WS_W) + (size_t)l * W_LAYER)
#define SRCP_ (l == 0 ? inp(F, 0) : (const float*)X_)
#define SRCS_ (l == 0 ? inp(F, 1) : (const float*)X_ + (size_t)SEQ * DM)
#ifndef SKIP_IN
        { pg8::Gemm g{XN_, (const bf16*)(WL_ + WO_IN), M, NIN, DM}; pg8::StaticOrder S; S.init(M, NIN, grid_n(), (int)blockIdx.x);
          rstd_prepass(F, S, (const float*)WSB(WS_RSQ) + (size_t)(2 * l) * M * 16);
          pg8::EpiIn E{wsp(F), outp(F), l, WS_ACT, WS_LOGA, (const LAS float*)(F.lds + RSTD_OFF)};
          pg8::gemm_phase<pg8::EpiIn, pg8::StaticOrder, true, true>(F.lds + RING_OFF, g, S, E);
#if defined(PROBE_DUP_GEMM) || defined(PROBE_DUP_IN)
          __syncthreads(); pg8::gemm_phase<pg8::EpiIn, pg8::StaticOrder, true, true>(F.lds + RING_OFF, g, S, E);
#endif
        }
#endif
        GRID_BAR();
#ifndef SKIP_G1
        { G1IN_DECL(gA); G1IN_DECL(gB); const int G_ = grid_n(); int u = blockIdx.x; constexpr int NU = NCHUNK * 4;
#define G1_LOAD(gx, uu) gla::g1_load(G1IN_ARGS(gx), (uu) >> 2, (uu) & 3, ACT_, LOGA_, inp(F, 7) + (size_t)l * 256)
#define G1_RUN(gx, uu) gla::g1_unit(F.lds + RING_OFF, G1IN_ARGS(gx), (uu) >> 2, (uu) & 3, l, (float*)WSB(WS_U), (float*)WSB(WS_D), (float*)WSB(WS_OI), (bf16*)WSB(WS_QT), (bf16*)WSB(WS_SC), \
                         inp(F, 4) + (size_t)l * DECB * 4 * 8192, outp(F) + OG_S + (size_t)l * DECB * 4 * 8192)
#define CLAMPU(x) ((x) < NU ? (x) : NU - 1)
          G1_LOAD(gA, CLAMPU(u));
          for (; u < NU; u += 2 * G_) {
            G1_LOAD(gB, CLAMPU(u + G_));
            G1_RUN(gA, u);
            if (u + G_ < NU) { G1_LOAD(gA, CLAMPU(u + 2 * G_)); G1_RUN(gB, u + G_); } }
#undef CLAMPU
#undef G1_LOAD
#undef G1_RUN
        }
#endif
        GRID_BAR();
#ifdef PROBE_DUP_GLA
        for (int rep_ = 0; rep_ < 2; ++rep_)
#endif
        for (int eg = blockIdx.x; eg < 256; eg += grid_n())
#ifndef SKIP_G2
            gla::g2_group(F.lds + RING_OFF, eg, (const float*)WSB(WS_U), (const float*)WSB(WS_D), (bf16*)WSB(WS_SC), outp(F) + OG_P + (size_t)l * 4 * 8192);
#endif
            ;
        GRID_BAR();
        att::attn_setup(F.lds + RING_OFF, inp(F, 17), inp(F, 9) + (size_t)l * 256, l);
#ifdef PROBE_DUP_ATT
        for (int rep = 0; rep < 2; ++rep)
#else
        const int rep = 0;
#endif
        for (int it = 0;; ++it) {
            if (it == 0) __syncthreads();
            volatile LAS int* slot = (volatile LAS int*)(F.lds + MISC_OFF) + 16 + (it & 1);
            if (threadIdx.x == 0) *slot = (int)__hip_atomic_fetch_add((unsigned*)(CTL_ + CW_QUEUE + 64 * (l + 4 * rep)), 1u, __ATOMIC_RELAXED, __HIP_MEMORY_SCOPE_AGENT);
            __syncthreads();
            const int idx = __builtin_amdgcn_readfirstlane(*slot);
            if (idx >= 64 + 512 + NCHUNK * 4) break;
            if (idx < 64) { const int b = idx >> 2, h = idx & 3;
                const float* kc = inp(F, 2) + ((size_t)(l * DECB + b) * PAST) * 512 + h * 128; const float* vc = inp(F, 3) + ((size_t)(l * DECB + b) * PAST) * 512 + h * 128;
                const float* kn = outp(F) + OK_S + ((size_t)(l * DECB + b) * 64) * 512 + h * 128; const float* vn = outp(F) + OV_S + ((size_t)(l * DECB + b) * 64) * 512 + h * 128;
#ifndef SKIP_AS
                att::attn_unit_sample(F.lds + RING_OFF, kc, vc, kn, vn, ACT_ + (size_t)(SEQ + 64 * b) * NIN + 1792 + h * 128, MIX_ + (size_t)(SEQ + 64 * b) * DM + 512 + h * 128,
                                      PAST, h, inp(F, 10) + (size_t)l * 128);
#endif
            } else if (idx < 576) { const int i = idx - 64, u = 127 - (i >> 2), h = i & 3;
#ifndef SKIP_AP
                att::attn_unit_prompt(F.lds + RING_OFF, ACT_ + 2304 + h * 128, ACT_ + 2816 + h * 128, ACT_ + (size_t)(128 * u) * NIN + 1792 + h * 128,
                                      MIX_ + (size_t)(128 * u) * DM + 512 + h * 128, 2 * u + 2, 128 * u, h, inp(F, 10) + (size_t)l * 128);
#endif
            } else { const int i = idx - 576;
#ifndef SKIP_G3
                gla::g3_unit((LAS float*)(F.lds + RING_OFF + att::OFF_G3), i >> 2, i & 3, ACT_, (const float*)WSB(WS_OI), (const bf16*)WSB(WS_QT), (const bf16*)WSB(WS_SC), inp(F, 8) + (size_t)l * 128, MIX_);
#endif
            }
        }
        GRID_BAR();
#ifndef SKIP_OUT
        { pg8::Gemm g{MIX_, (const bf16*)(WL_ + WO_OUT), SEQ, DM, DM}; pg8::StaticOrder S; S.init(SEQ, DM, grid_n(), (int)blockIdx.x);
          pg8::EpiRes E{SRCP_, SRCS_, X_, XN_, (float*)WSB(WS_RSQ) + (size_t)(1 + 2 * l) * M * 16};
          pg8::gemm_phase<pg8::EpiRes, pg8::StaticOrder, true, true>(F.lds + RING_OFF, g, S, E);
#ifdef PROBE_DUP_GEMM
          __syncthreads(); pg8::EpiRes E2{SRCP_, SRCS_, (float*)WSB(WS_H), XN_, (float*)WSB(WS_OI)}; pg8::gemm_phase<pg8::EpiRes, pg8::StaticOrder, true, true>(F.lds + RING_OFF, g, S, E2);
#endif
          __syncthreads();
          for (int p = blockIdx.x; p < 256; p += grid_n())
              mini::piece<DM>(F.lds + RING_OFF, p, MIX_ + (size_t)SEQ * DM, (const bf16*)(WL_ + WO_OUT), SRCS_, X_ + (size_t)SEQ * DM, XN_ + (size_t)SEQ * DM, (float*)WSB(WS_RSQ) + ((size_t)(1 + 2 * l) * M + SEQ) * 16);
        }
#endif
        GRID_BAR();
#ifndef SKIP_F1
        { pg8::Gemm g{XN_, (const bf16*)(WL_ + WO_F1), M, NF1, DM}; pg8::StaticOrder S; S.init(M, NF1, grid_n(), (int)blockIdx.x);
          rstd_prepass(F, S, (const float*)WSB(WS_RSQ) + (size_t)(1 + 2 * l) * M * 16);
          pg8::EpiSwi E{HB_, DFF, (const LAS float*)(F.lds + RSTD_OFF)};
          pg8::gemm_phase<pg8::EpiSwi, pg8::StaticOrder, true, true>(F.lds + RING_OFF, g, S, E);
#if defined(PROBE_DUP_GEMM) || defined(PROBE_DUP_F1)
          __syncthreads(); pg8::gemm_phase<pg8::EpiSwi, pg8::StaticOrder, true, true>(F.lds + RING_OFF, g, S, E);
#endif
        }
#endif
        GRID_BAR();
#ifndef SKIP_F2
        { pg8::Gemm g{HB_, (const bf16*)(WL_ + WO_F2), SEQ, DM, DFF}; pg8::StaticOrder S; S.init(SEQ, DM, grid_n(), (int)blockIdx.x);
          pg8::EpiRes E{X_, X_ + (size_t)SEQ * DM, X_, XN_, (float*)WSB(WS_RSQ) + (size_t)(2 + 2 * l) * M * 16};
#ifdef PROBE_DUP_GEMM
          { pg8::EpiRes E2{X_, X_ + (size_t)SEQ * DM, (float*)WSB(WS_ACT), XN_, (float*)WSB(WS_OI)}; pg8::gemm_phase<pg8::EpiRes, pg8::StaticOrder, true, true>(F.lds + RING_OFF, g, S, E2); __syncthreads(); }
#endif
          pg8::gemm_phase<pg8::EpiRes, pg8::StaticOrder, true, true>(F.lds + RING_OFF, g, S, E);
          __syncthreads();
          for (int p = blockIdx.x; p < 256; p += grid_n())
              mini::piece<DFF>(F.lds + RING_OFF, p, HB_ + (size_t)SEQ * DFF, (const bf16*)(WL_ + WO_F2), X_ + (size_t)SEQ * DM, X_ + (size_t)SEQ * DM, XN_ + (size_t)SEQ * DM, (float*)WSB(WS_RSQ) + ((size_t)(2 + 2 * l) * M + SEQ) * 16);
        }
#endif
        GRID_BAR();
    }
    norm_rows_f32(F, X_, inp(F, 16), outp(F) + OY);
}

extern "C" void kernel_launch(void* const* d_in, const int* in_sizes, int n_in, void* d_out, int out_size, void* d_ws, size_t ws_size, hipStream_t stream) {
    static int grid = 0;
    if (grid == 0) {
        if (n_in != 18 || (size_t)out_size != OUT_TOTAL || ws_size < WS_END) { fprintf(stderr, "kernel_launch: shape mismatch n_in %d out %d ws %zu\n", n_in, out_size, ws_size); grid = -1; return; }
        int dev = 0, cus = 0, per_cu = 0;
        if (hipGetDevice(&dev) != hipSuccess || hipDeviceGetAttribute(&cus, hipDeviceAttributeMultiprocessorCount, dev) != hipSuccess) { grid = -1; return; }
        if (hipFuncSetAttribute((const void*)hymba_fwd, hipFuncAttributeMaxDynamicSharedMemorySize, LDS_BYTES) != hipSuccess) { fprintf(stderr, "kernel_launch: hipFuncSetAttribute failed\n"); grid = -1; return; }
        if (hipOccupancyMaxActiveBlocksPerMultiprocessor(&per_cu, (const void*)hymba_fwd, NWAVES * 64, LDS_BYTES) != hipSuccess || per_cu < 1)
            fprintf(stderr, "kernel_launch: occupancy query reports %d\n", per_cu);
        (void)hipGetLastError();
        grid = cus;
    }
    if (grid < 0) return;
    if (hipMemsetAsync((char*)d_ws + WS_CTL, 0, CTL_ZERO_BYTES, stream) != hipSuccess) return;
    Args a{};
    for (int i = 0; i < 18; ++i) a.in[i] = (const float*)d_in[i];
    a.out = (float*)d_out; a.ws = (unsigned char*)d_ws;
    hipLaunchKernelGGL(hymba_fwd, dim3(grid), dim3(NWAVES * 64), LDS_BYTES, stream, a);
    const hipError_t le = hipPeekAtLastError();
    if (le != hipSuccess) fprintf(stderr, "kernel_launch: launch failed: %s\n", hipGetErrorName(le));
}
```

```cpp
#include <hip/hip_runtime.h>
#include <cstdio>
#include <cstdint>
namespace pg8 {
#define PG8_LAS __attribute__((address_space(3)))
typedef unsigned short bf16_t;
typedef short bf16x8 __attribute__((ext_vector_type(8)));
typedef float f32x4 __attribute__((ext_vector_type(4)));
typedef unsigned u32x4 __attribute__((ext_vector_type(4)));
constexpr int BM = 256, BK = 64, HALF = 128, HTB = HALF * BK * 2  , STAGE_BYTES = 8 * HTB, NXCD = 8, WGM = 8;

__host__ __device__ __forceinline__ int lds_byte(int r, int c) { const int st = (r >> 4) * 2 + (c >> 5), rr = r & 15, cc = c & 31, ob = rr * 64 + cc * 2; return st * 1024 + (ob ^ (((ob >> 9) & 1) << 5)); }
__host__ __device__ __forceinline__ void stage_rc(int b, int& R, int& C) { const int st = b / 1024, sb = b % 1024, swz = sb ^ (((sb >> 9) & 1) << 5); R = (st >> 1) * 16 + swz / 64; C = (st & 1) * 32 + (swz % 64) / 2; }
__host__ __device__ __forceinline__ int perm32(int rho) { const int n = rho >> 4, i = rho & 15; return 8 * (i >> 2) + 4 * n + (i & 3); }

struct Unit { int pm, pn; };
struct Gemm { const bf16_t* A; const bf16_t* Bt; int M, N, K; };

struct StaticOrder {
    int nM, nN, nwg, G, c;
    __host__ __device__ void init(int M, int N, int G_, int c_) { nM = M / BM; nN = N / BM; nwg = nM * nN; G = G_; c = c_; }
    __host__ __device__ bool next(int i, Unit& u) const {
        const long L = (long)i * G + c; if (L >= nwg) return false;
        int wgid = (int)L; { const int q = nwg / NXCD, r = nwg % NXCD, xcd = wgid % NXCD, off = wgid / NXCD; wgid = (xcd < r ? xcd * (q + 1) : r * (q + 1) + (xcd - r) * q) + off; }
        const int nig = WGM * nN, gid = wgid / nig, fm = gid * WGM, gsz = (nM - fm) < WGM ? (nM - fm) : WGM;
        u.pm = fm + ((wgid % nig) % gsz); u.pn = (wgid % nig) / gsz; return true;
    }
    __device__ __forceinline__ void a_ready(const Unit&) const {}
    __device__ __forceinline__ void done(const Unit&) const {}
};

__device__ __forceinline__ unsigned cvt_pk_bf16(float lo, float hi) { unsigned r; asm volatile("v_cvt_pk_bf16_f32 %0, %1, %2" : "=v"(r) : "v"(lo), "v"(hi)); return r; }
__device__ __forceinline__ float silu_f(float v) { return v * __builtin_amdgcn_rcpf(1.f + __expf(-v)); }
__device__ __forceinline__ float logsig_f(float z) { return fminf(z, 0.f) - log1pf(__expf(-fabsf(z))); }

__device__ __forceinline__ float row_rstd(const float* rsq, int row) {
    const f32x4* p = (const f32x4*)(rsq + (size_t)row * 16); const f32x4 a = p[0], b = p[1], c = p[2], d = p[3];
    const float s = ((a[0] + a[1]) + (a[2] + a[3])) + ((b[0] + b[1]) + (b[2] + b[3])) + (((c[0] + c[1]) + (c[2] + c[3])) + ((d[0] + d[1]) + (d[2] + d[3])));
    return 1.f / sqrtf(s * (1.f / 1024.f) + 1e-6f);
}
#ifndef EPI_REP
#define EPI_REP 1
#endif
constexpr int IN_N = 3328;
constexpr int PROMPT_ROWS = 16384;

struct EpiIn {
    static constexpr bool PERM = true, AFTER_DRAIN = false;
    unsigned char* ws; float* out; int layer;
    size_t act_off, loga_off;
    const PG8_LAS float* rstd;
    __device__ __forceinline__ void operator()(const f32x4 (&acc)[2][2][4][2], const Unit& u, int wr, int wc, int fr, int fq, int ui) const {
        const int row0 = u.pm * BM + wr * 64 + fr; const int pn = u.pn; const int cl0 = wc * 32 + 8 * fq;
        float* fo = nullptr; int fld = 512;
        if (pn == 2) { fo = (float*)(ws + loga_off) + (size_t)row0 * 256 + cl0; fld = 256; }
        else if (pn >= 9) { const bool samp = (u.pm >= PROMPT_ROWS / BM); const bool isv = (pn >= 11);
            const size_t b = samp ? (isv ? (size_t)87162880 : (size_t)85065728) + (size_t)layer * 524288 : (isv ? (size_t)51380224 : (size_t)17825792) + (size_t)layer * 8388608;
            fo = out + b + (size_t)(row0 - (samp ? PROMPT_ROWS : 0)) * 512 + ((pn - 9) & 1) * 256 + cl0; }
        bf16_t* ab = (bf16_t*)(ws + act_off) + (size_t)row0 * IN_N + pn * BM + cl0;
        for (int rep_ = 0; rep_ < EPI_REP; ++rep_) { asm volatile("" ::: "memory");
        const float qsc = (pn == 7 || pn == 8) ? 0.18033688011112042f : 1.f;
#pragma unroll
        for (int ai = 0; ai < 2; ++ai)
#pragma unroll
            for (int m = 0; m < 4; ++m) { const size_t ro = (size_t)(ai * HALF + m * 16);
                const float rs = rstd[ui * BM + wr * 64 + fr + ai * HALF + m * 16] * qsc;
#pragma unroll
                for (int bj = 0; bj < 2; ++bj) { f32x4 v0 = acc[ai][bj][m][0] * rs, v1 = acc[ai][bj][m][1] * rs;
                    u32x4 w; w.x = cvt_pk_bf16(v0[0], v0[1]); w.y = cvt_pk_bf16(v0[2], v0[3]); w.z = cvt_pk_bf16(v1[0], v1[1]); w.w = cvt_pk_bf16(v1[2], v1[3]);
                    if (pn != 2) *(u32x4*)(ab + ro * IN_N + bj * HALF) = w;
                    if (fo) { *(f32x4*)(fo + ro * fld + bj * HALF) = v0; *(f32x4*)(fo + ro * fld + bj * HALF + 4) = v1; } } }
        }
    }
};

struct EpiSwi {
    static constexpr bool PERM = true, AFTER_DRAIN = false;
    bf16_t* H; int ldh; const PG8_LAS float* rstd;
    __device__ __forceinline__ void operator()(const f32x4 (&acc)[2][2][4][2], const Unit& u, int wr, int wc, int fr, int fq, int ui) const {
        const int row0 = u.pm * BM + wr * 64 + fr; bf16_t* hb = H + (size_t)row0 * ldh + u.pn * HALF + wc * 32 + 8 * fq;
        for (int rep_ = 0; rep_ < EPI_REP; ++rep_) { asm volatile("" ::: "memory");
#pragma unroll
        for (int ai = 0; ai < 2; ++ai)
#pragma unroll
            for (int m = 0; m < 4; ++m) { const float rs = rstd[ui * BM + wr * 64 + fr + ai * HALF + m * 16];
                const f32x4 g0 = acc[ai][0][m][0] * rs, g1 = acc[ai][0][m][1] * rs, u0 = acc[ai][1][m][0] * rs, u1 = acc[ai][1][m][1] * rs;
                u32x4 w; w.x = cvt_pk_bf16(silu_f(g0[0]) * u0[0], silu_f(g0[1]) * u0[1]); w.y = cvt_pk_bf16(silu_f(g0[2]) * u0[2], silu_f(g0[3]) * u0[3]);
                w.z = cvt_pk_bf16(silu_f(g1[0]) * u1[0], silu_f(g1[1]) * u1[1]); w.w = cvt_pk_bf16(silu_f(g1[2]) * u1[2], silu_f(g1[3]) * u1[3]);
                *(u32x4*)(hb + (size_t)(ai * HALF + m * 16) * ldh) = w; }
        }
    }
};

struct EpiRes {
    static constexpr bool PERM = true, AFTER_DRAIN = false;
    bf16_t* xb; float* rowsq;
    __device__ __forceinline__ void operator()(const f32x4 (&acc)[2][2][4][2], const Unit& u, int wr, int wc, int fr, int fq, int ui) const {
        const int row0 = u.pm * BM + wr * 64 + fr; const int c0 = u.pn * BM + wc * 32 + 8 * fq;
        bf16_t* xbb = xb + (size_t)row0 * 1024 + c0;
#pragma unroll
        for (int ai = 0; ai < 2; ++ai)
#pragma unroll
            for (int m = 0; m < 4; ++m) { const size_t ro = (size_t)(ai * HALF + m * 16) * 1024; float sq = 0.f;
#pragma unroll
                for (int bj = 0; bj < 2; ++bj) { const u32x4 s = *(const u32x4*)(xbb + ro + bj * HALF);
                    f32x4 v0, v1;
                    v0[0] = __builtin_bit_cast(float, s.x << 16) + acc[ai][bj][m][0][0]; v0[1] = __builtin_bit_cast(float, s.x & 0xffff0000u) + acc[ai][bj][m][0][1];
                    v0[2] = __builtin_bit_cast(float, s.y << 16) + acc[ai][bj][m][0][2]; v0[3] = __builtin_bit_cast(float, s.y & 0xffff0000u) + acc[ai][bj][m][0][3];
                    v1[0] = __builtin_bit_cast(float, s.z << 16) + acc[ai][bj][m][1][0]; v1[1] = __builtin_bit_cast(float, s.z & 0xffff0000u) + acc[ai][bj][m][1][1];
                    v1[2] = __builtin_bit_cast(float, s.w << 16) + acc[ai][bj][m][1][2]; v1[3] = __builtin_bit_cast(float, s.w & 0xffff0000u) + acc[ai][bj][m][1][3];
                    sq += (v0[0] * v0[0] + v0[1] * v0[1]) + (v0[2] * v0[2] + v0[3] * v0[3]) + (v1[0] * v1[0] + v1[1] * v1[1]) + (v1[2] * v1[2] + v1[3] * v1[3]);
                    u32x4 w; w.x = cvt_pk_bf16(v0[0], v0[1]); w.y = cvt_pk_bf16(v0[2], v0[3]); w.z = cvt_pk_bf16(v1[0], v1[1]); w.w = cvt_pk_bf16(v1[2], v1[3]);
                    *(u32x4*)(xbb + ro + bj * HALF) = w; }
                sq += __shfl_xor(sq, 16); sq += __shfl_xor(sq, 32);
                if (fq == 0) rowsq[(size_t)(row0 + ai * HALF + m * 16) * 16 + u.pn * 4 + wc] = sq;
                if (m & 1) asm volatile("" ::: "memory"); }
    }
};
template <class Epi, class Sched, bool ALIGN_EPI = false, bool SP2 = false>
__device__ __forceinline__ void gemm_phase(PG8_LAS unsigned char* lds, const Gemm g, const Sched& S, const Epi& E) {
    int tid_ = threadIdx.x; asm volatile("" : "+v"(tid_));
    const int tid = tid_, wid = __builtin_amdgcn_readfirstlane(tid >> 6), lane = tid & 63, wr = wid >> 2, wc = wid & 3, fr = lane & 15, fq = lane >> 4;
    const int K = g.K, nt = K / BK;
    unsigned voffA[2], voffB[2];
#pragma unroll
    for (int i = 0; i < 2; ++i) { int R, C; stage_rc(tid * 16 + i * 8192, R, C); const int Rb = Epi::PERM ? ((R & ~31) + perm32(R & 31)) : R;
        voffA[i] = (unsigned)(R * K + C) * 2u; voffB[i] = (unsigned)(Rb * K + C) * 2u; }
    const size_t kstep = (size_t)(BK * 2);
    const size_t hstep = (size_t)HALF * K * 2;
    const size_t tstep = 2 * hstep;
    const unsigned ldsw = (unsigned)wid * 1024u;
    const int aoff = lds_byte(wr * 64 + fr, fq * 8), boff = lds_byte(wc * 32 + fr, fq * 8);
#define PG8_SA(b, h) (((b) * 2 + (h)) * HTB)
#define PG8_SB(b, h) ((4 + (b) * 2 + (h)) * HTB)
#define PG8_STAGE(bufoff, gbase, voff) do { _Pragma("unroll") for (int _i = 0; _i < 2; ++_i) \
        __builtin_amdgcn_global_load_lds((const unsigned*)((const char*)(gbase) + (voff)[_i]), (PG8_LAS unsigned*)(lds + (bufoff) + ldsw + _i * 8192), 16, 0, 0); } while (0)
#define PG8_LDA(dst, b, h) do { _Pragma("unroll") for (int m = 0; m < 4; ++m) _Pragma("unroll") for (int k = 0; k < 2; ++k) dst[m][k] = *(const PG8_LAS bf16x8*)(lds + PG8_SA(b, h) + aoff + m * 2048 + k * 1024); } while (0)
#define PG8_LDB(dst, b, h) do { _Pragma("unroll") for (int n = 0; n < 2; ++n) _Pragma("unroll") for (int k = 0; k < 2; ++k) dst[n][k] = *(const PG8_LAS bf16x8*)(lds + PG8_SB(b, h) + boff + n * 2048 + k * 1024); } while (0)
#define PG8_MMA(ai, bj, At, Bt) do { __builtin_amdgcn_s_setprio(1); _Pragma("unroll") for (int m = 0; m < 4; ++m) _Pragma("unroll") for (int n = 0; n < 2; ++n) _Pragma("unroll") for (int k = 0; k < 2; ++k) \
        acc[ai][bj][m][n] = __builtin_amdgcn_mfma_f32_16x16x32_bf16(Bt[n][k], At[m][k], acc[ai][bj][m][n], 0, 0, 0); __builtin_amdgcn_s_setprio(0); } while (0)
#define PG8_WAIT_V(n) asm volatile("s_waitcnt vmcnt(" #n ")" ::: "memory")
#define PG8_WAIT_L(n) asm volatile("s_waitcnt lgkmcnt(" #n ")" ::: "memory")
#define PG8_BAR __builtin_amdgcn_s_barrier()
#define PG8_SCHED __builtin_amdgcn_sched_barrier(0)
    Unit cur, nxt; int ui = 0;
    if (!S.next(0, cur)) return;
    f32x4 acc[2][2][4][2];
#pragma unroll
    for (int a = 0; a < 2; ++a)
#pragma unroll
        for (int b = 0; b < 2; ++b)
#pragma unroll
            for (int m = 0; m < 4; ++m)
#pragma unroll
                for (int n = 0; n < 2; ++n) acc[a][b][m][n] = (f32x4){0.f, 0.f, 0.f, 0.f};
    bf16x8 At[4][2], B0[2][2], B1[2][2];
    const char* cA = (const char*)g.A + (size_t)cur.pm * tstep; const char* cB = (const char*)g.Bt + (size_t)cur.pn * tstep;
    S.a_ready(cur);
    if constexpr (SP2) {
        PG8_STAGE(PG8_SB(0, 0), cB, voffB); PG8_STAGE(PG8_SB(0, 1), cB + hstep, voffB); PG8_STAGE(PG8_SA(0, 0), cA, voffA); PG8_STAGE(PG8_SA(0, 1), cA + hstep, voffA);
        if (wr == 1) PG8_BAR;
        PG8_WAIT_V(2); PG8_BAR;
        PG8_STAGE(PG8_SB(1, 0), cB + kstep, voffB); PG8_STAGE(PG8_SA(1, 0), cA + kstep, voffA); PG8_STAGE(PG8_SB(1, 1), cB + hstep + kstep, voffB);
        PG8_WAIT_V(6); PG8_BAR;
    } else {
        PG8_STAGE(PG8_SB(0, 0), cB, voffB); PG8_STAGE(PG8_SA(0, 0), cA, voffA); PG8_STAGE(PG8_SB(0, 1), cB + hstep, voffB); PG8_STAGE(PG8_SA(0, 1), cA + hstep, voffA);
        if (wr == 1) PG8_BAR;
        PG8_WAIT_V(4); PG8_BAR;
        PG8_STAGE(PG8_SB(1, 0), cB + kstep, voffB); PG8_STAGE(PG8_SA(1, 0), cA + kstep, voffA); PG8_STAGE(PG8_SB(1, 1), cB + hstep + kstep, voffB);
        PG8_WAIT_V(6); PG8_BAR;
    }
    for (;;) {
        const bool has_next = S.next(ui + 1, nxt);
        const char* nA = has_next ? (const char*)g.A + (size_t)nxt.pm * tstep : cA; const char* nB = has_next ? (const char*)g.Bt + (size_t)nxt.pn * tstep : cB;
        for (int t = 0; t < nt; t += 2) {
            const bool last = (t == nt - 2);
            const char* a1 = cA + (size_t)(t + 1) * kstep;
            const char* a2 = last ? nA : cA + (size_t)(t + 2) * kstep; const char* b2 = last ? nB : cB + (size_t)(t + 2) * kstep;
            const char* a3 = a2 + kstep; const char* b3 = b2 + kstep;
            if (last && has_next) S.a_ready(nxt);
            if constexpr (SP2) {
            PG8_LDB(B0, 0, 0); PG8_LDB(B1, 0, 1); PG8_SCHED; PG8_LDA(At, 0, 0); PG8_STAGE(PG8_SA(1, 1), a1 + hstep, voffA);
            PG8_WAIT_V(8); PG8_WAIT_L(0); PG8_BAR; PG8_MMA(0, 0, At, B0); PG8_MMA(0, 1, At, B1); PG8_BAR; PG8_SCHED;
            PG8_LDA(At, 0, 1); PG8_STAGE(PG8_SB(0, 0), b2, voffB); PG8_STAGE(PG8_SB(0, 1), b2 + hstep, voffB); PG8_STAGE(PG8_SA(0, 0), a2, voffA);
            PG8_WAIT_V(8); PG8_WAIT_L(0); PG8_BAR; PG8_MMA(1, 0, At, B0); PG8_MMA(1, 1, At, B1); PG8_BAR; PG8_SCHED;
            PG8_LDB(B0, 1, 0); PG8_LDB(B1, 1, 1); PG8_SCHED; PG8_LDA(At, 1, 0); PG8_STAGE(PG8_SA(0, 1), a2 + hstep, voffA);
            PG8_WAIT_V(8); PG8_WAIT_L(0); PG8_BAR; PG8_MMA(0, 0, At, B0); PG8_MMA(0, 1, At, B1); PG8_BAR; PG8_SCHED;
            PG8_LDA(At, 1, 1); PG8_STAGE(PG8_SB(1, 0), b3, voffB); PG8_STAGE(PG8_SB(1, 1), b3 + hstep, voffB); PG8_STAGE(PG8_SA(1, 0), a3, voffA);
            PG8_WAIT_V(8); PG8_WAIT_L(0); PG8_BAR; PG8_MMA(1, 0, At, B0); PG8_MMA(1, 1, At, B1); PG8_BAR; PG8_SCHED;
            } else {
            PG8_LDB(B0, 0, 0); PG8_SCHED; PG8_LDA(At, 0, 0); PG8_STAGE(PG8_SA(1, 1), a1 + hstep, voffA);
            PG8_WAIT_L(8); PG8_BAR; PG8_WAIT_L(0); PG8_MMA(0, 0, At, B0); PG8_BAR; PG8_SCHED;
            PG8_LDB(B1, 0, 1); PG8_STAGE(PG8_SB(0, 0), b2, voffB);
            PG8_BAR; PG8_WAIT_L(0); PG8_MMA(0, 1, At, B1); PG8_BAR;
            PG8_LDA(At, 0, 1); PG8_STAGE(PG8_SA(0, 0), a2, voffA);
            PG8_BAR; PG8_WAIT_L(0); PG8_MMA(1, 0, At, B0); PG8_BAR; PG8_SCHED;
            PG8_STAGE(PG8_SB(0, 1), b2 + hstep, voffB);
            PG8_WAIT_V(6); PG8_BAR; PG8_MMA(1, 1, At, B1); PG8_BAR;
            PG8_LDB(B0, 1, 0); PG8_SCHED; PG8_LDA(At, 1, 0); PG8_STAGE(PG8_SA(0, 1), a2 + hstep, voffA);
            PG8_WAIT_L(8); PG8_BAR; PG8_WAIT_L(0); PG8_MMA(0, 0, At, B0); PG8_BAR; PG8_SCHED;
            PG8_LDB(B1, 1, 1); PG8_STAGE(PG8_SB(1, 0), b3, voffB);
            PG8_BAR; PG8_WAIT_L(0); PG8_MMA(0, 1, At, B1); PG8_BAR;
            PG8_LDA(At, 1, 1); PG8_STAGE(PG8_SA(1, 0), a3, voffA);
            PG8_BAR; PG8_WAIT_L(0); PG8_MMA(1, 0, At, B0); PG8_BAR; PG8_SCHED;
            PG8_STAGE(PG8_SB(1, 1), b3 + hstep, voffB);
            PG8_WAIT_V(6); PG8_BAR; PG8_MMA(1, 1, At, B1); PG8_BAR;
            }
        }
        if constexpr (ALIGN_EPI) { if (wr == 0) PG8_BAR; }
        if constexpr (!Epi::AFTER_DRAIN) { E(acc, cur, wr, wc, fr, fq, ui); S.done(cur); }
        if (!has_next) break;
#pragma unroll
        for (int a = 0; a < 2; ++a)
#pragma unroll
            for (int b = 0; b < 2; ++b)
#pragma unroll
                for (int m = 0; m < 4; ++m)
#pragma unroll
                    for (int n = 0; n < 2; ++n) acc[a][b][m][n] = (f32x4){0.f, 0.f, 0.f, 0.f};
        cur = nxt; cA = nA; cB = nB; ++ui;
        if constexpr (ALIGN_EPI) { if (wr == 1) PG8_BAR; }
    }
    PG8_WAIT_V(0);
    if constexpr (!ALIGN_EPI) { if (wr == 0) PG8_BAR; }
    PG8_BAR;
    if constexpr (Epi::AFTER_DRAIN) { E.fused(acc, cur, wr, wc, fr, fq, lds, wid, lane); S.done(cur); }
#undef PG8_SA
#undef PG8_SB
#undef PG8_STAGE
#undef PG8_LDA
#undef PG8_LDB
#undef PG8_MMA
#undef PG8_WAIT_V
#undef PG8_WAIT_L
#undef PG8_BAR
#undef PG8_SCHED
}
}
constexpr int NWAVES = 8;
constexpr int DM = 1024, SEQ = 16384, DEPTH = 4, DECB = 16, DECS = 64, PAST = 4096;
constexpr int M = SEQ + DECB * DECS;
constexpr int NIN = pg8::IN_N;
constexpr int DFF = 2816, NF1 = 2 * DFF;
constexpr int WIN_ORIG = 3088;
constexpr int NCHUNK = M / 64;
constexpr int NPCH = SEQ / 64;
constexpr float RMS_EPS = 1e-6f;
constexpr size_t OY = 0, OK_P = 17825792, OV_P = 51380224, OG_P = 84934656, OK_S = 85065728, OV_S = 87162880, OG_S = 89260032, OUT_TOTAL = 91357184;

constexpr size_t MiB = 1u << 20;
constexpr size_t WS_CTL = 0, CTL_ZERO_BYTES = 1 * MiB;
constexpr size_t WS_W = 2 * MiB, W_LAYER = 25 * MiB;
constexpr size_t WO_IN = 0, WO_OUT = 6815744, WO_F1 = WO_OUT + 2 * MiB, WO_F2 = WO_F1 + 11 * MiB;
static_assert(WO_F2 + (size_t)DM * DFF * 2 == W_LAYER, "weight map");
constexpr size_t WS_X = 104 * MiB;
constexpr size_t WS_XN = 172 * MiB;
constexpr size_t WS_ACT = 206 * MiB;
constexpr size_t WS_MIX = 317 * MiB;
constexpr size_t WS_H = 351 * MiB;
constexpr size_t WS_LOGA = 445 * MiB;
constexpr size_t WS_U = 462 * MiB;
constexpr size_t WS_D = 496 * MiB;
constexpr size_t WS_SC = 497 * MiB;
constexpr size_t WS_OI = 529 * MiB;
constexpr size_t WS_QT = 563 * MiB;
constexpr size_t WS_RSQ = 576 * MiB;
constexpr size_t WS_END = 588 * MiB;
static_assert(WS_X + (size_t)M * DM * 4 <= WS_XN && WS_XN + (size_t)M * DM * 2 <= WS_ACT && WS_ACT + (size_t)M * NIN * 2 <= WS_MIX && WS_MIX + (size_t)M * DM * 2 <= WS_H &&
              WS_H + (size_t)M * DFF * 2 <= WS_LOGA && WS_LOGA + (size_t)M * 256 * 4 <= WS_U && WS_U + (size_t)NCHUNK * 4 * 64 * 128 * 4 <= WS_D && WS_D + (size_t)NCHUNK * 4 * 64 * 4 <= WS_SC &&
              WS_SC + (size_t)NPCH * 4 * 64 * 128 * 4 <= WS_OI && WS_OI + (size_t)M * 512 * 4 <= WS_QT && WS_QT + (size_t)M * 256 * 2 <= WS_RSQ && WS_RSQ + (size_t)9 * M * 64 <= WS_END, "d_ws map");
constexpr int CW_TMO = 0, CW_CODE = 1;
constexpr int CW_BAR = 4096;
constexpr int CW_QUEUE = 16384;

constexpr int RING_OFF = 0, RING_BYTES = 131072;
constexpr int LDSCTL_OFF = RING_BYTES, MISC_OFF = LDSCTL_OFF + 320;
constexpr int LDS_BYTES = 147456;

#define GAS __attribute__((address_space(1)))
#define LAS __attribute__((address_space(3)))
typedef unsigned short bf16;
typedef unsigned v4u __attribute__((ext_vector_type(4)));
typedef unsigned v2u __attribute__((ext_vector_type(2)));
typedef float f32x4 __attribute__((ext_vector_type(4)));
typedef float f32x16 __attribute__((ext_vector_type(16)));
typedef short bf16x8 __attribute__((ext_vector_type(8)));
typedef short s16x4 __attribute__((ext_vector_type(4)));
typedef GAS unsigned gu32;
#define RLX_AGENT __ATOMIC_RELAXED, __HIP_MEMORY_SCOPE_AGENT
#define LDS_WAIT() asm volatile("s_waitcnt lgkmcnt(0)" ::: "memory")
#define VM_WAIT() asm volatile("s_waitcnt vmcnt(0)" ::: "memory")
__device__ __forceinline__ unsigned f2bf(float f) { unsigned u = __builtin_bit_cast(unsigned, f); return (u + 0x7fffu + ((u >> 16) & 1u)) >> 16; }
__device__ __forceinline__ unsigned pk2(float lo, float hi) { return f2bf(lo) | (f2bf(hi) << 16); }
__device__ __forceinline__ float bf2f(unsigned short b) { return __builtin_bit_cast(float, (unsigned)b << 16); }
__device__ __forceinline__ float wave_sum(float v) {
#pragma unroll
    for (int o = 1; o < 64; o <<= 1) v += __shfl_xor(v, o);
    return v;
}
#define XB_TMO      128
#define XB_XCNT(j)  (256  + 64 * (j))
#define XB_XSUB(j)  (1280 + 64 * (j))
#define XB_XGEN(j)  (2304 + 64 * (j))
#define XB_TOP      3328
#define XB_TOPGEN   3392
#define XCD_BAR_WORDS 3456
#define XB_SPIN_CAP (1u << 18)

__device__ __forceinline__ unsigned xb_ld(unsigned* p)              { return __hip_atomic_load(p, __ATOMIC_RELAXED, __HIP_MEMORY_SCOPE_AGENT); }
__device__ __forceinline__ unsigned xb_add(unsigned* p, unsigned v) { return __hip_atomic_fetch_add(p, v, __ATOMIC_RELAXED, __HIP_MEMORY_SCOPE_AGENT); }
__device__ __forceinline__ unsigned xb_xcc_id() { return (unsigned)__builtin_amdgcn_s_getreg((3 << 11) | 20) & 0xFu; }
#define XB_SPIN(cond, bar) do { unsigned _sp = 0; while (cond) { __builtin_amdgcn_s_sleep(1); \
    if ((++_sp & 255u) == 0u) { if (xb_ld(&(bar)[XB_TMO])) break; if (_sp > XB_SPIN_CAP) { atomicAdd(&(bar)[XB_TMO], 1u); break; } } } } while (0)

struct XcdBarrier {
    unsigned* bar; unsigned x;
    volatile LAS unsigned* st;
};

__device__ __forceinline__ XcdBarrier xcd_barrier_post(unsigned* bar, volatile LAS unsigned* st) {
    XcdBarrier b; b.bar = bar; b.x = xb_xcc_id(); b.st = st;
    if (threadIdx.x == 0) (void)xb_add(&bar[XB_XCNT(b.x)], 1u);
    return b;
}
__device__ __forceinline__ void xcd_barrier_complete(unsigned* bar, unsigned x, unsigned& nloc, unsigned& nx) {
    const unsigned G = gridDim.x * gridDim.y * gridDim.z;
    unsigned sum, cnt, mine, sp = 0u;
    for (;;) {
        sum = 0u; cnt = 0u; mine = 0u;
#pragma unroll
        for (unsigned j = 0; j < 16; ++j) { const unsigned c = xb_ld(&bar[XB_XCNT(j)]); sum += c; cnt += (c > 0u) ? 1u : 0u; mine = (j == x) ? c : mine; }
        if (sum == G) break;
        __builtin_amdgcn_s_sleep(1);
        if ((++sp & 255u) == 0u) { if (xb_ld(&bar[XB_TMO])) break; if (sp > XB_SPIN_CAP) { atomicAdd(&bar[XB_TMO], 1u); break; } }
    }
    nloc = mine > 0u ? mine : 1u; nx = cnt > 0u ? cnt : 1u;
}

__device__ __forceinline__ void xcd_barrier(const XcdBarrier& b) {
    asm volatile("s_waitcnt vmcnt(0)" ::: "memory");
    __syncthreads();
    if (threadIdx.x == 0) {
        unsigned* bar = b.bar;
        __builtin_amdgcn_s_waitcnt(0);
        unsigned nloc = b.st[0], nx = b.st[1];
        if (nloc == 0u) { xcd_barrier_complete(bar, b.x, nloc, nx); b.st[0] = nloc; b.st[1] = nx; }
        const unsigned old = xb_add(&bar[XB_XSUB(b.x)], 1u);
        const unsigned gen = old / nloc;
        if (old + 1u == (gen + 1u) * nloc) {
            __builtin_amdgcn_fence(__ATOMIC_RELEASE, "agent");
            asm volatile("s_waitcnt vmcnt(0)" ::: "memory");
            const unsigned og = xb_add(&bar[XB_TOP], 1u);
            const unsigned tg = og / nx;
            if (og + 1u == (tg + 1u) * nx) xb_add(&bar[XB_TOPGEN], 1u);
            else XB_SPIN(xb_ld(&bar[XB_TOPGEN]) == tg, bar);
            __builtin_amdgcn_fence(__ATOMIC_ACQUIRE, "agent");
            xb_add(&bar[XB_XGEN(b.x)], 1u);
            asm volatile("s_waitcnt vmcnt(0)" ::: "memory");
        } else {
            XB_SPIN(xb_ld(&bar[XB_XGEN(b.x)]) == gen, bar);
            __builtin_amdgcn_fence(__ATOMIC_ACQUIRE, "agent");
            asm volatile("s_waitcnt vmcnt(0)" ::: "memory");
        }
    }
    __syncthreads();
}
struct Frame {
    LAS unsigned char* lds;
};
__device__ __forceinline__ int grid_n() { return (int)gridDim.x; }
__device__ __forceinline__ int vcu_id() { const int G = (int)gridDim.x, bx = (int)blockIdx.x; return (G % 8 == 0) ? (bx % 8) * (G / 8) + bx / 8 : bx; }
__device__ __forceinline__ int fresh_tid() { int t = threadIdx.x; asm volatile("" : "+v"(t)); return t; }

__device__ __forceinline__ void tr_store(LAS float* scr, bf16* WT, int K, int dstrow0, int k0, int lane) {
    LDS_WAIT(); asm volatile("" ::: "memory");
    const int c = lane & 7;
#pragma unroll
    for (int j = 0; j < 4; ++j) { const int n = (lane >> 3) + 8 * j; const LAS float* s = scr + (8 * c) * 33 + n;
        v4u o; o.x = pk2(s[0 * 33], s[1 * 33]); o.y = pk2(s[2 * 33], s[3 * 33]); o.z = pk2(s[4 * 33], s[5 * 33]); o.w = pk2(s[6 * 33], s[7 * 33]);
        *(GAS v4u*)(WT + (size_t)(dstrow0 + n) * K + k0 + 8 * c) = o; }
    LDS_WAIT(); asm volatile("" ::: "memory");
}
__device__ __forceinline__ void tr_item(const float* W, int ld, int K, int srccol0, bf16* WT, int dstrow0, int k0, LAS float* scr, int lane, const float* gk) {
    const int ks = lane >> 3, nq = (lane & 7) * 4; f32x4 v[8];
#pragma unroll
    for (int i = 0; i < 8; ++i) v[i] = *(const f32x4*)(W + (size_t)(k0 + 8 * i + ks) * ld + srccol0 + nq);
#pragma unroll
    for (int i = 0; i < 8; ++i) { const int kk = 8 * i + ks; f32x4 x = v[i]; if (gk) x = x * gk[k0 + kk];
        LAS float* d = scr + kk * 33 + nq; d[0] = x[0]; d[1] = x[1]; d[2] = x[2]; d[3] = x[3]; }
    tr_store(scr, WT, K, dstrow0, k0, lane);
}
__device__ __forceinline__ void tr_item_z(const float* Win, const float* a2, int n0z, bf16* WT, int k0, LAS float* scr, int lane, const float* gk) {
    float av[16];
#pragma unroll
    for (int r = 0; r < 16; ++r) av[r] = a2[r * 256 + n0z + (lane & 31)];
#pragma unroll 8
    for (int i = 0; i < 32; ++i) { const int kk = 2 * i + (lane >> 5); const float* wr_ = Win + (size_t)(k0 + kk) * WIN_ORIG + 1536; float s = 0.f;
#pragma unroll
        for (int r = 0; r < 16; ++r) s = fmaf(wr_[r], av[r], s);
        scr[kk * 33 + (lane & 31)] = s * gk[k0 + kk]; }
    tr_store(scr, WT, DM, 512 + n0z, k0, lane);
}

struct Args { const float* in[18]; float* out; unsigned char* ws; };
constexpr int PTAB_OFF = MISC_OFF + 128;
__device__ __forceinline__ const float* inp(const Frame& F, int i) {
    unsigned off = (unsigned)(PTAB_OFF + 8 * i); asm volatile("" : "+v"(off));
    const volatile LAS unsigned* t = (const volatile LAS unsigned*)(F.lds + off);
    const unsigned lo = __builtin_amdgcn_readfirstlane(t[0]), hi = __builtin_amdgcn_readfirstlane(t[1]);
    return (const float*)(((unsigned long long)hi << 32) | lo);
}
__device__ __forceinline__ float* outp(const Frame& F) { return (float*)inp(F, 18); }
__device__ __forceinline__ unsigned char* wsp(const Frame& F) { return (unsigned char*)inp(F, 19); }

__device__ __forceinline__ void p0_prologue(Frame& F) {
    const int tid_ = fresh_tid(), lane_ = tid_ & 63, wave_ = __builtin_amdgcn_readfirstlane(tid_ >> 6);
    LAS float* scr = (LAS float*)(F.lds + RING_OFF + wave_ * 16384);
    const int gw = vcu_id() * NWAVES + wave_, NGW = grid_n() * NWAVES;
    constexpr int I_IN = 16 * 104, I_OUT = 16 * 32, I_F1 = 16 * 176, I_F2 = 44 * 32, I_L = I_IN + I_OUT + I_F1 + I_F2;
    for (int it = gw; it < DEPTH * I_L; it += NGW) {
        const int l = it / I_L; int r = it % I_L;
        unsigned char* wl = wsp(F) + WS_W + (size_t)l * W_LAYER;
        if (r < I_IN) { const int kb = r / 104, nb = r % 104, n0 = 32 * nb; const float* W = inp(F, 5) + (size_t)l * DM * WIN_ORIG;
            if (n0 >= 512 && n0 < 768) tr_item_z(W, inp(F, 6) + (size_t)l * 16 * 256, n0 - 512, (bf16*)(wl + WO_IN), 64 * kb, scr, lane_, inp(F, 12) + (size_t)l * DM);
            else { const int src = n0 < 512 ? n0 : (n0 < 1792 ? n0 - 256 : n0 - 240); tr_item(W, WIN_ORIG, DM, src, (bf16*)(wl + WO_IN), n0, 64 * kb, scr, lane_, inp(F, 12) + (size_t)l * DM); }
            continue; }
        r -= I_IN;
        if (r < I_OUT) { const int kb = r / 32, nb = r % 32; tr_item(inp(F, 11) + (size_t)l * DM * DM, DM, DM, 32 * nb, (bf16*)(wl + WO_OUT), 32 * nb, 64 * kb, scr, lane_, nullptr); continue; }
        r -= I_OUT;
        if (r < I_F1) { const int kb = r / 176, nb = r % 176, n0 = 32 * nb, pn = n0 >> 8, j = n0 & 255; const int src = j < 128 ? 128 * pn + j : DFF + 128 * pn + (j - 128);
            tr_item(inp(F, 14) + (size_t)l * DM * NF1, NF1, DM, src, (bf16*)(wl + WO_F1), n0, 64 * kb, scr, lane_, inp(F, 13) + (size_t)l * DM); continue; }
        r -= I_F1;
        { const int kb = r / 32, nb = r % 32; tr_item(inp(F, 15) + (size_t)l * DFF * DM, DM, DFF, 32 * nb, (bf16*)(wl + WO_F2), 32 * nb, 64 * kb, scr, lane_, nullptr); }
    }
}

__device__ __forceinline__ void rows_to_bf16_sq(Frame& F, const float* srcp, const float* srcs, bf16* XB, float* rowsq) {
    const int tid_ = fresh_tid(), lane_ = tid_ & 63, wave_ = __builtin_amdgcn_readfirstlane(tid_ >> 6);
    const int gw = vcu_id() * NWAVES + wave_, NGW = grid_n() * NWAVES;
    for (int m = gw; m < M; m += NGW) {
        const float* xrow = m < SEQ ? srcp + (size_t)m * DM : srcs + (size_t)(m - SEQ) * DM;
        const GAS f32x4* xr = (const GAS f32x4*)xrow + lane_;
        f32x4 v[4]; float s = 0.f;
#pragma unroll
        for (int j = 0; j < 4; ++j) { v[j] = xr[64 * j]; s += (v[j].x * v[j].x + v[j].y * v[j].y) + (v[j].z * v[j].z + v[j].w * v[j].w); }
        s = wave_sum(s);
        GAS unsigned long long* o8 = (GAS unsigned long long*)(XB + (size_t)m * DM) + lane_;
#pragma unroll
        for (int j = 0; j < 4; ++j) o8[64 * j] = (unsigned long long)pk2(v[j].x, v[j].y) | ((unsigned long long)pk2(v[j].z, v[j].w) << 32);
        if (lane_ < 16) rowsq[(size_t)m * 16 + lane_] = lane_ == 0 ? s : 0.f;
    }
}
__device__ __forceinline__ void norm_rows_f32(Frame& F, const bf16* src, const float* g, float* out) {
    const int tid_ = fresh_tid(), lane_ = tid_ & 63, wave_ = __builtin_amdgcn_readfirstlane(tid_ >> 6);
    const int gw = vcu_id() * NWAVES + wave_, NGW = grid_n() * NWAVES;
    f32x4 gv[4];
#pragma unroll
    for (int j = 0; j < 4; ++j) gv[j] = ((const GAS f32x4*)g)[lane_ + 64 * j];
    for (int m = gw; m < M; m += NGW) {
        const GAS v2u* xr = (const GAS v2u*)(src + (size_t)m * DM) + lane_;
        f32x4 v[4]; float s = 0.f;
#pragma unroll
        for (int j = 0; j < 4; ++j) { const v2u w = xr[64 * j]; v[j].x = __builtin_bit_cast(float, w.x << 16); v[j].y = __builtin_bit_cast(float, w.x & 0xffff0000u);
            v[j].z = __builtin_bit_cast(float, w.y << 16); v[j].w = __builtin_bit_cast(float, w.y & 0xffff0000u);
            s += (v[j].x * v[j].x + v[j].y * v[j].y) + (v[j].z * v[j].z + v[j].w * v[j].w); }
        const float rstd = 1.f / sqrtf(wave_sum(s) * (1.f / DM) + RMS_EPS);
        GAS f32x4* o = (GAS f32x4*)(out + (size_t)m * DM) + lane_;
#pragma unroll
        for (int j = 0; j < 4; ++j) o[64 * j] = v[j] * rstd * gv[j];
    }
}

constexpr int RSTD_OFF = MISC_OFF + 512;
static_assert(RSTD_OFF + 8 * 256 * 4 <= LDS_BYTES, "rstd table");
__device__ __forceinline__ void rstd_prepass(Frame& F, const pg8::StaticOrder& S, const float* rsq) {
    const int tid_ = fresh_tid(); LAS float* tab = (LAS float*)(F.lds + RSTD_OFF);
    for (int idx = tid_; idx < 8 * 256; idx += NWAVES * 64) { pg8::Unit u; if (!S.next(idx >> 8, u)) break; tab[idx] = pg8::row_rstd(rsq, u.pm * 256 + (idx & 255)); }
    __syncthreads();
}

#ifdef PROBE_EXTRA_BARRIER
#define PROBE_XBAR asm volatile("s_barrier" ::: "memory")
#else
#define PROBE_XBAR do {} while (0)
#endif
#ifdef PROBE_EXTRA_EXP
#define PROBE_XEXP(x) do { float t_; asm volatile("v_exp_f32 %0, %1" : "=v"(t_) : "v"(x)); } while (0)
#else
#define PROBE_XEXP(x) do {} while (0)
#endif
namespace att {
typedef float f32x8 __attribute__((ext_vector_type(8)));
typedef unsigned u32x4 __attribute__((ext_vector_type(4)));
constexpr float THRL = 8.f * 1.4426950408889634f;
constexpr int SHM_V = 16384, SHM_K = 16384;
constexpr int OFF_V = 0, OFF_K = 2 * SHM_V;
constexpr int RK = 0, RV = 3 * SHM_K;
constexpr int OFF_WS = 7 * SHM_K, OFF_TAB = OFF_WS + 2048, TAB_N = 384, OFF_LAM = OFF_TAB + 4 * TAB_N * 4, OFF_G3 = OFF_LAM + 256, OFF_END = OFF_G3 + 1024;
static_assert(OFF_END <= RING_BYTES, "attention LDS map");
#define KSWZ(row, colB) ((row) * 256 + ((colB) ^ (((row) & 7) << 4)))
#define SBAR() __builtin_amdgcn_sched_barrier(0)
__device__ __forceinline__ int crow(int r, int hi) { return (r & 3) + 8 * (r >> 2) + 4 * hi; }
__device__ __forceinline__ unsigned cvtpk(float lo, float hi) { unsigned r; asm volatile("v_cvt_pk_bf16_f32 %0, %1, %2" : "=v"(r) : "v"(lo), "v"(hi)); return r; }
template <bool F32> struct Stage;
template <> struct Stage<false> { using E = bf16; using T = bf16x8;
  __device__ static __forceinline__ T ld8(const E* p) { return *reinterpret_cast<const bf16x8*>(p); }
  __device__ static __forceinline__ bf16x8 tobf(T x) { return x; } };
template <> struct Stage<true> { using E = float; using T = f32x8;
  __device__ static __forceinline__ T ld8(const E* p) { return *reinterpret_cast<const f32x8*>(p); }
  __device__ static __forceinline__ bf16x8 tobf(T x) { u32x4 w = {cvtpk(x[0], x[1]), cvtpk(x[2], x[3]), cvtpk(x[4], x[5]), cvtpk(x[6], x[7])}; return __builtin_bit_cast(bf16x8, w); } };

__device__ __forceinline__ float rowmax32(const f32x16& p0, const f32x16& p1) {
  float pmax = p0[0];
#pragma unroll
  for (int r = 1; r < 16; ++r) pmax = fmaxf(pmax, p0[r]);
#pragma unroll
  for (int r = 0; r < 16; ++r) pmax = fmaxf(pmax, p1[r]);
  auto rr = __builtin_amdgcn_permlane32_swap(__float_as_uint(pmax), __float_as_uint(pmax), false, false);
  return fmaxf(__uint_as_float(rr[0]), __uint_as_float(rr[1]));
}
__device__ __forceinline__ void partialSM(f32x16& p0, f32x16& p1, float& m_reg, float& mn, float& alpha) {
  const float pmax = rowmax32(p0, p1);
  if (__builtin_expect(__all(pmax - m_reg <= THRL), 1)) { mn = m_reg; alpha = 1.f; }
  else { mn = fmaxf(m_reg, pmax); alpha = __builtin_amdgcn_exp2f(m_reg - mn); m_reg = mn; }
#pragma unroll
  for (int r = 0; r < 16; ++r) p0[r] -= mn;
#pragma unroll
  for (int r = 0; r < 16; ++r) p1[r] -= mn;
#pragma unroll
  for (int r = 0; r < 16; ++r) p0[r] = __builtin_amdgcn_exp2f(p0[r]);
}
__device__ __forceinline__ void finishSM(f32x16& p0, f32x16& p1, float alpha, float& l_reg, bf16x8& pa0, bf16x8& pa1, bf16x8& pa2, bf16x8& pa3) {
#pragma unroll
  for (int r = 0; r < 16; ++r) p1[r] = __builtin_amdgcn_exp2f(p1[r]);
  float ps = 0;
#pragma unroll
  for (int r = 0; r < 16; ++r) ps += p0[r];
#pragma unroll
  for (int r = 0; r < 16; ++r) ps += p1[r];
  { auto rr = __builtin_amdgcn_permlane32_swap(__float_as_uint(ps), __float_as_uint(ps), false, false);
    ps = __uint_as_float(rr[0]) + __uint_as_float(rr[1]); }
  l_reg = l_reg * alpha + ps;
#define PK4(P, BASE, OUT) do { unsigned a0 = cvtpk(P[BASE + 0], P[BASE + 1]), a1 = cvtpk(P[BASE + 2], P[BASE + 3]);   \
    unsigned b0 = cvtpk(P[BASE + 4], P[BASE + 5]), b1 = cvtpk(P[BASE + 6], P[BASE + 7]);                              \
    auto r0 = __builtin_amdgcn_permlane32_swap(a0, b0, false, false); auto r1 = __builtin_amdgcn_permlane32_swap(a1, b1, false, false); \
    u32x4 w = {r0[0], r1[0], r0[1], r1[1]}; OUT = __builtin_bit_cast(bf16x8, w); } while (0)
  PK4(p0, 0, pa0); PK4(p0, 8, pa1); PK4(p1, 0, pa2); PK4(p1, 8, pa3);
#undef PK4
}
template <bool QL>
__device__ __forceinline__ void qkt(f32x16& p0, f32x16& p1, const LAS char* Ks, const bf16x8* qr, const LAS char* ql, int r32, int hi, int g) {
  p0 = f32x16{}; p1 = f32x16{};
#pragma unroll
  for (int d0 = 0; d0 < 4; ++d0) { const int cb = ((g * 4 + d0) * 16 + hi * 8) * 2;
    const bf16x8 b0 = *(const LAS bf16x8*)(Ks + KSWZ(r32, cb));
    const bf16x8 b1 = *(const LAS bf16x8*)(Ks + KSWZ(32 + r32, cb));
    bf16x8 q; if constexpr (QL) q = *(const LAS bf16x8*)(ql + d0 * 1024); else q = qr[d0];
    p0 = __builtin_amdgcn_mfma_f32_32x32x16_bf16(b0, q, p0, 0, 0, 0);
    p1 = __builtin_amdgcn_mfma_f32_32x32x16_bf16(b1, q, p1, 0, 0, 0); }
}
__device__ __forceinline__ int v_st(int k, int c) { const int kk = (k & ~0xC) | ((k & 4) << 1) | ((k & 8) >> 1); return ((kk >> 3) * 4 + (c >> 5)) * 512 + ((kk & 7) * 32 + (c & 31)) * 2; }
__device__ __forceinline__ int v_rd_base(int lane) { return ((lane & 3) << 3) | (((lane >> 2) & 3) << 6) | (((lane >> 4) & 1) << 5) | (((lane >> 5) & 1) << 8); }
constexpr int v_rd_off(int d0, int ks, int half) { return d0 * 512 + ks * 4096 + half * 2048; }
typedef short v4i16_t __attribute__((ext_vector_type(4)));
template <int OFF> __device__ __forceinline__ s16x4 tr_read(const LAS char* vb) {
  return __builtin_bit_cast(s16x4, __builtin_amdgcn_ds_read_tr16_b64_v4i16((LAS v4i16_t*)(vb + OFF)));
}
template <int D0> __device__ __forceinline__ void pv_one(f32x16& od, const LAS char* vb, bf16x8 pa0, bf16x8 pa1, bf16x8 pa2, bf16x8 pa3) {
  const s16x4 l0 = tr_read<v_rd_off(D0, 0, 0)>(vb), h0 = tr_read<v_rd_off(D0, 0, 1)>(vb), l1 = tr_read<v_rd_off(D0, 1, 0)>(vb), h1 = tr_read<v_rd_off(D0, 1, 1)>(vb);
  const s16x4 l2 = tr_read<v_rd_off(D0, 2, 0)>(vb), h2 = tr_read<v_rd_off(D0, 2, 1)>(vb), l3 = tr_read<v_rd_off(D0, 3, 0)>(vb), h3 = tr_read<v_rd_off(D0, 3, 1)>(vb);
#define PK(L, H) (bf16x8){L[0], L[1], L[2], L[3], H[0], H[1], H[2], H[3]}
  od = __builtin_amdgcn_mfma_f32_32x32x16_bf16(pa0, PK(l0, h0), od, 0, 0, 0);
  od = __builtin_amdgcn_mfma_f32_32x32x16_bf16(pa1, PK(l1, h1), od, 0, 0, 0);
  od = __builtin_amdgcn_mfma_f32_32x32x16_bf16(pa2, PK(l2, h2), od, 0, 0, 0);
  od = __builtin_amdgcn_mfma_f32_32x32x16_bf16(pa3, PK(l3, h3), od, 0, 0, 0);
#undef PK
}
__device__ __forceinline__ void pv_d0(f32x16* o, const LAS char* vb, bf16x8 pa0, bf16x8 pa1, bf16x8 pa2, bf16x8 pa3) {
  pv_one<0>(o[0], vb, pa0, pa1, pa2, pa3); pv_one<1>(o[1], vb, pa0, pa1, pa2, pa3); pv_one<2>(o[2], vb, pa0, pa1, pa2, pa3); pv_one<3>(o[3], vb, pa0, pa1, pa2, pa3);
}
template <int KS> __device__ __forceinline__ void pv_kstep(f32x16* o, const LAS char* vb, bf16x8 pa) {
  const s16x4 l0 = tr_read<v_rd_off(0, KS, 0)>(vb), h0 = tr_read<v_rd_off(0, KS, 1)>(vb), l1 = tr_read<v_rd_off(1, KS, 0)>(vb), h1 = tr_read<v_rd_off(1, KS, 1)>(vb);
  const s16x4 l2 = tr_read<v_rd_off(2, KS, 0)>(vb), h2 = tr_read<v_rd_off(2, KS, 1)>(vb), l3 = tr_read<v_rd_off(3, KS, 0)>(vb), h3 = tr_read<v_rd_off(3, KS, 1)>(vb);
#define PK(L, H) (bf16x8){L[0], L[1], L[2], L[3], H[0], H[1], H[2], H[3]}
  o[0] = __builtin_amdgcn_mfma_f32_32x32x16_bf16(pa, PK(l0, h0), o[0], 0, 0, 0);
  o[1] = __builtin_amdgcn_mfma_f32_32x32x16_bf16(pa, PK(l1, h1), o[1], 0, 0, 0);
  o[2] = __builtin_amdgcn_mfma_f32_32x32x16_bf16(pa, PK(l2, h2), o[2], 0, 0, 0);
  o[3] = __builtin_amdgcn_mfma_f32_32x32x16_bf16(pa, PK(l3, h3), o[3], 0, 0, 0);
#undef PK
}
struct VF { s16x4 l0, h0, l1, h1, l2, h2, l3, h3; };
template <int KS> __device__ __forceinline__ void vf_load(VF& f, const LAS char* vb) {
  f.l0 = tr_read<v_rd_off(0, KS, 0)>(vb); f.h0 = tr_read<v_rd_off(0, KS, 1)>(vb); f.l1 = tr_read<v_rd_off(1, KS, 0)>(vb); f.h1 = tr_read<v_rd_off(1, KS, 1)>(vb);
  f.l2 = tr_read<v_rd_off(2, KS, 0)>(vb); f.h2 = tr_read<v_rd_off(2, KS, 1)>(vb); f.l3 = tr_read<v_rd_off(3, KS, 0)>(vb); f.h3 = tr_read<v_rd_off(3, KS, 1)>(vb);
}
__device__ __forceinline__ void vf_mma(f32x16* o, const VF& f, bf16x8 pa) {
#define PK(L, H) (bf16x8){L[0], L[1], L[2], L[3], H[0], H[1], H[2], H[3]}
  o[0] = __builtin_amdgcn_mfma_f32_32x32x16_bf16(pa, PK(f.l0, f.h0), o[0], 0, 0, 0);
  o[1] = __builtin_amdgcn_mfma_f32_32x32x16_bf16(pa, PK(f.l1, f.h1), o[1], 0, 0, 0);
  o[2] = __builtin_amdgcn_mfma_f32_32x32x16_bf16(pa, PK(f.l2, f.h2), o[2], 0, 0, 0);
  o[3] = __builtin_amdgcn_mfma_f32_32x32x16_bf16(pa, PK(f.l3, f.h3), o[3], 0, 0, 0);
#undef PK
}
__device__ __forceinline__ void pv_ks(f32x16* o, const LAS char* vb, bf16x8 pa0, bf16x8 pa1, bf16x8 pa2, bf16x8 pa3) {
  pv_kstep<0>(o, vb, pa0); pv_kstep<1>(o, vb, pa1); pv_kstep<2>(o, vb, pa2); pv_kstep<3>(o, vb, pa3);
}

__device__ __forceinline__ int t5_bucket(int rel) {
  const int ret = rel > 0 ? 16 : 0; const int n = rel < 0 ? -rel : rel;
  if (n < 8) return ret + n;
  int large = 8 + (31 - __builtin_clz((unsigned)(n * n))) - 6; if (large > 15) large = 15;
  return ret + large;
}
__device__ __forceinline__ void attn_setup(LAS unsigned char* lds, const float* rel_bias, const float* lamp  , int layer) {
  const int tid = fresh_tid();
  LAS float* tab = (LAS float*)(lds + OFF_TAB);
  for (int e = tid; e < 4 * TAB_N; e += 512) { const int h = e / TAB_N, idx = e % TAB_N, rel = idx - 255;
    tab[e] = (rel_bias[t5_bucket(rel) * 4 + h] - rel_bias[15 * 4 + h]) * 1.4426950408889634f; }
  if (tid < 64) { const float a = lamp[tid] * lamp[64 + tid], b = lamp[128 + tid] * lamp[192 + tid];
    const float sa = wave_sum(a), sb = wave_sum(b);
    if (tid == 0) { const float lam_init = 0.8f - 0.6f * expf(-0.3f * (float)layer);
      ((LAS float*)(lds + OFF_LAM))[0] = expf(sa) - expf(sb) + lam_init; ((LAS float*)(lds + OFF_LAM))[1] = 1.f - lam_init; } }
  __syncthreads();
}


__device__ __forceinline__ void glds16(const void* gsrc, unsigned lds_dst) { unsigned keep;
  asm volatile("s_mov_b32 %0, m0\n\ts_mov_b32 m0, %2\n\ts_nop 0\n\tglobal_load_lds_dwordx4 %1, off\n\ts_mov_b32 m0, %0" : "=&s"(keep) : "v"(gsrc), "s"(lds_dst) : "memory"); }
__device__ __forceinline__ void attn_unit_prompt(LAS unsigned char* lds, const bf16* Kg, const bf16* Vg, const bf16* Qrow0, bf16* Orow0, int NT, int qpos0, int h, const float* gnorm) {
  constexpr int LDK = 3328;
  const int tid = fresh_tid(), wid = __builtin_amdgcn_readfirstlane(tid >> 6), lane = tid & 63, r32 = lane & 31, hi = lane >> 5;
  const int g = wid >> 2, rb = wid & 3;
  LAS char* K_lds = (LAS char*)lds + RK; LAS char* V_lds = (LAS char*)lds + RV;
  LAS float* wsf = (LAS float*)(lds + OFF_WS) + wid * 64; LAS float* li_l = wsf; LAS float* al_l = wsf + 32;
  const LAS float* tab = (const LAS float*)(lds + OFF_TAB) + h * TAB_N;
  float mhat = 0.f; f32x16 o[4] = {}; f32x16 osum = {}; bf16x8 qr[4];
  const bf16x8 kx = {(short)(hi == 0 ? (short)0xBF80 : (short)0), 0, 0, 0, 0, 0, 0, 0};
  bf16x8 qx = {0, 0, 0, 0, 0, 0, 0, 0};
  const bf16* Qw = Qrow0 + (size_t)(rb * 32 + r32) * 3328 + g * 64 + hi * 8;
#pragma unroll
  for (int d0 = 0; d0 < 4; ++d0) qr[d0] = *reinterpret_cast<const bf16x8*>(Qw + d0 * 16);
  const int qpos = qpos0 + rb * 32 + r32;
  unsigned kso0, vso0;
  { const int row = 8 * wid + (lane >> 4); kso0 = (unsigned)(row * LDK * 2 + (((lane & 15) ^ (row & 7)) << 4));
    const int kk = wid * 8 + ((lane & 31) >> 2), k = (kk & ~0xC) | ((kk & 4) << 1) | ((kk & 8) >> 1), c = (lane >> 5) * 32 + (lane & 3) * 8; vso0 = (unsigned)((k * LDK + c) * 2); }
#define KSO(p_) ((p_) == 0 ? kso0 : kso0 + (unsigned)(4 * LDK * 2) + ((kso0 & 64u) ? (unsigned)-64 : 64u))
#define VSO(p_) (vso0 + (unsigned)((p_) * 128))
  const int pw = wid * 2048; const unsigned kl0 = (unsigned)(uintptr_t)K_lds, vl0 = (unsigned)(uintptr_t)V_lds;
#define DMA_K(t, so) do { const char* kb_ = (const char*)(Kg + (size_t)(t) * 64 * LDK); _Pragma("unroll") for (int p_ = 0; p_ < 2; ++p_) \
    glds16(kb_ + KSO(p_), (unsigned)__builtin_amdgcn_readfirstlane((int)(kl0 + (unsigned)((so) + pw + p_ * 1024)))); } while (0)
#define DMA_V(t, so) do { const char* vb_ = (const char*)(Vg + (size_t)(t) * 64 * LDK); _Pragma("unroll") for (int p_ = 0; p_ < 2; ++p_) \
    glds16(vb_ + VSO(p_), (unsigned)__builtin_amdgcn_readfirstlane((int)(vl0 + (unsigned)((so) + pw + p_ * 1024)))); } while (0)
#define WAITBAR(j) do { if ((j) + 2 < NT) asm volatile("s_waitcnt vmcnt(4)\n\ts_barrier" ::: "memory"); else asm volatile("s_waitcnt vmcnt(0)\n\ts_barrier" ::: "memory"); } while (0)
#define RESC(a) do { if (__any((a) < 1.f)) { if (hi == 0) al_l[r32] = (a); asm volatile("s_waitcnt lgkmcnt(0)" ::: "memory"); \
    _Pragma("unroll") for (int d = 0; d < 4; ++d) _Pragma("unroll") for (int r = 0; r < 16; ++r) o[d][r] *= al_l[crow(r, hi)]; \
    _Pragma("unroll") for (int r = 0; r < 16; ++r) osum[r] *= al_l[crow(r, hi)]; } } while (0)
#define QKT(P0, P1, Ks) do { const LAS char* ks_ = (Ks); P0 = __builtin_amdgcn_mfma_f32_32x32x16_bf16(kx, qx, (f32x16){}, 0, 0, 0); P1 = __builtin_amdgcn_mfma_f32_32x32x16_bf16(kx, qx, (f32x16){}, 0, 0, 0); \
    _Pragma("unroll") for (int d0 = 0; d0 < 4; ++d0) { const int cb = ((g * 4 + d0) * 16 + hi * 8) * 2; \
      const bf16x8 b0 = *(const LAS bf16x8*)(ks_ + KSWZ(r32, cb)); const bf16x8 b1 = *(const LAS bf16x8*)(ks_ + KSWZ(32 + r32, cb)); \
      P0 = __builtin_amdgcn_mfma_f32_32x32x16_bf16(b0, qr[d0], P0, 0, 0, 0); P1 = __builtin_amdgcn_mfma_f32_32x32x16_bf16(b1, qr[d0], P1, 0, 0, 0); } } while (0)
#define PARTIAL(P0, P1, AL, FIRST, RMV) do { const float rm_ = (RMV); AL = 1.f; \
    if ((FIRST) || __any(rm_ > THRL)) { asm volatile("; reference moves" ::: "memory"); \
      const float nm_ = bf2f((unsigned short)f2bf(mhat + ((FIRST) ? rm_ : fmaxf(rm_, 0.f)))); const float dl_ = nm_ - mhat; mhat = nm_; \
      _Pragma("unroll") for (int r = 0; r < 16; ++r) { P0[r] -= dl_; P1[r] -= dl_; } \
      qx[0] = (short)(hi == 0 ? (short)(__float_as_uint(mhat) >> 16) : (short)0); \
      if (!(FIRST)) { AL = __builtin_amdgcn_exp2f(-dl_); } } \
    _Pragma("unroll") for (int r = 0; r < 16; ++r) { PROBE_XEXP(P0[r]); PROBE_XEXP(P1[r]); P0[r] = __builtin_amdgcn_exp2f(P0[r]); } } while (0)
#define PK4_(P, BASE, OUT) do { unsigned a0 = cvtpk(P[BASE + 0], P[BASE + 1]), a1 = cvtpk(P[BASE + 2], P[BASE + 3]);   \
    unsigned b0 = cvtpk(P[BASE + 4], P[BASE + 5]), b1 = cvtpk(P[BASE + 6], P[BASE + 7]);                              \
    auto r0 = __builtin_amdgcn_permlane32_swap(a0, b0, false, false); auto r1 = __builtin_amdgcn_permlane32_swap(a1, b1, false, false); \
    u32x4 w = {r0[0], r1[0], r0[1], r1[1]}; OUT = __builtin_bit_cast(bf16x8, w); } while (0)
#define BIASMASK(P0, P1, j) do { if ((j) >= NT - 4) { const bool msk_ = ((j) == NT - 1 && rb < 2); \
    if (msk_) { _Pragma("unroll") for (int r = 0; r < 16; ++r) { P0[r] = -1e30f; P1[r] = -1e30f; } } \
    else { const int base_ = 64 * (j) - qpos + 255 + 4 * hi; \
      _Pragma("unroll") for (int r = 0; r < 16; ++r) { const int i0_ = base_ + (r & 3) + 8 * (r >> 2); P0[r] += tab[i0_]; P1[r] += tab[i0_ + 32]; } } } } while (0)
#define ROT() do { const int t_ = s0; s0 = s1; s1 = s2; s2 = t_; } while (0)
  const LAS char* vrd = V_lds + v_rd_base(lane);
#define ONESMMA(pa) osum = __builtin_amdgcn_mfma_f32_32x32x16_bf16(pa, ones, osum, 0, 0, 0)
#define FINISH_PV(P0, P1, vp, C0, C1, RM) do { const LAS char* vp_ = (vp); VF fa_, fb_; \
    vf_load<0>(fa_, vp_); \
    _Pragma("unroll") for (int r = 0; r < 16; ++r) P1[r] = __builtin_amdgcn_exp2f(P1[r]); \
    bf16x8 pa_; PK4_(P0, 0, pa_); vf_load<1>(fb_, vp_); vf_mma(o, fa_, pa_); ONESMMA(pa_); \
    PK4_(P0, 8, pa_); vf_load<2>(fa_, vp_); vf_mma(o, fb_, pa_); ONESMMA(pa_); \
    RM = rowmax32(C0, C1); \
    PK4_(P1, 0, pa_); vf_load<3>(fb_, vp_); vf_mma(o, fa_, pa_); ONESMMA(pa_); \
    PK4_(P1, 8, pa_); vf_mma(o, fb_, pa_); ONESMMA(pa_); } while (0)
  const bf16x8 ones = {16256, 16256, 16256, 16256, 16256, 16256, 16256, 16256};
  f32x16 pA0, pA1, pB0, pB1; float alA = 1.f, alB = 1.f, rmx;
  int s0 = 2 * SHM_K, s1 = 0, s2 = SHM_K;
  asm volatile("s_waitcnt vmcnt(0)" ::: "memory");
  if (wid >= 4) __builtin_amdgcn_s_setprio(1);
#define VS(t) (((t) & 3) * SHM_V)
  DMA_K(0, 0); DMA_V(0, VS(0)); DMA_K(1, SHM_K); DMA_V(1, VS(1));
  WAITBAR(0); DMA_K(2, s0); DMA_V(2, VS(2));
  QKT(pA0, pA1, K_lds + s1); BIASMASK(pA0, pA1, 0); rmx = rowmax32(pA0, pA1); PARTIAL(pA0, pA1, alA, true, rmx);
  ROT();
#define HALFSTEP(C0, C1, Q0, Q1, ALC, jj, BAND) do { \
    if (BAND) { WAITBAR(jj); if ((jj) + 2 < NT) { DMA_K((jj) + 2, s0); DMA_V((jj) + 2, VS((jj) + 2)); } } \
    else { asm volatile("s_waitcnt vmcnt(4)\n\ts_barrier" ::: "memory"); DMA_K((jj) + 2, s0); DMA_V((jj) + 2, VS((jj) + 2)); } \
    QKT(C0, C1, K_lds + s1); PROBE_XBAR; \
    if (BAND) { BIASMASK(C0, C1, jj); } \
    FINISH_PV(Q0, Q1, vrd + VS((jj) - 1), C0, C1, rmx); \
    PARTIAL(C0, C1, ALC, false, rmx); RESC(ALC); ROT(); } while (0)
  int j = 1;
  for (; j + 1 < NT - 4; j += 2) { HALFSTEP(pB0, pB1, pA0, pA1, alB, j, false); HALFSTEP(pA0, pA1, pB0, pB1, alA, j + 1, false); }
  for (; j + 1 < NT; j += 2) { HALFSTEP(pB0, pB1, pA0, pA1, alB, j, true); HALFSTEP(pA0, pA1, pB0, pB1, alA, j + 1, true); }
#undef HALFSTEP
  WAITBAR(NT - 1);
  QKT(pB0, pB1, K_lds + s1); BIASMASK(pB0, pB1, NT - 1);
  FINISH_PV(pA0, pA1, vrd + VS(NT - 2), pB0, pB1, rmx); PARTIAL(pB0, pB1, alB, false, rmx); RESC(alB);
  FINISH_PV(pB0, pB1, vrd + VS(NT - 1), pB0, pB1, rmx);
#undef DMA_K
#undef DMA_V
#undef KSO
#undef VSO
#undef WAITBAR
#undef RESC
#undef BIASMASK
#undef ROT
#undef VS
#undef QKT
#undef PARTIAL
#undef FINISH_PV
#undef ONESMMA
#undef PK4_
  __builtin_amdgcn_s_setprio(0);
  float rli[16];
#pragma unroll
  for (int r = 0; r < 16; ++r) rli[r] = __builtin_amdgcn_rcpf(osum[r]);
  __syncthreads();
  LAS float* X = (LAS float*)lds + rb * 4096 + lane;
  if (g == 1) {
#pragma unroll
    for (int r = 0; r < 16; ++r)
#pragma unroll
      for (int d0 = 0; d0 < 4; ++d0) X[(r * 4 + d0) * 64] = o[d0][r] * rli[r];
  }
  __syncthreads();
  if (g == 0) {
    const float lam = ((const LAS float*)(lds + OFF_LAM))[0], osc = ((const LAS float*)(lds + OFF_LAM))[1];
    float ss[16];
#pragma unroll
    for (int r = 0; r < 16; ++r) { float s = 0.f;
#pragma unroll
      for (int d0 = 0; d0 < 4; ++d0) { const float od = o[d0][r] * rli[r] - lam * X[(r * 4 + d0) * 64]; o[d0][r] = od; s += od * od; }
      ss[r] = s; }
#pragma unroll
    for (int r = 0; r < 16; ++r) { float s = ss[r]; s += __shfl_xor(s, 1); s += __shfl_xor(s, 2); s += __shfl_xor(s, 4); s += __shfl_xor(s, 8); s += __shfl_xor(s, 16);
      ss[r] = osc / sqrtf(s * (1.f / 128.f) + RMS_EPS); }
    float gn[4];
#pragma unroll
    for (int d0 = 0; d0 < 4; ++d0) gn[d0] = gnorm[d0 * 32 + r32];
    bf16* Ow = Orow0 + (size_t)(rb * 32) * 1024 + r32;
#pragma unroll
    for (int r = 0; r < 16; ++r) { const int orow = crow(r, hi);
#pragma unroll
      for (int d0 = 0; d0 < 4; ++d0) Ow[(size_t)orow * 1024 + d0 * 32] = (bf16)f2bf(o[d0][r] * ss[r] * gn[d0]); }
  }
  __syncthreads();
}

__device__ __forceinline__ void attn_unit_sample(LAS unsigned char* lds, const float* Kg, const float* Vg, const float* Kl, const float* Vl, const bf16* Qrow0, bf16* Orow0,
                                                 int qpos0, int h, const float* gnorm) {
  using St = Stage<true>; constexpr int LDK = 512, NT = 65;
  const int tid = fresh_tid(), wid = __builtin_amdgcn_readfirstlane(tid >> 6), lane = tid & 63, r32 = lane & 31, hi = lane >> 5;
  const int g = wid & 1, rb = (wid >> 1) & 1; const bool live = wid < 4;
  LAS char* V_lds = (LAS char*)lds + OFF_V; LAS char* K_lds = (LAS char*)lds + OFF_K;
  LAS float* wsf = (LAS float*)(lds + OFF_WS) + wid * 64; LAS float* li_l = wsf; LAS float* al_l = wsf + 32;
  const LAS float* tab = (const LAS float*)(lds + OFF_TAB) + h * TAB_N;
  float l_reg = 0; f32x16 o[4] = {};
#define BARRIER1() asm volatile("s_waitcnt lgkmcnt(0)\n\ts_barrier" ::: "memory")
  if (!live) {
    const int lt = tid - 256, sr = lt >> 4, sc = (lt & 15) * 8;
    typename St::T A[8], B[8];
#define LLOAD(X, t) do { const float* kb_ = (t) < 64 ? Kg + (size_t)(t) * 64 * LDK : Kl; const float* vb_ = (t) < 64 ? Vg + (size_t)(t) * 64 * LDK : Vl; \
      _Pragma("unroll") for (int i_ = 0; i_ < 4; ++i_) { X[i_] = St::ld8(vb_ + (size_t)(sr + 16 * i_) * LDK + sc); X[4 + i_] = St::ld8(kb_ + (size_t)(sr + 16 * i_) * LDK + sc); } } while (0)
#define LWRITE(X, b) do { _Pragma("unroll") for (int i_ = 0; i_ < 4; ++i_) { *(LAS bf16x8*)(V_lds + (b) * SHM_V + v_st(sr + 16 * i_, sc)) = St::tobf(X[i_]); \
      *(LAS bf16x8*)(K_lds + (b) * SHM_K + KSWZ(sr + 16 * i_, sc * 2)) = St::tobf(X[4 + i_]); } } while (0)
    LLOAD(A, 0); LLOAD(B, 1);
    asm volatile("s_waitcnt vmcnt(16)" ::: "memory"); LWRITE(A, 0); BARRIER1();
    for (int t = 0; t < NT; t += 2) {
      if (t + 2 < NT) LLOAD(A, t + 2);
      if (t + 1 < NT) { if (t + 2 < NT) asm volatile("s_waitcnt vmcnt(16)" ::: "memory"); else asm volatile("s_waitcnt vmcnt(0)" ::: "memory"); LWRITE(B, 1); }
      BARRIER1();
      if (t + 1 >= NT) break;
      if (t + 3 < NT) LLOAD(B, t + 3);
      if (t + 2 < NT) { if (t + 3 < NT) asm volatile("s_waitcnt vmcnt(16)" ::: "memory"); else asm volatile("s_waitcnt vmcnt(0)" ::: "memory"); LWRITE(A, 0); }
      BARRIER1();
    }
#undef LLOAD
#undef LWRITE
  } else {
    float m_reg = -1e30f; bf16x8 qr[4];
    const bf16* Qw = Qrow0 + (size_t)(rb * 32 + r32) * 3328 + g * 64 + hi * 8;
#pragma unroll
    for (int d0 = 0; d0 < 4; ++d0) qr[d0] = *reinterpret_cast<const bf16x8*>(Qw + d0 * 16);
    const int qpos = qpos0 + rb * 32 + r32;
    const LAS char* vb0 = V_lds + v_rd_base(lane);
    BARRIER1();
    for (int j = 0; j < NT; ++j) { const int bsel = j & 1;
      f32x16 p0, p1; float mn, al; bf16x8 pa0, pa1, pa2, pa3;
      qkt<false>(p0, p1, K_lds + bsel * SHM_K, qr, nullptr, r32, hi, g);
      if (j >= NT - 3) { const int base_ = 64 * j - qpos + 255 + 4 * hi;
#pragma unroll
        for (int r = 0; r < 16; ++r) { const int i0_ = base_ + (r & 3) + 8 * (r >> 2); p0[r] += tab[i0_]; p1[r] += tab[i0_ + 32]; } }
      partialSM(p0, p1, m_reg, mn, al);
      if (__any(al < 1.f)) { if (hi == 0) al_l[r32] = al; asm volatile("s_waitcnt lgkmcnt(0)" ::: "memory");
#pragma unroll
        for (int d = 0; d < 4; ++d)
#pragma unroll
          for (int r = 0; r < 16; ++r) o[d][r] *= al_l[crow(r, hi)]; }
      finishSM(p0, p1, al, l_reg, pa0, pa1, pa2, pa3);
      pv_d0(o, vb0 + bsel * SHM_V, pa0, pa1, pa2, pa3);
      BARRIER1(); }
  }
#undef BARRIER1
  __syncthreads();
  if (hi == 0) li_l[r32] = l_reg;
  asm volatile("s_waitcnt lgkmcnt(0)" ::: "memory");
  float rli[16];
#pragma unroll
  for (int r = 0; r < 16; ++r) rli[r] = __builtin_amdgcn_rcpf(li_l[crow(r, hi)]);
  LAS float* X = (LAS float*)lds + rb * 4096 + lane;
  if (live && g == 1) {
#pragma unroll
    for (int r = 0; r < 16; ++r)
#pragma unroll
      for (int d0 = 0; d0 < 4; ++d0) X[(r * 4 + d0) * 64] = o[d0][r] * rli[r];
  }
  __syncthreads();
  if (live && g == 0) {
    const float lam = ((const LAS float*)(lds + OFF_LAM))[0], osc = ((const LAS float*)(lds + OFF_LAM))[1];
    float ss[16];
#pragma unroll
    for (int r = 0; r < 16; ++r) { float s = 0.f;
#pragma unroll
      for (int d0 = 0; d0 < 4; ++d0) { const float od = o[d0][r] * rli[r] - lam * X[(r * 4 + d0) * 64]; o[d0][r] = od; s += od * od; }
      ss[r] = s; }
#pragma unroll
    for (int r = 0; r < 16; ++r) { float s = ss[r]; s += __shfl_xor(s, 1); s += __shfl_xor(s, 2); s += __shfl_xor(s, 4); s += __shfl_xor(s, 8); s += __shfl_xor(s, 16);
      ss[r] = osc / sqrtf(s * (1.f / 128.f) + RMS_EPS); }
    float gn[4];
#pragma unroll
    for (int d0 = 0; d0 < 4; ++d0) gn[d0] = gnorm[d0 * 32 + r32];
    bf16* Ow = Orow0 + (size_t)(rb * 32) * 1024 + r32;
#pragma unroll
    for (int r = 0; r < 16; ++r) { const int orow = crow(r, hi);
#pragma unroll
      for (int d0 = 0; d0 < 4; ++d0) Ow[(size_t)orow * 1024 + d0 * 32] = (bf16)f2bf(o[d0][r] * ss[r] * gn[d0]); }
  }
  __syncthreads();
}
#undef KSWZ
#undef SBAR
}

namespace gla {
constexpr int P72 = 72;
constexpr int L_TOT = 0, L_DL = 2048, L_QT = 4096, L_KT = L_QT + 64 * P72 * 2, L_KDT = L_KT + 64 * P72 * 2, L_A = L_KDT + 64 * P72 * 2, L_VT = L_A + 64 * P72 * 2, L_END = L_VT + 128 * P72 * 2;
static_assert(L_END <= RING_BYTES, "gla LDS map");
__device__ __forceinline__ int crow(int r, int hi) { return (r & 3) + 8 * (r >> 2) + 4 * hi; }
__device__ __forceinline__ float logsig(float z) { return fminf(z, 0.f) - __logf(1.f + __expf(-fabsf(z))); }
__device__ __forceinline__ bf16x8 ldsfrag(const LAS unsigned char* img, int row, int k0) { return *(const LAS bf16x8*)(img + (row * P72 + k0) * 2); }

#define G1IN_DECL(p) float p##z[8]; unsigned p##qk[8]; bf16x8 p##v0, p##v1; float p##bal
#define G1IN_ARGS(p) p##z, p##qk, p##v0, p##v1, p##bal
__device__ __forceinline__ void g1_load(float (&z)[8], unsigned (&qk)[8], bf16x8& v0, bf16x8& v1, float& bal, int c, int h, const bf16* ACT, const float* LOGA, const float* balpha) {
    const int tid = fresh_tid(), lane = tid & 63, t0 = 8 * (tid >> 6), row0 = 64 * c;
    bal = balpha[h * 64 + lane];
#pragma unroll
    for (int i = 0; i < 8; ++i) z[i] = LOGA[(size_t)(row0 + t0 + i) * 256 + h * 64 + lane];
#pragma unroll
    for (int i = 0; i < 8; ++i) { const bf16* ap = ACT + (size_t)(row0 + t0 + i) * NIN + h * 64 + lane; qk[i] = (unsigned)ap[0] | ((unsigned)ap[256] << 16); }
    { const int s = tid >> 4, jc = (tid & 15) * 8; v0 = *(const bf16x8*)(ACT + (size_t)(row0 + s) * NIN + 768 + h * 128 + jc); v1 = *(const bf16x8*)(ACT + (size_t)(row0 + 32 + s) * NIN + 768 + h * 128 + jc); }
}
__device__ __forceinline__ void g1_unit(LAS unsigned char* lds, const float (&inz)[8], const unsigned (&inqk)[8], const bf16x8& inv0, const bf16x8& inv1, const float& inbal, int c, int h, int layer,
                                        bf16* UT, float* Dw, bf16* OI, bf16* QT, bf16* SCT, const float* state_in  , float* state_out  ) {
    const int tid = fresh_tid(), wid = __builtin_amdgcn_readfirstlane(tid >> 6), lane = tid & 63, r = lane & 31, hh = lane >> 5;
    const int row0 = 64 * c;
    LAS float* TOT = (LAS float*)(lds + L_TOT); LAS float* DL = (LAS float*)(lds + L_DL);
    LAS unsigned char* Qi = lds + L_QT; LAS unsigned char* Ki = lds + L_KT; LAS unsigned char* KDi = lds + L_KDT; LAS unsigned char* Ai = lds + L_A; LAS unsigned char* Vi = lds + L_VT;
    { const int d = lane, tg = wid, t0 = 8 * tg;
      const float bal = inbal;
      float cs[8]; float run = 0.f;
#pragma unroll
      for (int i = 0; i < 8; ++i) { const float z = inz[i] + bal; run += logsig(z) * 0.0625f; cs[i] = run; }
      float qv[8], kv[8];
#pragma unroll
      for (int i = 0; i < 8; ++i) { qv[i] = bf2f((unsigned short)(inqk[i] & 0xffffu)); kv[i] = bf2f((unsigned short)(inqk[i] >> 16)); }
      TOT[tg * 64 + d] = run;
#pragma unroll
      for (int k = 0; k < 2; ++k) { const int ci = tid + 512 * k, s = ci >> 4, jc = (ci & 15) * 8;
        const bf16x8 v = k ? inv1 : inv0;
#pragma unroll
        for (int e = 0; e < 8; ++e) *(LAS short*)(Vi + ((jc + e) * P72 + s) * 2) = v[e]; }
      __syncthreads();
      float off = 0.f, blast = 0.f;
#pragma unroll
      for (int g2 = 0; g2 < 8; ++g2) { const float tv = TOT[g2 * 64 + d]; blast += tv; if (g2 < tg) off += tv; }
      unsigned kd[4];
      float kdf[8];
#pragma unroll
      for (int i = 0; i < 8; ++i) { const float b = off + cs[i]; const float eb = __expf(b);
        const float qt = qv[i] * 0.125f * eb, kt = kv[i] * __expf(-b); kdf[i] = kv[i] * __expf(blast - b);
        const unsigned short qb = (unsigned short)f2bf(qt);
        *(LAS unsigned short*)(Qi + ((t0 + i) * P72 + d) * 2) = qb; *(LAS unsigned short*)(Ki + ((t0 + i) * P72 + d) * 2) = (unsigned short)f2bf(kt);
        QT[(size_t)(row0 + t0 + i) * 256 + h * 64 + d] = qb; }
#pragma unroll
      for (int i = 0; i < 4; ++i) kd[i] = pk2(kdf[2 * i], kdf[2 * i + 1]);
      *(LAS v4u*)(KDi + (d * P72 + t0) * 2) = (v4u){kd[0], kd[1], kd[2], kd[3]};
      if (tg == 0) { const float Dd = __expf(blast); DL[d] = Dd; Dw[(size_t)(c * 4 + h) * 64 + d] = Dd; }
    }
    __syncthreads();
    if (wid < 3) { const int sb = (wid == 2), tb = (wid >= 1); f32x16 acc = {};
#pragma unroll
      for (int kk = 0; kk < 4; ++kk) acc = __builtin_amdgcn_mfma_f32_32x32x16_bf16(ldsfrag(Ki, sb * 32 + r, kk * 16 + 8 * hh), ldsfrag(Qi, tb * 32 + r, kk * 16 + 8 * hh), acc, 0, 0, 0);
      const int t = tb * 32 + r;
#pragma unroll
      for (int q = 0; q < 4; ++q) { const int s0 = sb * 32 + 8 * q + 4 * hh; float v[4];
#pragma unroll
        for (int e = 0; e < 4; ++e) v[e] = (s0 + e <= t) ? acc[4 * q + e] : 0.f;
        *(LAS v2u*)(Ai + (t * P72 + s0) * 2) = (v2u){pk2(v[0], v[1]), pk2(v[2], v[3])}; }
    } else if (wid == 3) {
#pragma unroll
      for (int q = 0; q < 4; ++q) *(LAS v2u*)(Ai + (r * P72 + 32 + 8 * q + 4 * hh) * 2) = (v2u){0u, 0u};
    } else {
      const int jb = wid - 4, j = jb * 32 + r;
#pragma unroll
      for (int db = 0; db < 2; ++db) { f32x16 acc = {};
#pragma unroll
        for (int kk = 0; kk < 4; ++kk) acc = __builtin_amdgcn_mfma_f32_32x32x16_bf16(ldsfrag(KDi, db * 32 + r, kk * 16 + 8 * hh), ldsfrag(Vi, j, kk * 16 + 8 * hh), acc, 0, 0, 0);
        if (c < NPCH) {
#pragma unroll
          for (int q = 0; q < 4; ++q) { const int d0 = db * 32 + 8 * q + 4 * hh;
            *(v2u*)(UT + ((size_t)(c * 4 + h) * 128 + j) * 64 + d0) = (v2u){pk2(acc[4 * q], acc[4 * q + 1]), pk2(acc[4 * q + 2], acc[4 * q + 3])}; }
        } else { const int b = c - NPCH; const size_t sbase = (size_t)(b * 4 + h) * 8192;
#pragma unroll
          for (int q = 0; q < 4; ++q) { const int d0 = db * 32 + 8 * q + 4 * hh; float si[4];
#pragma unroll
            for (int e = 0; e < 4; ++e) { si[e] = state_in[sbase + (size_t)(d0 + e) * 128 + j]; state_out[sbase + (size_t)(d0 + e) * 128 + j] = DL[d0 + e] * si[e] + acc[4 * q + e]; }
            *(v2u*)(SCT + ((size_t)(c * 4 + h) * 128 + j) * 64 + d0) = (v2u){pk2(si[0], si[1]), pk2(si[2], si[3])}; }
        }
      }
    }
    __syncthreads();
    { const int jb = wid >> 1, tb = wid & 1; f32x16 acc = {};
#pragma unroll
      for (int kk = 0; kk < 4; ++kk) acc = __builtin_amdgcn_mfma_f32_32x32x16_bf16(ldsfrag(Vi, jb * 32 + r, kk * 16 + 8 * hh), ldsfrag(Ai, tb * 32 + r, kk * 16 + 8 * hh), acc, 0, 0, 0);
      bf16* op = OI + (size_t)(row0 + tb * 32 + r) * 512 + h * 128 + jb * 32 + 4 * hh;
#pragma unroll
      for (int q = 0; q < 4; ++q) *(v2u*)(op + 8 * q) = (v2u){pk2(acc[4 * q], acc[4 * q + 1]), pk2(acc[4 * q + 2], acc[4 * q + 3])}; }
    __syncthreads();
}

__device__ __forceinline__ void g2_group(LAS unsigned char* lds, int eg, const bf16* UT, const float* Dw, bf16* SCT, float* gout  ) {
    const int tid = fresh_tid(); const int el = tid & 127, seg = tid >> 7; const int e = eg * 128 + el; const int h = e >> 13, j = (e >> 6) & 127, d = e & 63;
    LAS float* PL = (LAS float*)lds;
    const size_t ustride = 4 * 128 * 64, dstride = 4 * 64;
    const bf16* up = UT + ((size_t)h * 128 + j) * 64 + d + (size_t)(64 * seg) * ustride; const float* dp = Dw + h * 64 + d + (size_t)(64 * seg) * dstride;
    float P = 1.f, L = 0.f;
#pragma unroll 32
    for (int cc = 0; cc < 64; ++cc) { const float Dv = dp[(size_t)cc * dstride], Uv = bf2f(up[(size_t)cc * ustride]); L = fmaf(Dv, L, Uv); P *= Dv; }
    PL[(seg * 128 + el) * 2] = P; PL[(seg * 128 + el) * 2 + 1] = L;
    __syncthreads();
    float S = 0.f;
    for (int s2 = 0; s2 < seg; ++s2) S = fmaf(PL[(s2 * 128 + el) * 2], S, PL[(s2 * 128 + el) * 2 + 1]);
    bf16* sp = SCT + ((size_t)h * 128 + j) * 64 + d + (size_t)(64 * seg) * ustride;
#pragma unroll 32
    for (int cc = 0; cc < 64; ++cc) { const float Dv = dp[(size_t)cc * dstride], Uv = bf2f(up[(size_t)cc * ustride]); sp[(size_t)cc * ustride] = (bf16)f2bf(S); S = fmaf(Dv, S, Uv); }
    if (seg == 3) gout[((size_t)h * 64 + d) * 128 + j] = S;
    __syncthreads();
}

__device__ __forceinline__ void g3_unit(LAS float* part, int c, int h, const bf16* ACT, const bf16* OI, const bf16* QT, const bf16* SCT, const float* gnorm  , bf16* MIX) {
    const int tid = fresh_tid(), wid = __builtin_amdgcn_readfirstlane(tid >> 6), lane = tid & 63, r = lane & 31, hh = lane >> 5;
    const int jb = wid >> 1, tb = wid & 1; const int row = 64 * c + tb * 32 + r;
    f32x16 acc = {};
    const bf16* ap = SCT + ((size_t)(c * 4 + h) * 128 + jb * 32 + r) * 64 + 8 * hh; const bf16* bp = QT + (size_t)row * 256 + h * 64 + 8 * hh;
#pragma unroll
    for (int kk = 0; kk < 4; ++kk) acc = __builtin_amdgcn_mfma_f32_32x32x16_bf16(*(const bf16x8*)(ap + kk * 16), *(const bf16x8*)(bp + kk * 16), acc, 0, 0, 0);
    const int j0 = jb * 32 + 4 * hh;
    const bf16* oip = OI + (size_t)row * 512 + h * 128 + j0;
    float ss = 0.f;
#pragma unroll
    for (int q = 0; q < 4; ++q) { const v2u ow = *(const v2u*)(oip + 8 * q);
      const float oi[4] = {__builtin_bit_cast(float, ow.x << 16), __builtin_bit_cast(float, ow.x & 0xffff0000u), __builtin_bit_cast(float, ow.y << 16), __builtin_bit_cast(float, ow.y & 0xffff0000u)};
#pragma unroll
      for (int e = 0; e < 4; ++e) { acc[4 * q + e] += oi[e]; ss += acc[4 * q + e] * acc[4 * q + e]; } }
    ss += __shfl_xor(ss, 32);
    if (hh == 0) part[wid * 32 + r] = ss;
    __syncthreads();
    const float tot = part[tb * 32 + r] + part[(tb + 2) * 32 + r] + part[(tb + 4) * 32 + r] + part[(tb + 6) * 32 + r];
    const float rstd = 1.f / sqrtf(tot * (1.f / 128.f) + RMS_EPS);
    const bf16* gp = ACT + (size_t)row * NIN + 1280 + h * 128 + j0; bf16* mp = MIX + (size_t)row * 1024 + h * 128 + j0;
#pragma unroll
    for (int q = 0; q < 4; ++q) { const v2u gg = *(const v2u*)(gp + 8 * q); const f32x4 gn = *(const f32x4*)(gnorm + j0 + 8 * q);
      float gv[4] = {bf2f((unsigned short)(gg.x & 0xffffu)), bf2f((unsigned short)(gg.x >> 16)), bf2f((unsigned short)(gg.y & 0xffffu)), bf2f((unsigned short)(gg.y >> 16))}; float y[4];
#pragma unroll
      for (int e = 0; e < 4; ++e) { const float sg = gv[e] / (1.f + __expf(-gv[e])); y[e] = acc[4 * q + e] * rstd * gn[e] * sg; }
      *(v2u*)(mp + 8 * q) = (v2u){pk2(y[0], y[1]), pk2(y[2], y[3])}; }
    __syncthreads();
}
}

namespace mini {
__device__ __forceinline__ int crow(int r, int hi) { return (r & 3) + 8 * (r >> 2) + 4 * hi; }
template <int K>
__device__ __forceinline__ void piece(LAS unsigned char* lds, int p, const bf16* A  , const bf16* Bt, bf16* xb  , float* rowsq  ) {
    const int tid = fresh_tid(), wid = __builtin_amdgcn_readfirstlane(tid >> 6), lane = tid & 63, r = lane & 31, hh = lane >> 5;
    const int r0 = (p >> 4) * 64, c0 = (p & 15) * 64;
    constexpr int KW = K / 8, NS = KW / 16;
    static_assert(KW % 16 == 0, "K / 8 must be a multiple of 16");
    const bf16* ap = A + (size_t)(r0 + r) * K + wid * KW + 8 * hh; const bf16* bp = Bt + (size_t)(c0 + r) * K + wid * KW + 8 * hh;
    f32x16 acc[2][2] = {};
    constexpr int U = (NS % 11 == 0) ? 11 : 8;
    static_assert(NS % U == 0, "batching");
    for (int kb = 0; kb < NS; kb += U) {
        bf16x8 a0[U], a1[U], b0[U], b1[U];
#pragma unroll
        for (int u = 0; u < U; ++u) { a0[u] = *(const bf16x8*)(ap + (kb + u) * 16); a1[u] = *(const bf16x8*)(ap + (size_t)32 * K + (kb + u) * 16);
                                      b0[u] = *(const bf16x8*)(bp + (kb + u) * 16); b1[u] = *(const bf16x8*)(bp + (size_t)32 * K + (kb + u) * 16); }
#pragma unroll
        for (int u = 0; u < U; ++u) {
            acc[0][0] = __builtin_amdgcn_mfma_f32_32x32x16_bf16(a0[u], b0[u], acc[0][0], 0, 0, 0); acc[0][1] = __builtin_amdgcn_mfma_f32_32x32x16_bf16(a0[u], b1[u], acc[0][1], 0, 0, 0);
            acc[1][0] = __builtin_amdgcn_mfma_f32_32x32x16_bf16(a1[u], b0[u], acc[1][0], 0, 0, 0); acc[1][1] = __builtin_amdgcn_mfma_f32_32x32x16_bf16(a1[u], b1[u], acc[1][1], 0, 0, 0); }
    }
    LAS float* P = (LAS float*)lds;
#pragma unroll
    for (int i = 0; i < 2; ++i)
#pragma unroll
        for (int j = 0; j < 2; ++j)
#pragma unroll
            for (int q = 0; q < 16; ++q) P[(((wid * 2 + i) * 2 + j) * 16 + q) * 64 + lane] = acc[i][j][q];
    __syncthreads();
    float vv[8];
#pragma unroll
    for (int q = 0; q < 8; ++q) { const int e = tid + 512 * q;
        float s = 0.f;
#pragma unroll
        for (int w = 0; w < 8; ++w) s += P[w * 4096 + e];
        const int ln = e & 63, reg = (e >> 6) & 15, j = (e >> 10) & 1, i = e >> 11;
        const int row = r0 + 32 * i + crow(reg, ln >> 5), col = c0 + 32 * j + (ln & 31);
        const float v = bf2f(xb[(size_t)row * 1024 + col]) + s;
        xb[(size_t)row * 1024 + col] = (bf16)f2bf(v); vv[q] = v; }
#pragma unroll
    for (int q = 0; q < 8; ++q) { if (q & 2) continue;
        float sq = vv[q] * vv[q] + vv[q + 2] * vv[q + 2]; sq += __shfl_xor(sq, 1); sq += __shfl_xor(sq, 2); sq += __shfl_xor(sq, 4); sq += __shfl_xor(sq, 8); sq += __shfl_xor(sq, 16);
        const int e = tid + 512 * q, ln = e & 63, reg = (e >> 6) & 15, i = e >> 11; const int row = r0 + 32 * i + crow(reg, ln >> 5);
        if ((ln & 31) == 0) rowsq[(size_t)row * 16 + (p & 15)] = sq; }
    __syncthreads();
}
}

__global__ void __launch_bounds__(NWAVES * 64, 2) hymba_fwd(Args args) {
    extern __shared__ __attribute__((aligned(16))) unsigned char lds[];
    Frame F;
    F.lds = (LAS unsigned char*)lds;
    for (int u = threadIdx.x; u < (LDS_BYTES - LDSCTL_OFF) / 4; u += NWAVES * 64) ((LAS unsigned*)(F.lds + LDSCTL_OFF))[u] = 0u;
    __syncthreads();
    if (threadIdx.x == 0) { LAS unsigned long long* t = (LAS unsigned long long*)(F.lds + PTAB_OFF);
#pragma unroll
        for (int i = 0; i < 18; ++i) t[i] = (unsigned long long)args.in[i];
        t[18] = (unsigned long long)args.out; t[19] = (unsigned long long)args.ws; }
    __syncthreads();
#define CTL_ ((gu32*)(wsp(F) + WS_CTL))
    (void)xcd_barrier_post((unsigned*)(CTL_ + CW_BAR), (volatile LAS unsigned*)(F.lds + MISC_OFF) + 8);
#ifdef PROBE_DUP_BAR
#define GRID_BAR() do { XcdBarrier b_; b_.bar = (unsigned*)(CTL_ + CW_BAR); b_.x = xb_xcc_id(); b_.st = (volatile LAS unsigned*)(F.lds + MISC_OFF) + 8; xcd_barrier(b_); xcd_barrier(b_); } while (0)
#else
#define GRID_BAR() do { XcdBarrier b_; b_.bar = (unsigned*)(CTL_ + CW_BAR); b_.x = xb_xcc_id(); b_.st = (volatile LAS unsigned*)(F.lds + MISC_OFF) + 8; xcd_barrier(b_); } while (0)
#endif

#define WSB(off) (wsp(F) + (off))
#define X_ ((float*)WSB(WS_X))
#define XN_ ((bf16*)WSB(WS_XN))
#define ACT_ ((bf16*)WSB(WS_ACT))
#define MIX_ ((bf16*)WSB(WS_MIX))
#define HB_ ((bf16*)WSB(WS_H))
#define LOGA_ ((float*)WSB(WS_LOGA))

#ifndef SKIP_P0
    p0_prologue(F);
#endif
    rows_to_bf16_sq(F, inp(F, 0), inp(F, 1), XN_, (float*)WSB(WS_RSQ));
    GRID_BAR();

    for (int l = 0; l < DEPTH; ++l) {
#define WL_ (WSB(WS_W) + (size_t)l * W_LAYER)
#define SRCP_ (l == 0 ? inp(F, 0) : (const float*)X_)
#define SRCS_ (l == 0 ? inp(F, 1) : (const float*)X_ + (size_t)SEQ * DM)
#ifndef SKIP_IN
        { pg8::Gemm g{XN_, (const bf16*)(WL_ + WO_IN), M, NIN, DM}; pg8::StaticOrder S; S.init(M, NIN, grid_n(), (int)blockIdx.x);
          rstd_prepass(F, S, (const float*)WSB(WS_RSQ) + (size_t)(2 * l) * M * 16);
          pg8::EpiIn E{wsp(F), outp(F), l, WS_ACT, WS_LOGA, (const LAS float*)(F.lds + RSTD_OFF)};
          pg8::gemm_phase<pg8::EpiIn, pg8::StaticOrder, true, true>(F.lds + RING_OFF, g, S, E);
#if defined(PROBE_DUP_GEMM) || defined(PROBE_DUP_IN)
          __syncthreads(); pg8::gemm_phase<pg8::EpiIn, pg8::StaticOrder, true, true>(F.lds + RING_OFF, g, S, E);
#endif
        }
#endif
        GRID_BAR();
#ifndef SKIP_G1
        { G1IN_DECL(gA); G1IN_DECL(gB); const int G_ = grid_n(); int u = blockIdx.x; constexpr int NU = NCHUNK * 4;
#define G1_LOAD(gx, uu) gla::g1_load(G1IN_ARGS(gx), (uu) >> 2, (uu) & 3, ACT_, LOGA_, inp(F, 7) + (size_t)l * 256)
#define G1_RUN(gx, uu) gla::g1_unit(F.lds + RING_OFF, G1IN_ARGS(gx), (uu) >> 2, (uu) & 3, l, (bf16*)WSB(WS_U), (float*)WSB(WS_D), (bf16*)WSB(WS_OI), (bf16*)WSB(WS_QT), (bf16*)WSB(WS_SC), \
                         inp(F, 4) + (size_t)l * DECB * 4 * 8192, outp(F) + OG_S + (size_t)l * DECB * 4 * 8192)
#define CLAMPU(x) ((x) < NU ? (x) : NU - 1)
          G1_LOAD(gA, CLAMPU(u));
          for (; u < NU; u += 2 * G_) {
            G1_LOAD(gB, CLAMPU(u + G_));
            G1_RUN(gA, u);
            if (u + G_ < NU) { G1_LOAD(gA, CLAMPU(u + 2 * G_)); G1_RUN(gB, u + G_); } }
#undef CLAMPU
#undef G1_LOAD
#undef G1_RUN
        }
#endif
        GRID_BAR();
#ifdef PROBE_DUP_GLA
        for (int rep_ = 0; rep_ < 2; ++rep_)
#endif
        for (int eg = blockIdx.x; eg < 256; eg += grid_n())
#ifndef SKIP_G2
            gla::g2_group(F.lds + RING_OFF, eg, (const bf16*)WSB(WS_U), (const float*)WSB(WS_D), (bf16*)WSB(WS_SC), outp(F) + OG_P + (size_t)l * 4 * 8192);
#endif
            ;
        GRID_BAR();
        att::attn_setup(F.lds + RING_OFF, inp(F, 17), inp(F, 9) + (size_t)l * 256, l);
#ifdef PROBE_DUP_ATT
        for (int rep = 0; rep < 2; ++rep)
#else
        const int rep = 0;
#endif
        for (int it = 0;; ++it) {
            if (it == 0) __syncthreads();
            volatile LAS int* slot = (volatile LAS int*)(F.lds + MISC_OFF) + 16 + (it & 1);
            if (threadIdx.x == 0) *slot = (int)__hip_atomic_fetch_add((unsigned*)(CTL_ + CW_QUEUE + 64 * (l + 4 * rep)), 1u, __ATOMIC_RELAXED, __HIP_MEMORY_SCOPE_AGENT);
            __syncthreads();
            const int idx = __builtin_amdgcn_readfirstlane(*slot);
            if (idx >= 64 + 512 + NCHUNK * 4) break;
            if (idx < 64) { const int b = idx >> 2, h = idx & 3;
                const float* kc = inp(F, 2) + ((size_t)(l * DECB + b) * PAST) * 512 + h * 128; const float* vc = inp(F, 3) + ((size_t)(l * DECB + b) * PAST) * 512 + h * 128;
                const float* kn = outp(F) + OK_S + ((size_t)(l * DECB + b) * 64) * 512 + h * 128; const float* vn = outp(F) + OV_S + ((size_t)(l * DECB + b) * 64) * 512 + h * 128;
#ifndef SKIP_AS
                att::attn_unit_sample(F.lds + RING_OFF, kc, vc, kn, vn, ACT_ + (size_t)(SEQ + 64 * b) * NIN + 1792 + h * 128, MIX_ + (size_t)(SEQ + 64 * b) * DM + 512 + h * 128,
                                      PAST, h, inp(F, 10) + (size_t)l * 128);
#endif
            } else if (idx < 576) { const int i = idx - 64, u = 127 - (i >> 2), h = i & 3;
#ifndef SKIP_AP
                att::attn_unit_prompt(F.lds + RING_OFF, ACT_ + 2304 + h * 128, ACT_ + 2816 + h * 128, ACT_ + (size_t)(128 * u) * NIN + 1792 + h * 128,
                                      MIX_ + (size_t)(128 * u) * DM + 512 + h * 128, 2 * u + 2, 128 * u, h, inp(F, 10) + (size_t)l * 128);
#ifdef PROBE_DUP_PROMPT
                att::attn_unit_prompt(F.lds + RING_OFF, ACT_ + 2304 + h * 128, ACT_ + 2816 + h * 128, ACT_ + (size_t)(128 * u) * NIN + 1792 + h * 128,
                                      MIX_ + (size_t)(128 * u) * DM + 512 + h * 128, 2 * u + 2, 128 * u, h, inp(F, 10) + (size_t)l * 128);
#endif
#endif
            } else { const int i = idx - 576;
#ifndef SKIP_G3
                gla::g3_unit((LAS float*)(F.lds + RING_OFF + att::OFF_G3), i >> 2, i & 3, ACT_, (const bf16*)WSB(WS_OI), (const bf16*)WSB(WS_QT), (const bf16*)WSB(WS_SC), inp(F, 8) + (size_t)l * 128, MIX_);
#endif
            }
        }
        GRID_BAR();
#ifndef SKIP_OUT
        { pg8::Gemm g{MIX_, (const bf16*)(WL_ + WO_OUT), SEQ, DM, DM}; pg8::StaticOrder S; S.init(SEQ, DM, grid_n(), (int)blockIdx.x);
          pg8::EpiRes E{XN_, (float*)WSB(WS_RSQ) + (size_t)(1 + 2 * l) * M * 16};
          pg8::gemm_phase<pg8::EpiRes, pg8::StaticOrder, true, true>(F.lds + RING_OFF, g, S, E);
          __syncthreads();
          for (int p = blockIdx.x; p < 256; p += grid_n())
              mini::piece<DM>(F.lds + RING_OFF, p, MIX_ + (size_t)SEQ * DM, (const bf16*)(WL_ + WO_OUT), XN_ + (size_t)SEQ * DM, (float*)WSB(WS_RSQ) + ((size_t)(1 + 2 * l) * M + SEQ) * 16);
        }
#endif
        GRID_BAR();
#ifndef SKIP_F1
        { pg8::Gemm g{XN_, (const bf16*)(WL_ + WO_F1), M, NF1, DM}; pg8::StaticOrder S; S.init(M, NF1, grid_n(), (int)blockIdx.x);
          rstd_prepass(F, S, (const float*)WSB(WS_RSQ) + (size_t)(1 + 2 * l) * M * 16);
          pg8::EpiSwi E{HB_, DFF, (const LAS float*)(F.lds + RSTD_OFF)};
          pg8::gemm_phase<pg8::EpiSwi, pg8::StaticOrder, true, true>(F.lds + RING_OFF, g, S, E);
#if defined(PROBE_DUP_GEMM) || defined(PROBE_DUP_F1)
          __syncthreads(); pg8::gemm_phase<pg8::EpiSwi, pg8::StaticOrder, true, true>(F.lds + RING_OFF, g, S, E);
#endif
        }
#endif
        GRID_BAR();
#ifndef SKIP_F2
        { pg8::Gemm g{HB_, (const bf16*)(WL_ + WO_F2), SEQ, DM, DFF}; pg8::StaticOrder S; S.init(SEQ, DM, grid_n(), (int)blockIdx.x);
          pg8::EpiRes E{XN_, (float*)WSB(WS_RSQ) + (size_t)(2 + 2 * l) * M * 16};
          pg8::gemm_phase<pg8::EpiRes, pg8::StaticOrder, true, true>(F.lds + RING_OFF, g, S, E);
          __syncthreads();
          for (int p = blockIdx.x; p < 256; p += grid_n())
              mini::piece<DFF>(F.lds + RING_OFF, p, HB_ + (size_t)SEQ * DFF, (const bf16*)(WL_ + WO_F2), XN_ + (size_t)SEQ * DM, (float*)WSB(WS_RSQ) + ((size_t)(2 + 2 * l) * M + SEQ) * 16);
        }
#endif
        GRID_BAR();
    }
    norm_rows_f32(F, XN_, inp(F, 16), outp(F) + OY);
}

extern "C" void kernel_launch(void* const* d_in, const int* in_sizes, int n_in, void* d_out, int out_size, void* d_ws, size_t ws_size, hipStream_t stream) {
    static int grid = 0;
    if (grid == 0) {
        if (n_in != 18 || (size_t)out_size != OUT_TOTAL || ws_size < WS_END) { fprintf(stderr, "kernel_launch: shape mismatch n_in %d out %d ws %zu\n", n_in, out_size, ws_size); grid = -1; return; }
        int dev = 0, cus = 0, per_cu = 0;
        if (hipGetDevice(&dev) != hipSuccess || hipDeviceGetAttribute(&cus, hipDeviceAttributeMultiprocessorCount, dev) != hipSuccess) { grid = -1; return; }
        if (hipFuncSetAttribute((const void*)hymba_fwd, hipFuncAttributeMaxDynamicSharedMemorySize, LDS_BYTES) != hipSuccess) { fprintf(stderr, "kernel_launch: hipFuncSetAttribute failed\n"); grid = -1; return; }
        if (hipOccupancyMaxActiveBlocksPerMultiprocessor(&per_cu, (const void*)hymba_fwd, NWAVES * 64, LDS_BYTES) != hipSuccess || per_cu < 1)
            fprintf(stderr, "kernel_launch: occupancy query reports %d\n", per_cu);
        (void)hipGetLastError();
        grid = cus;
    }
    if (grid < 0) return;
    if (hipMemsetAsync((char*)d_ws + WS_CTL, 0, CTL_ZERO_BYTES, stream) != hipSuccess) return;
    Args a{};
    for (int i = 0; i < 18; ++i) a.in[i] = (const float*)d_in[i];
    a.out = (float*)d_out; a.ws = (unsigned char*)d_ws;
    hipLaunchKernelGGL(hymba_fwd, dim3(grid), dim3(NWAVES * 64), LDS_BYTES, stream, a);
    const hipError_t le = hipPeekAtLastError();
    if (le != hipSuccess) fprintf(stderr, "kernel_launch: launch failed: %s\n", hipGetErrorName(le));
}
```

```cpp
#define EPI_WT
#include <hip/hip_runtime.h>
#include <cstdio>
#include <cstdint>
namespace pg8 {
#define PG8_LAS __attribute__((address_space(3)))
typedef unsigned short bf16_t;
typedef short bf16x8 __attribute__((ext_vector_type(8)));
typedef float f32x4 __attribute__((ext_vector_type(4)));
typedef unsigned u32x4 __attribute__((ext_vector_type(4)));
constexpr int BM = 256, BK = 64, HALF = 128, HTB = HALF * BK * 2  , STAGE_BYTES = 8 * HTB, NXCD = 8, WGM = 8;

__host__ __device__ __forceinline__ int lds_byte(int r, int c) { const int st = (r >> 4) * 2 + (c >> 5), rr = r & 15, cc = c & 31, ob = rr * 64 + cc * 2; return st * 1024 + (ob ^ (((ob >> 9) & 1) << 5)); }
__host__ __device__ __forceinline__ void stage_rc(int b, int& R, int& C) { const int st = b / 1024, sb = b % 1024, swz = sb ^ (((sb >> 9) & 1) << 5); R = (st >> 1) * 16 + swz / 64; C = (st & 1) * 32 + (swz % 64) / 2; }
__host__ __device__ __forceinline__ int perm32(int rho) { const int n = rho >> 4, i = rho & 15; return 8 * (i >> 2) + 4 * n + (i & 3); }

struct Unit { int pm, pn; };
struct Gemm { const bf16_t* A; const bf16_t* Bt; int M, N, K; };

struct StaticOrder {
    int nM, nN, nwg, G, c;
    __host__ __device__ void init(int M, int N, int G_, int c_) { nM = M / BM; nN = N / BM; nwg = nM * nN; G = G_; c = c_; }
    __host__ __device__ bool next(int i, Unit& u) const {
        const long L = (long)i * G + c; if (L >= nwg) return false;
        int wgid = (int)L; { const int q = nwg / NXCD, r = nwg % NXCD, xcd = wgid % NXCD, off = wgid / NXCD; wgid = (xcd < r ? xcd * (q + 1) : r * (q + 1) + (xcd - r) * q) + off; }
        const int nig = WGM * nN, gid = wgid / nig, fm = gid * WGM, gsz = (nM - fm) < WGM ? (nM - fm) : WGM;
        u.pm = fm + ((wgid % nig) % gsz); u.pn = (wgid % nig) / gsz; return true;
    }
    __device__ __forceinline__ void a_ready(const Unit&) const {}
    __device__ __forceinline__ void done(const Unit&) const {}
};

__device__ __forceinline__ unsigned cvt_pk_bf16(float lo, float hi) { unsigned r; asm volatile("v_cvt_pk_bf16_f32 %0, %1, %2" : "=v"(r) : "v"(lo), "v"(hi)); return r; }
#ifdef EPI_WT
__device__ __forceinline__ void st16(void* p, u32x4 w) { asm volatile("global_store_dwordx4 %0, %1, off sc1\n\ts_nop 1" :: "v"(p), "v"(w) : "memory"); }
#else
__device__ __forceinline__ void st16(void* p, u32x4 w) { *(u32x4*)p = w; }
#endif
__device__ __forceinline__ float silu_f(float v) { return v * __builtin_amdgcn_rcpf(1.f + __expf(-v)); }
__device__ __forceinline__ float logsig_f(float z) { return fminf(z, 0.f) - log1pf(__expf(-fabsf(z))); }

__device__ __forceinline__ float row_rstd(const float* rsq, int row) {
    const f32x4* p = (const f32x4*)(rsq + (size_t)row * 16); const f32x4 a = p[0], b = p[1], c = p[2], d = p[3];
    const float s = ((a[0] + a[1]) + (a[2] + a[3])) + ((b[0] + b[1]) + (b[2] + b[3])) + (((c[0] + c[1]) + (c[2] + c[3])) + ((d[0] + d[1]) + (d[2] + d[3])));
    return __builtin_amdgcn_rsqf(s * (1.f / 1024.f) + 1e-6f);
}
#ifndef EPI_REP
#define EPI_REP 1
#endif
constexpr int IN_N = 3328;
constexpr int PROMPT_ROWS = 16384;

struct EpiIn {
    static constexpr bool PERM = true, AFTER_DRAIN = false;
    unsigned char* ws; float* out; int layer;
    size_t act_off, loga_off;
    const PG8_LAS float* rstd;
    __device__ __forceinline__ void operator()(const f32x4 (&acc)[2][2][4][2], const Unit& u, int wr, int wc, int fr, int fq, int ui) const {
        const int row0 = u.pm * BM + wr * 64 + fr; const int pn = u.pn; const int cl0 = wc * 32 + 8 * fq;
        float* fo = nullptr; int fld = 512;
        if (pn == 2) { fo = (float*)(ws + loga_off) + (size_t)row0 * 256 + cl0; fld = 256; }
        else if (pn >= 9) { const bool samp = (u.pm >= PROMPT_ROWS / BM); const bool isv = (pn >= 11);
            const size_t b = samp ? (isv ? (size_t)87162880 : (size_t)85065728) + (size_t)layer * 524288 : (isv ? (size_t)51380224 : (size_t)17825792) + (size_t)layer * 8388608;
            fo = out + b + (size_t)(row0 - (samp ? PROMPT_ROWS : 0)) * 512 + ((pn - 9) & 1) * 256 + cl0; }
        bf16_t* ab = (bf16_t*)(ws + act_off) + (size_t)row0 * IN_N + pn * BM + cl0;
        for (int rep_ = 0; rep_ < EPI_REP; ++rep_) { asm volatile("" ::: "memory");
        const float qsc = (pn == 7 || pn == 8) ? 0.18033688011112042f : 1.f;
#pragma unroll
        for (int ai = 0; ai < 2; ++ai)
#pragma unroll
            for (int m = 0; m < 4; ++m) { const size_t ro = (size_t)(ai * HALF + m * 16);
                const float rs = rstd[ui * BM + wr * 64 + fr + ai * HALF + m * 16] * qsc;
#pragma unroll
                for (int bj = 0; bj < 2; ++bj) { f32x4 v0 = acc[ai][bj][m][0] * rs, v1 = acc[ai][bj][m][1] * rs;
                    u32x4 w; w.x = cvt_pk_bf16(v0[0], v0[1]); w.y = cvt_pk_bf16(v0[2], v0[3]); w.z = cvt_pk_bf16(v1[0], v1[1]); w.w = cvt_pk_bf16(v1[2], v1[3]);
                    if (pn != 2) st16(ab + ro * IN_N + bj * HALF, w);
                    if (fo) { __builtin_nontemporal_store(v0, (f32x4*)(fo + ro * fld + bj * HALF)); __builtin_nontemporal_store(v1, (f32x4*)(fo + ro * fld + bj * HALF + 4)); } } }
        }
    }
};

struct EpiSwi {
    static constexpr bool PERM = true, AFTER_DRAIN = false;
    bf16_t* H; int ldh; const PG8_LAS float* rstd;
    __device__ __forceinline__ void operator()(const f32x4 (&acc)[2][2][4][2], const Unit& u, int wr, int wc, int fr, int fq, int ui) const {
        const int row0 = u.pm * BM + wr * 64 + fr; bf16_t* hb = H + (size_t)row0 * ldh + u.pn * HALF + wc * 32 + 8 * fq;
        for (int rep_ = 0; rep_ < EPI_REP; ++rep_) { asm volatile("" ::: "memory");
#pragma unroll
        for (int ai = 0; ai < 2; ++ai)
#pragma unroll
            for (int m = 0; m < 4; ++m) { const float rs = rstd[ui * BM + wr * 64 + fr + ai * HALF + m * 16];
                const float c2 = -1.4426950408889634f * rs, rs2 = rs * rs;
                const f32x4 a0 = acc[ai][0][m][0], a1 = acc[ai][0][m][1], u0 = acc[ai][1][m][0], u1 = acc[ai][1][m][1];
                f32x4 r0, r1;
#pragma unroll
                for (int e = 0; e < 4; ++e) { r0[e] = __builtin_amdgcn_rcpf(1.f + __builtin_amdgcn_exp2f(a0[e] * c2)) * rs2; r1[e] = __builtin_amdgcn_rcpf(1.f + __builtin_amdgcn_exp2f(a1[e] * c2)) * rs2; }
                const f32x4 o0 = (a0 * u0) * r0, o1 = (a1 * u1) * r1;
                u32x4 w; w.x = cvt_pk_bf16(o0[0], o0[1]); w.y = cvt_pk_bf16(o0[2], o0[3]); w.z = cvt_pk_bf16(o1[0], o1[1]); w.w = cvt_pk_bf16(o1[2], o1[3]);
                st16(hb + (size_t)(ai * HALF + m * 16) * ldh, w); }
        }
    }
};

struct EpiRes {
    static constexpr bool PERM = true, AFTER_DRAIN = false;
    bf16_t* xb; float* rowsq;
    __device__ __forceinline__ void operator()(const f32x4 (&acc)[2][2][4][2], const Unit& u, int wr, int wc, int fr, int fq, int ui) const {
        const int row0 = u.pm * BM + wr * 64 + fr; const int c0 = u.pn * BM + wc * 32 + 8 * fq;
        bf16_t* xbb = xb + (size_t)row0 * 1024 + c0;
        u32x4 sres[2][4][2];
#pragma unroll
        for (int ai = 0; ai < 2; ++ai)
#pragma unroll
            for (int m = 0; m < 4; ++m)
#pragma unroll
                for (int bj = 0; bj < 2; ++bj) sres[ai][m][bj] = *(const u32x4*)(xbb + (size_t)(ai * HALF + m * 16) * 1024 + bj * HALF);
#pragma unroll
        for (int ai = 0; ai < 2; ++ai)
#pragma unroll
            for (int m = 0; m < 4; ++m) { const size_t ro = (size_t)(ai * HALF + m * 16) * 1024; float sq = 0.f;
#pragma unroll
                for (int bj = 0; bj < 2; ++bj) { const u32x4 s = sres[ai][m][bj];
                    f32x4 v0, v1;
                    v0[0] = __builtin_bit_cast(float, s.x << 16) + acc[ai][bj][m][0][0]; v0[1] = __builtin_bit_cast(float, s.x & 0xffff0000u) + acc[ai][bj][m][0][1];
                    v0[2] = __builtin_bit_cast(float, s.y << 16) + acc[ai][bj][m][0][2]; v0[3] = __builtin_bit_cast(float, s.y & 0xffff0000u) + acc[ai][bj][m][0][3];
                    v1[0] = __builtin_bit_cast(float, s.z << 16) + acc[ai][bj][m][1][0]; v1[1] = __builtin_bit_cast(float, s.z & 0xffff0000u) + acc[ai][bj][m][1][1];
                    v1[2] = __builtin_bit_cast(float, s.w << 16) + acc[ai][bj][m][1][2]; v1[3] = __builtin_bit_cast(float, s.w & 0xffff0000u) + acc[ai][bj][m][1][3];
                    sq += (v0[0] * v0[0] + v0[1] * v0[1]) + (v0[2] * v0[2] + v0[3] * v0[3]) + (v1[0] * v1[0] + v1[1] * v1[1]) + (v1[2] * v1[2] + v1[3] * v1[3]);
                    u32x4 w; w.x = cvt_pk_bf16(v0[0], v0[1]); w.y = cvt_pk_bf16(v0[2], v0[3]); w.z = cvt_pk_bf16(v1[0], v1[1]); w.w = cvt_pk_bf16(v1[2], v1[3]);
                    st16(xbb + ro + bj * HALF, w); }
                sq += __shfl_xor(sq, 16); sq += __shfl_xor(sq, 32);
                if (fq == 0) rowsq[(size_t)(row0 + ai * HALF + m * 16) * 16 + u.pn * 4 + wc] = sq; }
    }
};
template <class Epi, class Sched, bool ALIGN_EPI = false, bool SP2 = false>
__device__ __forceinline__ void gemm_phase(PG8_LAS unsigned char* lds, const Gemm g, const Sched& S, const Epi& E) {
    int tid_ = threadIdx.x; asm volatile("" : "+v"(tid_));
    const int tid = tid_, wid = __builtin_amdgcn_readfirstlane(tid >> 6), lane = tid & 63, wr = wid >> 2, wc = wid & 3, fr = lane & 15, fq = lane >> 4;
    const int K = g.K, nt = K / BK;
    unsigned voffA[2], voffB[2];
#pragma unroll
    for (int i = 0; i < 2; ++i) { int R, C; stage_rc(tid * 16 + i * 8192, R, C); const int Rb = Epi::PERM ? ((R & ~31) + perm32(R & 31)) : R;
        voffA[i] = (unsigned)(R * K + C) * 2u; voffB[i] = (unsigned)(Rb * K + C) * 2u; }
    const size_t kstep = (size_t)(BK * 2);
    const size_t hstep = (size_t)HALF * K * 2;
    const size_t tstep = 2 * hstep;
    const unsigned ldsw = (unsigned)wid * 1024u;
    const int aoff = lds_byte(wr * 64 + fr, fq * 8), boff = lds_byte(wc * 32 + fr, fq * 8);
#define PG8_SA(b, h) (((b) * 2 + (h)) * HTB)
#define PG8_SB(b, h) ((4 + (b) * 2 + (h)) * HTB)
#define PG8_STAGE(bufoff, gbase, voff) do { _Pragma("unroll") for (int _i = 0; _i < 2; ++_i) \
        __builtin_amdgcn_global_load_lds((const unsigned*)((const char*)(gbase) + (voff)[_i]), (PG8_LAS unsigned*)(lds + (bufoff) + ldsw + _i * 8192), 16, 0, 0); } while (0)
#define PG8_LDA(dst, b, h) do { _Pragma("unroll") for (int m = 0; m < 4; ++m) _Pragma("unroll") for (int k = 0; k < 2; ++k) dst[m][k] = *(const PG8_LAS bf16x8*)(lds + PG8_SA(b, h) + aoff + m * 2048 + k * 1024); } while (0)
#define PG8_LDB(dst, b, h) do { _Pragma("unroll") for (int n = 0; n < 2; ++n) _Pragma("unroll") for (int k = 0; k < 2; ++k) dst[n][k] = *(const PG8_LAS bf16x8*)(lds + PG8_SB(b, h) + boff + n * 2048 + k * 1024); } while (0)
#define PG8_MMA(ai, bj, At, Bt) do { __builtin_amdgcn_s_setprio(1); _Pragma("unroll") for (int m = 0; m < 4; ++m) _Pragma("unroll") for (int n = 0; n < 2; ++n) _Pragma("unroll") for (int k = 0; k < 2; ++k) \
        acc[ai][bj][m][n] = __builtin_amdgcn_mfma_f32_16x16x32_bf16(Bt[n][k], At[m][k], acc[ai][bj][m][n], 0, 0, 0); __builtin_amdgcn_s_setprio(0); } while (0)
#define PG8_WAIT_V(n) asm volatile("s_waitcnt vmcnt(" #n ")" ::: "memory")
#define PG8_WAIT_L(n) asm volatile("s_waitcnt lgkmcnt(" #n ")" ::: "memory")
#define PG8_BAR __builtin_amdgcn_s_barrier()
#define PG8_SCHED __builtin_amdgcn_sched_barrier(0)
    Unit cur, nxt; int ui = 0;
    if (!S.next(0, cur)) return;
    f32x4 acc[2][2][4][2];
#pragma unroll
    for (int a = 0; a < 2; ++a)
#pragma unroll
        for (int b = 0; b < 2; ++b)
#pragma unroll
            for (int m = 0; m < 4; ++m)
#pragma unroll
                for (int n = 0; n < 2; ++n) acc[a][b][m][n] = (f32x4){0.f, 0.f, 0.f, 0.f};
    bf16x8 At[4][2], B0[2][2], B1[2][2];
    const char* cA = (const char*)g.A + (size_t)cur.pm * tstep; const char* cB = (const char*)g.Bt + (size_t)cur.pn * tstep;
    S.a_ready(cur);
    if constexpr (SP2) {
        PG8_STAGE(PG8_SB(0, 0), cB, voffB); PG8_STAGE(PG8_SB(0, 1), cB + hstep, voffB); PG8_STAGE(PG8_SA(0, 0), cA, voffA); PG8_STAGE(PG8_SA(0, 1), cA + hstep, voffA);
        if (wr == 1) PG8_BAR;
        PG8_WAIT_V(2); PG8_BAR;
        PG8_STAGE(PG8_SB(1, 0), cB + kstep, voffB); PG8_STAGE(PG8_SA(1, 0), cA + kstep, voffA); PG8_STAGE(PG8_SB(1, 1), cB + hstep + kstep, voffB);
        PG8_WAIT_V(6); PG8_BAR;
    } else {
        PG8_STAGE(PG8_SB(0, 0), cB, voffB); PG8_STAGE(PG8_SA(0, 0), cA, voffA); PG8_STAGE(PG8_SB(0, 1), cB + hstep, voffB); PG8_STAGE(PG8_SA(0, 1), cA + hstep, voffA);
        if (wr == 1) PG8_BAR;
        PG8_WAIT_V(4); PG8_BAR;
        PG8_STAGE(PG8_SB(1, 0), cB + kstep, voffB); PG8_STAGE(PG8_SA(1, 0), cA + kstep, voffA); PG8_STAGE(PG8_SB(1, 1), cB + hstep + kstep, voffB);
        PG8_WAIT_V(6); PG8_BAR;
    }
    for (;;) {
        const bool has_next = S.next(ui + 1, nxt);
        const char* nA = has_next ? (const char*)g.A + (size_t)nxt.pm * tstep : cA; const char* nB = has_next ? (const char*)g.Bt + (size_t)nxt.pn * tstep : cB;
        for (int t = 0; t < nt; t += 2) {
            const bool last = (t == nt - 2);
            const char* a1 = cA + (size_t)(t + 1) * kstep;
            const char* a2 = last ? nA : cA + (size_t)(t + 2) * kstep; const char* b2 = last ? nB : cB + (size_t)(t + 2) * kstep;
            const char* a3 = a2 + kstep; const char* b3 = b2 + kstep;
            if (last && has_next) S.a_ready(nxt);
            if constexpr (SP2) {
            PG8_LDB(B0, 0, 0); PG8_LDB(B1, 0, 1); PG8_SCHED; PG8_LDA(At, 0, 0); PG8_STAGE(PG8_SA(1, 1), a1 + hstep, voffA);
            PG8_WAIT_V(8); PG8_WAIT_L(0); PG8_BAR; PG8_MMA(0, 0, At, B0); PG8_MMA(0, 1, At, B1); PG8_BAR; PG8_SCHED;
            PG8_LDA(At, 0, 1); PG8_STAGE(PG8_SB(0, 0), b2, voffB); PG8_STAGE(PG8_SB(0, 1), b2 + hstep, voffB); PG8_STAGE(PG8_SA(0, 0), a2, voffA);
            PG8_WAIT_V(8); PG8_WAIT_L(0); PG8_BAR; PG8_MMA(1, 0, At, B0); PG8_MMA(1, 1, At, B1); PG8_BAR; PG8_SCHED;
            PG8_LDB(B0, 1, 0); PG8_LDB(B1, 1, 1); PG8_SCHED; PG8_LDA(At, 1, 0); PG8_STAGE(PG8_SA(0, 1), a2 + hstep, voffA);
            PG8_WAIT_V(8); PG8_WAIT_L(0); PG8_BAR; PG8_MMA(0, 0, At, B0); PG8_MMA(0, 1, At, B1); PG8_BAR; PG8_SCHED;
            PG8_LDA(At, 1, 1); PG8_STAGE(PG8_SB(1, 0), b3, voffB); PG8_STAGE(PG8_SB(1, 1), b3 + hstep, voffB); PG8_STAGE(PG8_SA(1, 0), a3, voffA);
            PG8_WAIT_V(8); PG8_WAIT_L(0); PG8_BAR; PG8_MMA(1, 0, At, B0); PG8_MMA(1, 1, At, B1); PG8_BAR; PG8_SCHED;
            } else {
            PG8_LDB(B0, 0, 0); PG8_SCHED; PG8_LDA(At, 0, 0); PG8_STAGE(PG8_SA(1, 1), a1 + hstep, voffA);
            PG8_WAIT_L(8); PG8_BAR; PG8_WAIT_L(0); PG8_MMA(0, 0, At, B0); PG8_BAR; PG8_SCHED;
            PG8_LDB(B1, 0, 1); PG8_STAGE(PG8_SB(0, 0), b2, voffB);
            PG8_BAR; PG8_WAIT_L(0); PG8_MMA(0, 1, At, B1); PG8_BAR;
            PG8_LDA(At, 0, 1); PG8_STAGE(PG8_SA(0, 0), a2, voffA);
            PG8_BAR; PG8_WAIT_L(0); PG8_MMA(1, 0, At, B0); PG8_BAR; PG8_SCHED;
            PG8_STAGE(PG8_SB(0, 1), b2 + hstep, voffB);
            PG8_WAIT_V(6); PG8_BAR; PG8_MMA(1, 1, At, B1); PG8_BAR;
            PG8_LDB(B0, 1, 0); PG8_SCHED; PG8_LDA(At, 1, 0); PG8_STAGE(PG8_SA(0, 1), a2 + hstep, voffA);
            PG8_WAIT_L(8); PG8_BAR; PG8_WAIT_L(0); PG8_MMA(0, 0, At, B0); PG8_BAR; PG8_SCHED;
            PG8_LDB(B1, 1, 1); PG8_STAGE(PG8_SB(1, 0), b3, voffB);
            PG8_BAR; PG8_WAIT_L(0); PG8_MMA(0, 1, At, B1); PG8_BAR;
            PG8_LDA(At, 1, 1); PG8_STAGE(PG8_SA(1, 0), a3, voffA);
            PG8_BAR; PG8_WAIT_L(0); PG8_MMA(1, 0, At, B0); PG8_BAR; PG8_SCHED;
            PG8_STAGE(PG8_SB(1, 1), b3 + hstep, voffB);
            PG8_WAIT_V(6); PG8_BAR; PG8_MMA(1, 1, At, B1); PG8_BAR;
            }
        }
        if constexpr (ALIGN_EPI) { if (wr == 0) PG8_BAR; }
        if constexpr (!Epi::AFTER_DRAIN) { E(acc, cur, wr, wc, fr, fq, ui); S.done(cur); }
        if (!has_next) break;
#pragma unroll
        for (int a = 0; a < 2; ++a)
#pragma unroll
            for (int b = 0; b < 2; ++b)
#pragma unroll
                for (int m = 0; m < 4; ++m)
#pragma unroll
                    for (int n = 0; n < 2; ++n) acc[a][b][m][n] = (f32x4){0.f, 0.f, 0.f, 0.f};
        cur = nxt; cA = nA; cB = nB; ++ui;
        if constexpr (ALIGN_EPI) { if (wr == 1) PG8_BAR; }
    }
    PG8_WAIT_V(0);
    if constexpr (!ALIGN_EPI) { if (wr == 0) PG8_BAR; }
    PG8_BAR;
    if constexpr (Epi::AFTER_DRAIN) { E.fused(acc, cur, wr, wc, fr, fq, lds, wid, lane); S.done(cur); }
#undef PG8_SA
#undef PG8_SB
#undef PG8_STAGE
#undef PG8_LDA
#undef PG8_LDB
#undef PG8_MMA
#undef PG8_WAIT_V
#undef PG8_WAIT_L
#undef PG8_BAR
#undef PG8_SCHED
}
}
constexpr int NWAVES = 8;
constexpr int DM = 1024, SEQ = 16384, DEPTH = 4, DECB = 16, DECS = 64, PAST = 4096;
constexpr int M = SEQ + DECB * DECS;
constexpr int NIN = pg8::IN_N;
constexpr int DFF = 2816, NF1 = 2 * DFF;
constexpr int WIN_ORIG = 3088;
constexpr int NCHUNK = M / 64;
constexpr int NPCH = SEQ / 64;
constexpr float RMS_EPS = 1e-6f;
constexpr size_t OY = 0, OK_P = 17825792, OV_P = 51380224, OG_P = 84934656, OK_S = 85065728, OV_S = 87162880, OG_S = 89260032, OUT_TOTAL = 91357184;

constexpr size_t MiB = 1u << 20;
constexpr size_t WS_CTL = 0, CTL_ZERO_BYTES = 128 * 1024;
constexpr size_t WS_W = 2 * MiB, W_LAYER = 25 * MiB;
constexpr size_t WO_IN = 0, WO_OUT = 6815744, WO_F1 = WO_OUT + 2 * MiB, WO_F2 = WO_F1 + 11 * MiB;
static_assert(WO_F2 + (size_t)DM * DFF * 2 == W_LAYER, "weight map");
constexpr size_t WS_X = 104 * MiB;
constexpr size_t WS_XN = 172 * MiB;
constexpr size_t WS_ACT = 206 * MiB;
constexpr size_t WS_MIX = 317 * MiB;
constexpr size_t WS_H = 351 * MiB;
constexpr size_t WS_LOGA = 445 * MiB;
constexpr size_t WS_U = 462 * MiB;
constexpr size_t WS_D = 496 * MiB;
constexpr size_t WS_SC = 497 * MiB;
constexpr size_t WS_OI = 529 * MiB;
constexpr size_t WS_QT = 563 * MiB;
constexpr size_t WS_RSQ = 576 * MiB;
constexpr size_t WS_END = 588 * MiB;
static_assert(WS_X + (size_t)M * DM * 4 <= WS_XN && WS_XN + (size_t)M * DM * 2 <= WS_ACT && WS_ACT + (size_t)M * NIN * 2 <= WS_MIX && WS_MIX + (size_t)M * DM * 2 <= WS_H &&
              WS_H + (size_t)M * DFF * 2 <= WS_LOGA && WS_LOGA + (size_t)M * 256 * 4 <= WS_U && WS_U + (size_t)NCHUNK * 4 * 64 * 128 * 4 <= WS_D && WS_D + (size_t)NCHUNK * 4 * 64 * 4 <= WS_SC &&
              WS_SC + (size_t)NPCH * 4 * 64 * 128 * 4 <= WS_OI && WS_OI + (size_t)M * 512 * 4 <= WS_QT && WS_QT + (size_t)M * 256 * 2 <= WS_RSQ && WS_RSQ + (size_t)9 * M * 64 <= WS_END, "d_ws map");
constexpr int CW_TMO = 0, CW_CODE = 1;
constexpr int CW_BAR = 4096;
constexpr int CW_QUEUE = 16384;

constexpr int RING_OFF = 0, RING_BYTES = 131072;
constexpr int LDSCTL_OFF = RING_BYTES, MISC_OFF = LDSCTL_OFF + 320;
constexpr int LDS_BYTES = 147456;

#define GAS __attribute__((address_space(1)))
#define LAS __attribute__((address_space(3)))
typedef unsigned short bf16;
typedef unsigned v4u __attribute__((ext_vector_type(4)));
typedef unsigned v2u __attribute__((ext_vector_type(2)));
typedef float f32x4 __attribute__((ext_vector_type(4)));
typedef float f32x16 __attribute__((ext_vector_type(16)));
typedef short bf16x8 __attribute__((ext_vector_type(8)));
typedef short s16x4 __attribute__((ext_vector_type(4)));
typedef GAS unsigned gu32;
#define RLX_AGENT __ATOMIC_RELAXED, __HIP_MEMORY_SCOPE_AGENT
#define LDS_WAIT() asm volatile("s_waitcnt lgkmcnt(0)" ::: "memory")
#define VM_WAIT() asm volatile("s_waitcnt vmcnt(0)" ::: "memory")
__device__ __forceinline__ unsigned f2bf(float f) { unsigned u = __builtin_bit_cast(unsigned, f); return (u + 0x7fffu + ((u >> 16) & 1u)) >> 16; }
typedef float pkf2_t __attribute__((ext_vector_type(2)));
typedef __bf16 pkb2_t __attribute__((ext_vector_type(2)));
__device__ __forceinline__ unsigned pk2(float lo, float hi) { const pkf2_t v = {lo, hi}; return __builtin_bit_cast(unsigned, __builtin_convertvector(v, pkb2_t)); }
__device__ __forceinline__ float bf2f(unsigned short b) { return __builtin_bit_cast(float, (unsigned)b << 16); }
__device__ __forceinline__ float wave_sum(float v) {
#define WS_DPP_(ctrl) do { const int t_ = __builtin_amdgcn_update_dpp(0, __builtin_bit_cast(int, v), (ctrl), 0xf, 0xf, false); v += __builtin_bit_cast(float, t_); } while (0)
    WS_DPP_(0xB1);
    WS_DPP_(0x4E);
    WS_DPP_(0x124);
    WS_DPP_(0x128);
#undef WS_DPP_
    { const unsigned u = __builtin_bit_cast(unsigned, v); const auto r = __builtin_amdgcn_permlane16_swap(u, u, false, false); const unsigned a = r[0], b = r[1];
      v = __builtin_bit_cast(float, a) + __builtin_bit_cast(float, b); }
    { const unsigned u = __builtin_bit_cast(unsigned, v); const auto r = __builtin_amdgcn_permlane32_swap(u, u, false, false); const unsigned a = r[0], b = r[1];
      v = __builtin_bit_cast(float, a) + __builtin_bit_cast(float, b); }
    return v;
}
#define XB_TMO      128
#define XB_XCNT(j)  (256  + 64 * (j))
#define XB_XSUB(j)  (1280 + 64 * (j))
#define XB_XGEN(j)  (2304 + 64 * (j))
#define XB_TOP      3328
#define XB_TOPGEN   3392
#define XCD_BAR_WORDS 3456
#define XB_SPIN_CAP (1u << 18)

__device__ __forceinline__ unsigned xb_ld(unsigned* p)              { return __hip_atomic_load(p, __ATOMIC_RELAXED, __HIP_MEMORY_SCOPE_AGENT); }
__device__ __forceinline__ unsigned xb_add(unsigned* p, unsigned v) { return __hip_atomic_fetch_add(p, v, __ATOMIC_RELAXED, __HIP_MEMORY_SCOPE_AGENT); }
__device__ __forceinline__ unsigned xb_xcc_id() { return (unsigned)__builtin_amdgcn_s_getreg((3 << 11) | 20) & 0xFu; }
#define XB_SPIN(cond, bar) do { unsigned _sp = 0; while (cond) { __builtin_amdgcn_s_sleep(1); \
    if ((++_sp & 255u) == 0u) { if (xb_ld(&(bar)[XB_TMO])) break; if (_sp > XB_SPIN_CAP) { atomicAdd(&(bar)[XB_TMO], 1u); break; } } } } while (0)

struct XcdBarrier {
    unsigned* bar; unsigned x;
    volatile LAS unsigned* st;
};

__device__ __forceinline__ XcdBarrier xcd_barrier_post(unsigned* bar, volatile LAS unsigned* st) {
    XcdBarrier b; b.bar = bar; b.x = xb_xcc_id(); b.st = st;
    if (threadIdx.x == 0) (void)xb_add(&bar[XB_XCNT(b.x)], 1u);
    return b;
}
__device__ __forceinline__ void xcd_barrier_complete(unsigned* bar, unsigned x, unsigned& nloc, unsigned& nx) {
    const unsigned G = gridDim.x * gridDim.y * gridDim.z;
    unsigned sum, cnt, mine, sp = 0u;
    for (;;) {
        sum = 0u; cnt = 0u; mine = 0u;
#pragma unroll
        for (unsigned j = 0; j < 16; ++j) { const unsigned c = xb_ld(&bar[XB_XCNT(j)]); sum += c; cnt += (c > 0u) ? 1u : 0u; mine = (j == x) ? c : mine; }
        if (sum == G) break;
        __builtin_amdgcn_s_sleep(1);
        if ((++sp & 255u) == 0u) { if (xb_ld(&bar[XB_TMO])) break; if (sp > XB_SPIN_CAP) { atomicAdd(&bar[XB_TMO], 1u); break; } }
    }
    nloc = mine > 0u ? mine : 1u; nx = cnt > 0u ? cnt : 1u;
}

__device__ __forceinline__ void xcd_barrier(const XcdBarrier& b) {
    asm volatile("s_waitcnt vmcnt(0)" ::: "memory");
    __syncthreads();
    if (threadIdx.x == 0) {
        unsigned* bar = b.bar;
        __builtin_amdgcn_s_waitcnt(0);
        unsigned nloc = b.st[0], nx = b.st[1];
        if (nloc == 0u) { xcd_barrier_complete(bar, b.x, nloc, nx); b.st[0] = nloc; b.st[1] = nx; }
        const unsigned old = xb_add(&bar[XB_XSUB(b.x)], 1u);
        const unsigned gen = old / nloc;
        if (old + 1u == (gen + 1u) * nloc) {
            __builtin_amdgcn_fence(__ATOMIC_RELEASE, "agent");
            asm volatile("s_waitcnt vmcnt(0)" ::: "memory");
            const unsigned og = xb_add(&bar[XB_TOP], 1u);
            const unsigned tg = og / nx;
            if (og + 1u == (tg + 1u) * nx) xb_add(&bar[XB_TOPGEN], 1u);
            else XB_SPIN(xb_ld(&bar[XB_TOPGEN]) == tg, bar);
            __builtin_amdgcn_fence(__ATOMIC_ACQUIRE, "agent");
            xb_add(&bar[XB_XGEN(b.x)], 1u);
            asm volatile("s_waitcnt vmcnt(0)" ::: "memory");
        } else {
            XB_SPIN(xb_ld(&bar[XB_XGEN(b.x)]) == gen, bar);
            __builtin_amdgcn_fence(__ATOMIC_ACQUIRE, "agent");
            asm volatile("s_waitcnt vmcnt(0)" ::: "memory");
        }
    }
    __syncthreads();
}
struct Frame {
    LAS unsigned char* lds;
};
__device__ __forceinline__ int grid_n() { return (int)gridDim.x; }
__device__ __forceinline__ int vcu_id() { const int G = (int)gridDim.x, bx = (int)blockIdx.x; return (G % 8 == 0) ? (bx % 8) * (G / 8) + bx / 8 : bx; }
__device__ __forceinline__ int fresh_tid() { int t = threadIdx.x; asm volatile("" : "+v"(t)); return t; }

__device__ __forceinline__ void tr_store(LAS float* scr, bf16* WT, int K, int dstrow0, int k0, int lane, int dstep = 1) {
    LDS_WAIT(); asm volatile("" ::: "memory");
    const int c = lane & 7;
#pragma unroll
    for (int j = 0; j < 4; ++j) { const int n = (lane >> 3) + 8 * j; const LAS float* s = scr + (8 * c) * 33 + n;
        v4u o; o.x = pk2(s[0 * 33], s[1 * 33]); o.y = pk2(s[2 * 33], s[3 * 33]); o.z = pk2(s[4 * 33], s[5 * 33]); o.w = pk2(s[6 * 33], s[7 * 33]);
        *(GAS v4u*)(WT + (size_t)(dstrow0 + n * dstep) * K + k0 + 8 * c) = o; }
    LDS_WAIT(); asm volatile("" ::: "memory");
}
__device__ __forceinline__ void tr_item(const float* W, int ld, int K, int srccol0, bf16* WT, int dstrow0, int k0, LAS float* scr, int lane, const float* gk, int dstep = 1) {
    const int ks = lane >> 3, nq = (lane & 7) * 4; f32x4 v[8];
#pragma unroll
    for (int i = 0; i < 8; ++i) v[i] = *(const f32x4*)(W + (size_t)(k0 + 8 * i + ks) * ld + srccol0 + nq);
#pragma unroll
    for (int i = 0; i < 8; ++i) { const int kk = 8 * i + ks; f32x4 x = v[i]; if (gk) x = x * gk[k0 + kk];
        LAS float* d = scr + kk * 33 + nq; d[0] = x[0]; d[1] = x[1]; d[2] = x[2]; d[3] = x[3]; }
    tr_store(scr, WT, K, dstrow0, k0, lane, dstep);
}
__device__ __forceinline__ void tr_item_z(const float* Win, const float* a2, int n0z, bf16* WT, int k0, LAS float* scr, int lane, const float* gk) {
    float av[16];
#pragma unroll
    for (int r = 0; r < 16; ++r) av[r] = a2[r * 256 + n0z + (lane & 31)];
#pragma unroll 8
    for (int i = 0; i < 32; ++i) { const int kk = 2 * i + (lane >> 5); const float* wr_ = Win + (size_t)(k0 + kk) * WIN_ORIG + 1536; float s = 0.f;
#pragma unroll
        for (int r4 = 0; r4 < 4; ++r4) { const f32x4 w4 = ((const f32x4*)wr_)[r4];
            s = fmaf(w4[0], av[4 * r4], s); s = fmaf(w4[1], av[4 * r4 + 1], s); s = fmaf(w4[2], av[4 * r4 + 2], s); s = fmaf(w4[3], av[4 * r4 + 3], s); }
        scr[kk * 33 + (lane & 31)] = s * gk[k0 + kk]; }
    tr_store(scr, WT, DM, 512 + n0z, k0, lane);
}

struct Args { const float* in[18]; float* out; unsigned char* ws; };
constexpr int PTAB_OFF = MISC_OFF + 128;
__device__ __forceinline__ const float* inp(const Frame& F, int i) {
    unsigned off = (unsigned)(PTAB_OFF + 8 * i); asm volatile("" : "+v"(off));
    const volatile LAS unsigned* t = (const volatile LAS unsigned*)(F.lds + off);
    const unsigned lo = __builtin_amdgcn_readfirstlane(t[0]), hi = __builtin_amdgcn_readfirstlane(t[1]);
    return (const float*)(const GAS float*)(((unsigned long long)hi << 32) | lo);
}
__device__ __forceinline__ float* outp(const Frame& F) { return (float*)inp(F, 18); }
__device__ __forceinline__ unsigned char* wsp(const Frame& F) { return (unsigned char*)inp(F, 19); }

__device__ __forceinline__ void p0_items(Frame& F, int it_lo, int it_hi, int cu0, int ncu);
__device__ __forceinline__ void p0_prologue(Frame& F, int l_lo, int l_hi, int cu0, int ncu) { p0_items(F, l_lo * 6400, l_hi * 6400, cu0, ncu); }
__device__ __forceinline__ void p0_items(Frame& F, int it_lo, int it_hi, int cu0, int ncu) {
    const int tid_ = fresh_tid(), lane_ = tid_ & 63, wave_ = __builtin_amdgcn_readfirstlane(tid_ >> 6);
    LAS float* scr = (LAS float*)(F.lds + RING_OFF + wave_ * 16384);
    const int me = (int)blockIdx.x - cu0; if (me < 0 || me >= ncu) return;
    const int gw = me * NWAVES + wave_, NGW = ncu * NWAVES;
    constexpr int I_IN = 16 * 104, I_OUT = 16 * 32, I_F1 = 16 * 176, I_F2 = 44 * 32, I_L = I_IN + I_OUT + I_F1 + I_F2;
    static_assert(I_L == 6400, "item count");
    for (int it = it_lo + gw; it < it_hi; it += NGW) {
        const int l = it / I_L; int r = it % I_L;
        unsigned char* wl = wsp(F) + WS_W + (size_t)l * W_LAYER;
        if (r < I_IN) { const int kb = r / 104, nb = r % 104, n0 = 32 * nb; const float* W = inp(F, 5) + (size_t)l * DM * WIN_ORIG;
            if (n0 >= 512 && n0 < 768) tr_item_z(W, inp(F, 6) + (size_t)l * 16 * 256, n0 - 512, (bf16*)(wl + WO_IN), 64 * kb, scr, lane_, inp(F, 12) + (size_t)l * DM);
            else if (n0 < 512) {
                const int dst = n0 < 256 ? 2 * n0 : 2 * (n0 - 256) + 1; tr_item(W, WIN_ORIG, DM, n0, (bf16*)(wl + WO_IN), dst, 64 * kb, scr, lane_, inp(F, 12) + (size_t)l * DM, 2); }
            else { const int src = n0 < 1792 ? n0 - 256 : n0 - 240; tr_item(W, WIN_ORIG, DM, src, (bf16*)(wl + WO_IN), n0, 64 * kb, scr, lane_, inp(F, 12) + (size_t)l * DM); }
            continue; }
        r -= I_IN;
        if (r < I_OUT) { const int kb = r / 32, nb = r % 32; tr_item(inp(F, 11) + (size_t)l * DM * DM, DM, DM, 32 * nb, (bf16*)(wl + WO_OUT), 32 * nb, 64 * kb, scr, lane_, nullptr); continue; }
        r -= I_OUT;
        if (r < I_F1) { const int kb = r / 176, nb = r % 176, n0 = 32 * nb, pn = n0 >> 8, j = n0 & 255; const int src = j < 128 ? 128 * pn + j : DFF + 128 * pn + (j - 128);
            tr_item(inp(F, 14) + (size_t)l * DM * NF1, NF1, DM, src, (bf16*)(wl + WO_F1), n0, 64 * kb, scr, lane_, inp(F, 13) + (size_t)l * DM); continue; }
        r -= I_F1;
        { const int kb = r / 32, nb = r % 32; tr_item(inp(F, 15) + (size_t)l * DFF * DM, DM, DFF, 32 * nb, (bf16*)(wl + WO_F2), 32 * nb, 64 * kb, scr, lane_, nullptr); }
    }
}

__device__ __forceinline__ void rows_to_bf16_sq(Frame& F, const float* srcp, const float* srcs, bf16* XB, float* rowsq) {
    const int tid_ = fresh_tid(), lane_ = tid_ & 63, wave_ = __builtin_amdgcn_readfirstlane(tid_ >> 6);
    const int gw = vcu_id() * NWAVES + wave_, NGW = grid_n() * NWAVES;
    for (int m0 = gw; m0 < M; m0 += 2 * NGW) {
        const int m1 = (m0 + NGW < M) ? m0 + NGW : m0;
        f32x4 v[2][4]; float s[2] = {0.f, 0.f};
#pragma unroll
        for (int t = 0; t < 2; ++t) { const int m = t ? m1 : m0; const float* xrow = m < SEQ ? srcp + (size_t)m * DM : srcs + (size_t)(m - SEQ) * DM;
            const GAS f32x4* xr = (const GAS f32x4*)xrow + lane_;
#pragma unroll
            for (int j = 0; j < 4; ++j) v[t][j] = xr[64 * j]; }
#pragma unroll
        for (int t = 0; t < 2; ++t) {
#pragma unroll
            for (int j = 0; j < 4; ++j) s[t] += (v[t][j].x * v[t][j].x + v[t][j].y * v[t][j].y) + (v[t][j].z * v[t][j].z + v[t][j].w * v[t][j].w);
            s[t] = wave_sum(s[t]); }
#pragma unroll
        for (int t = 0; t < 2; ++t) { const int m = t ? m1 : m0;
            GAS unsigned long long* o8 = (GAS unsigned long long*)(XB + (size_t)m * DM) + lane_;
#pragma unroll
            for (int j = 0; j < 4; ++j) o8[64 * j] = (unsigned long long)pk2(v[t][j].x, v[t][j].y) | ((unsigned long long)pk2(v[t][j].z, v[t][j].w) << 32);
            if (lane_ < 16) rowsq[(size_t)m * 16 + lane_] = lane_ == 0 ? s[t] : 0.f; }
    }
}
__device__ __forceinline__ void norm_rows_f32(Frame& F, const bf16* src, const float* g, float* out) {
    const int tid_ = fresh_tid(), lane_ = tid_ & 63, wave_ = __builtin_amdgcn_readfirstlane(tid_ >> 6);
    const int gw = vcu_id() * NWAVES + wave_, NGW = grid_n() * NWAVES;
    f32x4 gv[4];
#pragma unroll
    for (int j = 0; j < 4; ++j) gv[j] = ((const GAS f32x4*)g)[lane_ + 64 * j];
    for (int m0 = gw; m0 < M; m0 += 2 * NGW) {
        const int m1 = (m0 + NGW < M) ? m0 + NGW : m0;
        v2u w[2][4];
#pragma unroll
        for (int t = 0; t < 2; ++t) { const GAS v2u* xr = (const GAS v2u*)(src + (size_t)(t ? m1 : m0) * DM) + lane_;
#pragma unroll
            for (int j = 0; j < 4; ++j) w[t][j] = xr[64 * j]; }
#pragma unroll
        for (int t = 0; t < 2; ++t) { f32x4 v[4]; float s = 0.f;
#pragma unroll
            for (int j = 0; j < 4; ++j) { v[j].x = __builtin_bit_cast(float, w[t][j].x << 16); v[j].y = __builtin_bit_cast(float, w[t][j].x & 0xffff0000u);
                v[j].z = __builtin_bit_cast(float, w[t][j].y << 16); v[j].w = __builtin_bit_cast(float, w[t][j].y & 0xffff0000u);
                s += (v[j].x * v[j].x + v[j].y * v[j].y) + (v[j].z * v[j].z + v[j].w * v[j].w); }
            const float rstd = __builtin_amdgcn_rsqf(wave_sum(s) * (1.f / DM) + RMS_EPS);
            GAS f32x4* o = (GAS f32x4*)(out + (size_t)(t ? m1 : m0) * DM) + lane_;
#pragma unroll
            for (int j = 0; j < 4; ++j) o[64 * j] = v[j] * rstd * gv[j]; }
    }
}

constexpr int RSTD_OFF = MISC_OFF + 512;
static_assert(RSTD_OFF + 8 * 256 * 4 <= LDS_BYTES, "rstd table");
__device__ __forceinline__ void rstd_prepass(Frame& F, const pg8::StaticOrder& S, const float* rsq) {
    const int tid_ = fresh_tid(); LAS float* tab = (LAS float*)(F.lds + RSTD_OFF);
    for (int idx = tid_; idx < 8 * 256; idx += NWAVES * 64) { pg8::Unit u; if (!S.next(idx >> 8, u)) break; tab[idx] = pg8::row_rstd(rsq, u.pm * 256 + (idx & 255)); }
    __syncthreads();
}

#ifdef PROBE_EXTRA_BARRIER
#define PROBE_XBAR asm volatile("s_barrier" ::: "memory")
#else
#define PROBE_XBAR do {} while (0)
#endif
#ifdef PROBE_EXTRA_EXP
#define PROBE_XEXP(x) do { float t_; asm volatile("v_exp_f32 %0, %1" : "=v"(t_) : "v"(x)); } while (0)
#else
#define PROBE_XEXP(x) do {} while (0)
#endif
namespace att {
typedef float f32x8 __attribute__((ext_vector_type(8)));
typedef unsigned u32x4 __attribute__((ext_vector_type(4)));
constexpr float THRL = 8.f * 1.4426950408889634f;
constexpr int SHM_V = 16384, SHM_K = 16384;
constexpr int OFF_V = 0, OFF_K = 2 * SHM_V;
constexpr int RK = 0, RV = 3 * SHM_K;
constexpr int OFF_WS = 7 * SHM_K, TAB_N = 384, OFF_LAM = OFF_WS + 2048, OFF_G3 = OFF_LAM + 256, OFF_END = OFF_G3 + 1024;
constexpr int OFF_TAB = MISC_OFF + 512 + 8 * 256 * 4 + 64;
static_assert(OFF_END <= RING_BYTES && OFF_TAB + 4 * TAB_N * 4 <= LDS_BYTES, "attention LDS map");
#define KSWZ(row, colB) ((row) * 256 + ((colB) ^ (((row) & 7) << 4)))
#define SBAR() __builtin_amdgcn_sched_barrier(0)
__device__ __forceinline__ int crow(int r, int hi) { return (r & 3) + 8 * (r >> 2) + 4 * hi; }
__device__ __forceinline__ unsigned cvtpk(float lo, float hi) { unsigned r; asm volatile("v_cvt_pk_bf16_f32 %0, %1, %2" : "=v"(r) : "v"(lo), "v"(hi)); return r; }
template <bool F32> struct Stage;
template <> struct Stage<false> { using E = bf16; using T = bf16x8;
  __device__ static __forceinline__ T ld8(const E* p) { return *reinterpret_cast<const bf16x8*>(p); }
  __device__ static __forceinline__ bf16x8 tobf(T x) { return x; } };
template <> struct Stage<true> { using E = float; using T = f32x8;
  __device__ static __forceinline__ T ld8(const E* p) { return *reinterpret_cast<const f32x8*>(p); }
  __device__ static __forceinline__ bf16x8 tobf(T x) { u32x4 w = {cvtpk(x[0], x[1]), cvtpk(x[2], x[3]), cvtpk(x[4], x[5]), cvtpk(x[6], x[7])}; return __builtin_bit_cast(bf16x8, w); } };

__device__ __forceinline__ float rowmax32(const f32x16& p0, const f32x16& p1) {
  float pmax = p0[0];
#pragma unroll
  for (int r = 1; r < 16; ++r) pmax = fmaxf(pmax, p0[r]);
#pragma unroll
  for (int r = 0; r < 16; ++r) pmax = fmaxf(pmax, p1[r]);
  auto rr = __builtin_amdgcn_permlane32_swap(__float_as_uint(pmax), __float_as_uint(pmax), false, false);
  return fmaxf(__uint_as_float(rr[0]), __uint_as_float(rr[1]));
}
__device__ __forceinline__ void partialSM(f32x16& p0, f32x16& p1, float& m_reg, float& mn, float& alpha) {
  const float pmax = rowmax32(p0, p1);
  if (__builtin_expect(__all(pmax - m_reg <= THRL), 1)) { mn = m_reg; alpha = 1.f; }
  else { mn = fmaxf(m_reg, pmax); alpha = __builtin_amdgcn_exp2f(m_reg - mn); m_reg = mn; }
#pragma unroll
  for (int r = 0; r < 16; ++r) p0[r] -= mn;
#pragma unroll
  for (int r = 0; r < 16; ++r) p1[r] -= mn;
#pragma unroll
  for (int r = 0; r < 16; ++r) p0[r] = __builtin_amdgcn_exp2f(p0[r]);
}
__device__ __forceinline__ void finishSM(f32x16& p0, f32x16& p1, float alpha, float& l_reg, bf16x8& pa0, bf16x8& pa1, bf16x8& pa2, bf16x8& pa3) {
#pragma unroll
  for (int r = 0; r < 16; ++r) p1[r] = __builtin_amdgcn_exp2f(p1[r]);
  float ps = 0;
#pragma unroll
  for (int r = 0; r < 16; ++r) ps += p0[r];
#pragma unroll
  for (int r = 0; r < 16; ++r) ps += p1[r];
  { auto rr = __builtin_amdgcn_permlane32_swap(__float_as_uint(ps), __float_as_uint(ps), false, false);
    ps = __uint_as_float(rr[0]) + __uint_as_float(rr[1]); }
  l_reg = l_reg * alpha + ps;
#define PK4(P, BASE, OUT) do { unsigned a0 = cvtpk(P[BASE + 0], P[BASE + 1]), a1 = cvtpk(P[BASE + 2], P[BASE + 3]);   \
    unsigned b0 = cvtpk(P[BASE + 4], P[BASE + 5]), b1 = cvtpk(P[BASE + 6], P[BASE + 7]);                              \
    auto r0 = __builtin_amdgcn_permlane32_swap(a0, b0, false, false); auto r1 = __builtin_amdgcn_permlane32_swap(a1, b1, false, false); \
    u32x4 w = {r0[0], r1[0], r0[1], r1[1]}; OUT = __builtin_bit_cast(bf16x8, w); } while (0)
  PK4(p0, 0, pa0); PK4(p0, 8, pa1); PK4(p1, 0, pa2); PK4(p1, 8, pa3);
#undef PK4
}
template <bool QL>
__device__ __forceinline__ void qkt(f32x16& p0, f32x16& p1, const LAS char* Ks, const bf16x8* qr, const LAS char* ql, int r32, int hi, int g) {
  p0 = f32x16{}; p1 = f32x16{};
#pragma unroll
  for (int d0 = 0; d0 < 4; ++d0) { const int cb = ((g * 4 + d0) * 16 + hi * 8) * 2;
    const bf16x8 b0 = *(const LAS bf16x8*)(Ks + KSWZ(r32, cb));
    const bf16x8 b1 = *(const LAS bf16x8*)(Ks + KSWZ(32 + r32, cb));
    bf16x8 q; if constexpr (QL) q = *(const LAS bf16x8*)(ql + d0 * 1024); else q = qr[d0];
    p0 = __builtin_amdgcn_mfma_f32_32x32x16_bf16(b0, q, p0, 0, 0, 0);
    p1 = __builtin_amdgcn_mfma_f32_32x32x16_bf16(b1, q, p1, 0, 0, 0); }
}
__device__ __forceinline__ int v_st(int k, int c) { const int kk = (k & ~0xC) | ((k & 4) << 1) | ((k & 8) >> 1); return ((kk >> 3) * 4 + (c >> 5)) * 512 + ((kk & 7) * 32 + (c & 31)) * 2; }
__device__ __forceinline__ int v_rd_base(int lane) { return ((lane & 3) << 3) | (((lane >> 2) & 3) << 6) | (((lane >> 4) & 1) << 5) | (((lane >> 5) & 1) << 8); }
constexpr int v_rd_off(int d0, int ks, int half) { return d0 * 512 + ks * 4096 + half * 2048; }
typedef short v4i16_t __attribute__((ext_vector_type(4)));
template <int OFF> __device__ __forceinline__ s16x4 tr_read(const LAS char* vb) {
  return __builtin_bit_cast(s16x4, __builtin_amdgcn_ds_read_tr16_b64_v4i16((LAS v4i16_t*)(vb + OFF)));
}
template <int D0> __device__ __forceinline__ void pv_one(f32x16& od, const LAS char* vb, bf16x8 pa0, bf16x8 pa1, bf16x8 pa2, bf16x8 pa3) {
  const s16x4 l0 = tr_read<v_rd_off(D0, 0, 0)>(vb), h0 = tr_read<v_rd_off(D0, 0, 1)>(vb), l1 = tr_read<v_rd_off(D0, 1, 0)>(vb), h1 = tr_read<v_rd_off(D0, 1, 1)>(vb);
  const s16x4 l2 = tr_read<v_rd_off(D0, 2, 0)>(vb), h2 = tr_read<v_rd_off(D0, 2, 1)>(vb), l3 = tr_read<v_rd_off(D0, 3, 0)>(vb), h3 = tr_read<v_rd_off(D0, 3, 1)>(vb);
#define PK(L, H) (bf16x8){L[0], L[1], L[2], L[3], H[0], H[1], H[2], H[3]}
  od = __builtin_amdgcn_mfma_f32_32x32x16_bf16(pa0, PK(l0, h0), od, 0, 0, 0);
  od = __builtin_amdgcn_mfma_f32_32x32x16_bf16(pa1, PK(l1, h1), od, 0, 0, 0);
  od = __builtin_amdgcn_mfma_f32_32x32x16_bf16(pa2, PK(l2, h2), od, 0, 0, 0);
  od = __builtin_amdgcn_mfma_f32_32x32x16_bf16(pa3, PK(l3, h3), od, 0, 0, 0);
#undef PK
}
__device__ __forceinline__ void pv_d0(f32x16* o, const LAS char* vb, bf16x8 pa0, bf16x8 pa1, bf16x8 pa2, bf16x8 pa3) {
  pv_one<0>(o[0], vb, pa0, pa1, pa2, pa3); pv_one<1>(o[1], vb, pa0, pa1, pa2, pa3); pv_one<2>(o[2], vb, pa0, pa1, pa2, pa3); pv_one<3>(o[3], vb, pa0, pa1, pa2, pa3);
}
template <int KS> __device__ __forceinline__ void pv_kstep(f32x16* o, const LAS char* vb, bf16x8 pa) {
  const s16x4 l0 = tr_read<v_rd_off(0, KS, 0)>(vb), h0 = tr_read<v_rd_off(0, KS, 1)>(vb), l1 = tr_read<v_rd_off(1, KS, 0)>(vb), h1 = tr_read<v_rd_off(1, KS, 1)>(vb);
  const s16x4 l2 = tr_read<v_rd_off(2, KS, 0)>(vb), h2 = tr_read<v_rd_off(2, KS, 1)>(vb), l3 = tr_read<v_rd_off(3, KS, 0)>(vb), h3 = tr_read<v_rd_off(3, KS, 1)>(vb);
#define PK(L, H) (bf16x8){L[0], L[1], L[2], L[3], H[0], H[1], H[2], H[3]}
  o[0] = __builtin_amdgcn_mfma_f32_32x32x16_bf16(pa, PK(l0, h0), o[0], 0, 0, 0);
  o[1] = __builtin_amdgcn_mfma_f32_32x32x16_bf16(pa, PK(l1, h1), o[1], 0, 0, 0);
  o[2] = __builtin_amdgcn_mfma_f32_32x32x16_bf16(pa, PK(l2, h2), o[2], 0, 0, 0);
  o[3] = __builtin_amdgcn_mfma_f32_32x32x16_bf16(pa, PK(l3, h3), o[3], 0, 0, 0);
#undef PK
}
struct VF { s16x4 l0, h0, l1, h1, l2, h2, l3, h3; };
template <int KS> __device__ __forceinline__ void vf_load(VF& f, const LAS char* vb) {
  f.l0 = tr_read<v_rd_off(0, KS, 0)>(vb); f.h0 = tr_read<v_rd_off(0, KS, 1)>(vb); f.l1 = tr_read<v_rd_off(1, KS, 0)>(vb); f.h1 = tr_read<v_rd_off(1, KS, 1)>(vb);
  f.l2 = tr_read<v_rd_off(2, KS, 0)>(vb); f.h2 = tr_read<v_rd_off(2, KS, 1)>(vb); f.l3 = tr_read<v_rd_off(3, KS, 0)>(vb); f.h3 = tr_read<v_rd_off(3, KS, 1)>(vb);
}
__device__ __forceinline__ void vf_mma(f32x16* o, const VF& f, bf16x8 pa) {
#define PK(L, H) (bf16x8){L[0], L[1], L[2], L[3], H[0], H[1], H[2], H[3]}
  o[0] = __builtin_amdgcn_mfma_f32_32x32x16_bf16(pa, PK(f.l0, f.h0), o[0], 0, 0, 0);
  o[1] = __builtin_amdgcn_mfma_f32_32x32x16_bf16(pa, PK(f.l1, f.h1), o[1], 0, 0, 0);
  o[2] = __builtin_amdgcn_mfma_f32_32x32x16_bf16(pa, PK(f.l2, f.h2), o[2], 0, 0, 0);
  o[3] = __builtin_amdgcn_mfma_f32_32x32x16_bf16(pa, PK(f.l3, f.h3), o[3], 0, 0, 0);
#undef PK
}
__device__ __forceinline__ void pv_ks(f32x16* o, const LAS char* vb, bf16x8 pa0, bf16x8 pa1, bf16x8 pa2, bf16x8 pa3) {
  pv_kstep<0>(o, vb, pa0); pv_kstep<1>(o, vb, pa1); pv_kstep<2>(o, vb, pa2); pv_kstep<3>(o, vb, pa3);
}

__device__ __forceinline__ int t5_bucket(int rel) {
  const int ret = rel > 0 ? 16 : 0; const int n = rel < 0 ? -rel : rel;
  if (n < 8) return ret + n;
  int large = 8 + (31 - __builtin_clz((unsigned)(n * n))) - 6; if (large > 15) large = 15;
  return ret + large;
}
__device__ __forceinline__ void attn_setup_tab(LAS unsigned char* lds, const float* rel_bias) {
  const int tid = fresh_tid();
  LAS float* tab = (LAS float*)(lds + OFF_TAB);
  for (int e = tid; e < 4 * TAB_N; e += 512) { const int h = e / TAB_N, idx = e % TAB_N, rel = idx - 255;
    tab[e] = (rel_bias[t5_bucket(rel) * 4 + h] - rel_bias[15 * 4 + h]) * 1.4426950408889634f; }
}
__device__ __forceinline__ void attn_setup(LAS unsigned char* lds, const float* lamp  , int layer) {
  const int tid = fresh_tid();
  if (tid < 64) { const float a = lamp[tid] * lamp[64 + tid], b = lamp[128 + tid] * lamp[192 + tid];
    const float sa = wave_sum(a), sb = wave_sum(b);
    if (tid == 0) { const float lam_init = 0.8f - 0.6f * expf(-0.3f * (float)layer);
      ((LAS float*)(lds + OFF_LAM))[0] = expf(sa) - expf(sb) + lam_init; ((LAS float*)(lds + OFF_LAM))[1] = 1.f - lam_init; } }
  __syncthreads();
}


__device__ __forceinline__ void glds16(const void* gsrc, unsigned lds_dst) { unsigned keep;
  asm volatile("s_mov_b32 %0, m0\n\ts_mov_b32 m0, %2\n\ts_nop 0\n\tglobal_load_lds_dwordx4 %1, off\n\ts_mov_b32 m0, %0" : "=&s"(keep) : "v"(gsrc), "s"(lds_dst) : "memory"); }
template <int IMM> __device__ __forceinline__ void glds16_s(const void* sbase, unsigned voff, unsigned lds_dst) { unsigned keep;
  asm volatile("s_mov_b32 %0, m0\n\ts_mov_b32 m0, %3\n\ts_nop 0\n\tglobal_load_lds_dwordx4 %1, %2 offset:%4\n\ts_mov_b32 m0, %0" : "=&s"(keep) : "v"(voff), "s"(sbase), "s"(lds_dst), "i"(IMM) : "memory"); }
__device__ __forceinline__ void glds16_pair(const void* sbase, unsigned voffA, unsigned voffB_minus_1024, unsigned lds_dst) {
  asm volatile("s_mov_b32 m0, %3\n\ts_nop 0\n\tglobal_load_lds_dwordx4 %0, %2 offset:0\n\tglobal_load_lds_dwordx4 %1, %2 offset:1024" :: "v"(voffA), "v"(voffB_minus_1024), "s"(sbase), "s"(lds_dst) : "memory", "m0"); }
template <bool SAFE>
__device__ __forceinline__ bool attn_unit_prompt_t(LAS unsigned char* lds, const bf16* Kg, const bf16* Vg, const bf16* Qrow0, bf16* Orow0, int NT, int qpos0, int h, const float* gnorm) {
  constexpr int LDK = 3328;
  const int tid = fresh_tid(), wid = __builtin_amdgcn_readfirstlane(tid >> 6), lane = tid & 63, r32 = lane & 31, hi = lane >> 5;
  const int g = wid >> 2, rb = wid & 3;
  volatile LAS int* badflag = (volatile LAS int*)(lds + OFF_G3);
  if (!SAFE && tid == 0) *badflag = 0;
  int zflag; asm volatile("s_mov_b32 %0, 0" : "=s"(zflag));
  LAS char* K_lds = (LAS char*)lds + RK; LAS char* V_lds = (LAS char*)lds + RV;
  LAS float* wsf = (LAS float*)(lds + OFF_WS) + wid * 64; LAS float* li_l = wsf; LAS float* al_l = wsf + 32;
  const LAS float* tab = (const LAS float*)(lds + OFF_TAB) + h * TAB_N;
  float mhat = 0.f; f32x16 o[4] = {}; f32x4 osum = {}; f32x16 negm = {}; bf16x8 qr[4];
  const bf16* Qw = Qrow0 + (size_t)(rb * 32 + r32) * 3328 + g * 64 + hi * 8;
#pragma unroll
  for (int d0 = 0; d0 < 4; ++d0) qr[d0] = *reinterpret_cast<const bf16x8*>(Qw + d0 * 16);
  const int qpos = qpos0 + rb * 32 + r32;
  unsigned kso0, kso1, vso0;
  { const int row = 8 * wid + (lane >> 4); kso0 = (unsigned)(row * LDK * 2 + (((lane & 15) ^ (row & 7)) << 4)); kso1 = kso0 + (unsigned)(4 * LDK * 2) + ((kso0 & 64u) ? (unsigned)-64 : 64u);
    const int kk = wid * 8 + ((lane & 31) >> 2), k = kk, c = (lane >> 5) * 32 + (lane & 3) * 8; vso0 = (unsigned)((k * LDK + c) * 2); }
  const int pw = wid * 2048; const unsigned kl0 = (unsigned)(uintptr_t)K_lds, vl0 = (unsigned)(uintptr_t)V_lds;
  const unsigned kso1m = kso1 - 1024u, vsoA = vso0 + 1024u, vsoB = vso0 + 128u;
#define DMA_K(t, so) do { const char* kb_ = (const char*)(Kg + (size_t)(t) * 64 * LDK); \
    glds16_pair(kb_, kso0, kso1m, (unsigned)__builtin_amdgcn_readfirstlane((int)(kl0 + (unsigned)((so) + pw)))); } while (0)
#define DMA_V(t, so) do { const char* vb_ = (const char*)(Vg + (size_t)(t) * 64 * LDK) - 1024; \
    glds16_pair(vb_, vsoA, vsoB, (unsigned)__builtin_amdgcn_readfirstlane((int)(vl0 + (unsigned)((so) + pw)))); } while (0)
#define WAITBAR(j) do { if ((j) + 2 < NT) asm volatile("s_waitcnt vmcnt(4)\n\ts_barrier" ::: "memory"); else asm volatile("s_waitcnt vmcnt(0)\n\ts_barrier" ::: "memory"); } while (0)
#define RESC(a) do { if (__any((a) < 1.f)) { if (hi == 0) al_l[r32] = (a); asm volatile("s_waitcnt lgkmcnt(0)" ::: "memory"); \
    _Pragma("unroll") for (int d = 0; d < 4; ++d) _Pragma("unroll") for (int r = 0; r < 16; ++r) o[d][r] *= al_l[crow(r, hi)]; \
    _Pragma("unroll") for (int r = 0; r < 4; ++r) osum[r] *= al_l[4 * (lane >> 4) + r + 16 * (lane & 1)]; } } while (0)
#define QKT(P0, P1, Ks) do { const LAS char* ks_ = (Ks); \
    _Pragma("unroll") for (int d0 = 0; d0 < 4; ++d0) { const int cb = ((g * 4 + d0) * 16 + hi * 8) * 2; \
      const bf16x8 b0 = *(const LAS bf16x8*)(ks_ + KSWZ(r32, cb)); const bf16x8 b1 = *(const LAS bf16x8*)(ks_ + KSWZ(32 + r32, cb)); \
      if (d0 == 0) { P0 = __builtin_amdgcn_mfma_f32_32x32x16_bf16(b0, qr[0], negm, 0, 0, 0); P1 = __builtin_amdgcn_mfma_f32_32x32x16_bf16(b1, qr[0], negm, 0, 0, 0); } \
      else { P0 = __builtin_amdgcn_mfma_f32_32x32x16_bf16(b0, qr[d0], P0, 0, 0, 0); P1 = __builtin_amdgcn_mfma_f32_32x32x16_bf16(b1, qr[d0], P1, 0, 0, 0); } } } while (0)
#define KFR(d0, half) (*(const LAS bf16x8*)(ks_ + KSWZ(32 * (half) + r32, ((g * 4 + (d0)) * 16 + hi * 8) * 2)))
#define KPRE(Ks) const LAS char* ks_ = (Ks); const bf16x8 k00_ = KFR(0, 0), k01_ = KFR(0, 1), k10_ = KFR(1, 0), k11_ = KFR(1, 1)
#define QKT2(P0, P1) do { P0 = __builtin_amdgcn_mfma_f32_32x32x16_bf16(k00_, qr[0], negm, 0, 0, 0); P1 = __builtin_amdgcn_mfma_f32_32x32x16_bf16(k01_, qr[0], negm, 0, 0, 0); \
    const bf16x8 k20_ = KFR(2, 0), k21_ = KFR(2, 1), k30_ = KFR(3, 0), k31_ = KFR(3, 1); SBAR(); \
    P0 = __builtin_amdgcn_mfma_f32_32x32x16_bf16(k10_, qr[1], P0, 0, 0, 0); P1 = __builtin_amdgcn_mfma_f32_32x32x16_bf16(k11_, qr[1], P1, 0, 0, 0); SBAR(); \
    P0 = __builtin_amdgcn_mfma_f32_32x32x16_bf16(k20_, qr[2], P0, 0, 0, 0); P1 = __builtin_amdgcn_mfma_f32_32x32x16_bf16(k21_, qr[2], P1, 0, 0, 0); \
    P0 = __builtin_amdgcn_mfma_f32_32x32x16_bf16(k30_, qr[3], P0, 0, 0, 0); P1 = __builtin_amdgcn_mfma_f32_32x32x16_bf16(k31_, qr[3], P1, 0, 0, 0); SBAR(); } while (0)
#define PARTIAL(P0, P1, AL, FIRST, RMV) do { const float rm_ = (RMV); AL = 1.f; \
    if ((FIRST) || (SAFE ? __any(rm_ > THRL) : (zflag != 0))) { asm volatile("; reference moves" ::: "memory"); \
      const float nm_ = mhat + ((FIRST) ? rm_ : fmaxf(rm_, 0.f)); const float dl_ = nm_ - mhat; mhat = nm_; \
      _Pragma("unroll") for (int r = 0; r < 16; ++r) { P0[r] -= dl_; P1[r] -= dl_; } \
      _Pragma("unroll") for (int r = 0; r < 16; ++r) negm[r] -= dl_; \
      if (!(FIRST)) { AL = __builtin_amdgcn_exp2f(-dl_); } } \
    _Pragma("unroll") for (int r = 0; r < 16; ++r) { PROBE_XEXP(P0[r]); PROBE_XEXP(P1[r]); P0[r] = __builtin_amdgcn_exp2f(P0[r]); } } while (0)
#define PK4_(P, BASE, OUT) do { u32x4 w = {cvtpk(P[BASE + 0], P[BASE + 1]), cvtpk(P[BASE + 2], P[BASE + 3]), cvtpk(P[BASE + 4], P[BASE + 5]), cvtpk(P[BASE + 6], P[BASE + 7])}; \
    OUT = __builtin_bit_cast(bf16x8, w); } while (0)
#define BIASMASK(P0, P1, j) do { if ((j) >= NT - 4) { const bool msk_ = ((j) == NT - 1 && rb < 2); \
    if (msk_) { _Pragma("unroll") for (int r = 0; r < 16; ++r) { P0[r] = -1e30f; P1[r] = -1e30f; } } \
    else { const int base_ = 64 * (j) - qpos + 255 + 4 * hi; \
      _Pragma("unroll") for (int r = 0; r < 16; ++r) { const int i0_ = base_ + (r & 3) + 8 * (r >> 2); P0[r] += tab[i0_]; P1[r] += tab[i0_ + 32]; } } } } while (0)
#define ROT() do { const int t_ = s0; s0 = s1; s1 = s2; s2 = t_; } while (0)
  const LAS char* vrd = V_lds + v_rd_base(lane);
#define ONESMMA(pa) osum = __builtin_amdgcn_mfma_f32_16x16x32_bf16(pa, ones, osum, 0, 0, 0)
#define FINISH_PV(P0, P1, vp, C0, C1, RM) do { const LAS char* vp_ = (vp); VF fa_, fb_; \
    vf_load<0>(fa_, vp_); \
    _Pragma("unroll") for (int r = 0; r < 16; ++r) P1[r] = __builtin_amdgcn_exp2f(P1[r]); \
    bf16x8 pa_; PK4_(P0, 0, pa_); vf_load<1>(fb_, vp_); vf_mma(o, fa_, pa_); ONESMMA(pa_); \
    PK4_(P0, 8, pa_); vf_load<2>(fa_, vp_); vf_mma(o, fb_, pa_); ONESMMA(pa_); \
    if (SAFE) RM = rowmax32(C0, C1); \
    PK4_(P1, 0, pa_); vf_load<3>(fb_, vp_); vf_mma(o, fa_, pa_); ONESMMA(pa_); \
    PK4_(P1, 8, pa_); vf_mma(o, fb_, pa_); ONESMMA(pa_); } while (0)
  const short one_ = (((lane >> 4) & 1) == (lane & 1)) ? (short)16256 : (short)0;
  const bf16x8 ones = {one_, one_, one_, one_, one_, one_, one_, one_};
  f32x16 pA0, pA1, pB0, pB1; float alA = 1.f, alB = 1.f, rmx;
  int s0 = 2 * SHM_K, s1 = 0, s2 = SHM_K;
  if (wid >= 4) __builtin_amdgcn_s_setprio(1);
#define VS(t) (((t) & 3) * SHM_V)
  DMA_K(0, 0); DMA_V(0, VS(0)); DMA_K(1, SHM_K); DMA_V(1, VS(1));
  asm volatile("" :: "v"(qr[0]), "v"(qr[1]), "v"(qr[2]), "v"(qr[3]) : "memory");
#ifdef ATT_SKEW
#define WB1(j) do { if ((j) + 2 < NT) asm volatile("s_waitcnt vmcnt(6)\n\ts_barrier" ::: "memory"); else asm volatile("s_waitcnt vmcnt(0)\n\ts_barrier" ::: "memory"); } while (0)
#define WB2(j) do { if ((j) + 2 < NT) asm volatile("s_waitcnt vmcnt(4)\n\ts_barrier" ::: "memory"); else asm volatile("s_waitcnt vmcnt(0)\n\ts_barrier" ::: "memory"); } while (0)
  const int ph = wid >> 2;
  if (ph != 0) { asm volatile("s_waitcnt vmcnt(6)\n\ts_barrier" ::: "memory"); }
  WB1(0); DMA_K(2, s0);
  QKT(pA0, pA1, K_lds + s1);
  WB2(0); DMA_V(2, VS(2));
  BIASMASK(pA0, pA1, 0); rmx = rowmax32(pA0, pA1); PARTIAL(pA0, pA1, alA, true, rmx);
  ROT();
#else
  WAITBAR(0); DMA_K(2, s0); DMA_V(2, VS(2));
  QKT(pA0, pA1, K_lds + s1); BIASMASK(pA0, pA1, 0); rmx = rowmax32(pA0, pA1); PARTIAL(pA0, pA1, alA, true, rmx);
  ROT();
#endif
#ifdef ATT_SKEW
#define HALFSTEP(C0, C1, Q0, Q1, ALC, jj, BAND) do { \
    if (BAND) { WB1(jj); } else { asm volatile("s_waitcnt vmcnt(6)\n\ts_barrier" ::: "memory"); } \
    KPRE(K_lds + s1); SBAR(); \
    if (!(BAND) || (jj) + 2 < NT) { DMA_K((jj) + 2, s0); } \
    SBAR(); QKT2(C0, C1); SBAR(); \
    if (BAND) { WB2(jj); } else { asm volatile("s_waitcnt vmcnt(4)\n\ts_barrier" ::: "memory"); } \
    if (!(BAND) || (jj) + 2 < NT) { DMA_V((jj) + 2, VS((jj) + 2)); } \
    if (BAND) { BIASMASK(C0, C1, jj); } \
    FINISH_PV(Q0, Q1, vrd + VS((jj) - 1), C0, C1, rmx); \
    PARTIAL(C0, C1, ALC, false, rmx); RESC(ALC); ROT(); } while (0)
#else
#define HALFSTEP(C0, C1, Q0, Q1, ALC, jj, BAND) do { \
    if (BAND) { WAITBAR(jj); } else { asm volatile("s_waitcnt vmcnt(4)\n\ts_barrier" ::: "memory"); } \
    KPRE(K_lds + s1); SBAR(); \
    if (BAND) { if ((jj) + 2 < NT) { DMA_K((jj) + 2, s0); DMA_V((jj) + 2, VS((jj) + 2)); } } \
    else { DMA_K((jj) + 2, s0); DMA_V((jj) + 2, VS((jj) + 2)); } \
    SBAR(); QKT2(C0, C1); PROBE_XBAR; \
    if (BAND) { BIASMASK(C0, C1, jj); } \
    FINISH_PV(Q0, Q1, vrd + VS((jj) - 1), C0, C1, rmx); \
    PARTIAL(C0, C1, ALC, false, rmx); RESC(ALC); ROT(); } while (0)
#endif
  int j = 1;
  for (; j + 1 < NT - 4; j += 2) { HALFSTEP(pB0, pB1, pA0, pA1, alB, j, false); HALFSTEP(pA0, pA1, pB0, pB1, alA, j + 1, false); }
  for (; j + 1 < NT; j += 2) { HALFSTEP(pB0, pB1, pA0, pA1, alB, j, true); HALFSTEP(pA0, pA1, pB0, pB1, alA, j + 1, true); }
#undef HALFSTEP
#ifdef ATT_SKEW
  WB1(NT - 1);
  QKT(pB0, pB1, K_lds + s1);
  WB2(NT - 1); BIASMASK(pB0, pB1, NT - 1);
#else
  WAITBAR(NT - 1);
  QKT(pB0, pB1, K_lds + s1); BIASMASK(pB0, pB1, NT - 1);
#endif
  FINISH_PV(pA0, pA1, vrd + VS(NT - 2), pB0, pB1, rmx); PARTIAL(pB0, pB1, alB, false, rmx); RESC(alB);
  FINISH_PV(pB0, pB1, vrd + VS(NT - 1), pB0, pB1, rmx);
#ifdef ATT_SKEW
  if (ph == 0) { asm volatile("s_barrier" ::: "memory"); }
#undef WB1
#undef WB2
#endif
#undef DMA_K
#undef DMA_V
#undef WAITBAR
#undef RESC
#undef BIASMASK
#undef ROT
#undef VS
#undef QKT
#undef QKT2
#undef KPRE
#undef KFR
#undef PARTIAL
#undef FINISH_PV
#undef ONESMMA
#undef PK4_
  __builtin_amdgcn_s_setprio(0);
  float rli[16];
  if ((lane & 15) < 2) {
#pragma unroll
    for (int r = 0; r < 4; ++r) li_l[4 * (lane >> 4) + r + 16 * (lane & 15)] = osum[r]; }
#pragma unroll
  for (int r = 0; r < 16; ++r) rli[r] = __builtin_amdgcn_rcpf(li_l[crow(r, hi)]);
  bool bad = false;
  if (!SAFE) {
#pragma unroll
    for (int r = 0; r < 4; ++r) bad |= !(osum[r] < 3e38f); }
  __syncthreads();
  LAS float* X = (LAS float*)lds + rb * 4096 + lane;
  if (g == 1) {
#pragma unroll
    for (int r = 0; r < 16; ++r)
#pragma unroll
      for (int d0 = 0; d0 < 4; ++d0) X[(r * 4 + d0) * 64] = o[d0][r] * rli[r];
  }
  __syncthreads();
  if (g == 0) {
    const float lam = ((const LAS float*)(lds + OFF_LAM))[0], osc = ((const LAS float*)(lds + OFF_LAM))[1];
    float ss[16];
#pragma unroll
    for (int r = 0; r < 16; ++r) { float s = 0.f;
#pragma unroll
      for (int d0 = 0; d0 < 4; ++d0) { const float od = o[d0][r] * rli[r] - lam * X[(r * 4 + d0) * 64]; o[d0][r] = od; s += od * od; }
      ss[r] = s; if (!SAFE) bad |= !(s < 3e38f); }
#pragma unroll
    for (int r = 0; r < 16; ++r) { float s = ss[r]; s += __shfl_xor(s, 1); s += __shfl_xor(s, 2); s += __shfl_xor(s, 4); s += __shfl_xor(s, 8); s += __shfl_xor(s, 16);
      ss[r] = osc * __builtin_amdgcn_rsqf(s * (1.f / 128.f) + RMS_EPS); }
    float gn[4];
#pragma unroll
    for (int d0 = 0; d0 < 4; ++d0) gn[d0] = gnorm[d0 * 32 + r32];
    bf16* Ow = Orow0 + (size_t)(rb * 32) * 1024 + r32;
#pragma unroll
    for (int r = 0; r < 16; ++r) { const int orow = crow(r, hi);
#pragma unroll
      for (int d0 = 0; d0 < 4; ++d0) Ow[(size_t)orow * 1024 + d0 * 32] = (bf16)(cvtpk(o[d0][r] * ss[r] * gn[d0], 0.f) & 0xffffu); }
  }
  if (!SAFE) { if (__any(bad)) { if (lane == 0) *badflag = 1; } }
  __syncthreads();
#ifdef PROBE_FORCE_FALLBACK
  if (!SAFE) return (__builtin_amdgcn_readfirstlane(*badflag) != 0) || (h == 1) || ((NT & 6) == 2);
#endif
  if (!SAFE) return __builtin_amdgcn_readfirstlane(*badflag) != 0;
  return false;
}

__device__ __forceinline__ void attn_unit_sample(LAS unsigned char* lds, const float* Kg, const float* Vg, const float* Kl, const float* Vl, const bf16* Qrow0, bf16* Orow0,
                                                 int qpos0, int h, const float* gnorm) {
  using St = Stage<true>; constexpr int LDK = 512, NT = 65;
  const int tid = fresh_tid(), wid = __builtin_amdgcn_readfirstlane(tid >> 6), lane = tid & 63, r32 = lane & 31, hi = lane >> 5;
  const int g = wid & 1, rb = (wid >> 1) & 1; const bool live = wid < 4;
  LAS char* V_lds = (LAS char*)lds + OFF_V; LAS char* K_lds = (LAS char*)lds + OFF_K;
  LAS float* wsf = (LAS float*)(lds + OFF_WS) + wid * 64; LAS float* li_l = wsf; LAS float* al_l = wsf + 32;
  const LAS float* tab = (const LAS float*)(lds + OFF_TAB) + h * TAB_N;
  float l_reg = 0; f32x16 o[4] = {};
#define BARRIER1() asm volatile("s_waitcnt lgkmcnt(0)\n\ts_barrier" ::: "memory")
  if (!live) {
    const int lt = tid - 256, sr = lt >> 4, sc = (lt & 15) * 8;
    typename St::T A[8], B[8], C[8];
#define LLOAD(X, t) do { const float* kb_ = (t) < 64 ? Kg + (size_t)(t) * 64 * LDK : Kl; const float* vb_ = (t) < 64 ? Vg + (size_t)(t) * 64 * LDK : Vl; \
      _Pragma("unroll") for (int i_ = 0; i_ < 4; ++i_) { X[i_] = St::ld8(vb_ + (size_t)(sr + 16 * i_) * LDK + sc); X[4 + i_] = St::ld8(kb_ + (size_t)(sr + 16 * i_) * LDK + sc); } } while (0)
#define LWRITE(X, b) do { _Pragma("unroll") for (int i_ = 0; i_ < 4; ++i_) { *(LAS bf16x8*)(V_lds + (b) * SHM_V + v_st(sr + 16 * i_, sc)) = St::tobf(X[i_]); \
      *(LAS bf16x8*)(K_lds + (b) * SHM_K + KSWZ(sr + 16 * i_, sc * 2)) = St::tobf(X[4 + i_]); } } while (0)
#define LSTEP(t, Xfree, Xnext, nb) do { const int t_ = (t); \
      if (t_ + 3 < NT) LLOAD(Xfree, t_ + 3); \
      if (t_ + 1 < NT) { if (t_ + 3 < NT) asm volatile("s_waitcnt vmcnt(32)" ::: "memory"); else if (t_ + 2 < NT) asm volatile("s_waitcnt vmcnt(16)" ::: "memory"); else asm volatile("s_waitcnt vmcnt(0)" ::: "memory"); \
        LWRITE(Xnext, nb); } \
      BARRIER1(); } while (0)
    LLOAD(A, 0); LLOAD(B, 1); LLOAD(C, 2);
    asm volatile("s_waitcnt vmcnt(32)" ::: "memory"); LWRITE(A, 0); BARRIER1();
    for (int t = 0; t < NT; t += 6) {
      LSTEP(t, A, B, 1);     if (t + 1 >= NT) break;
      LSTEP(t + 1, B, C, 0); if (t + 2 >= NT) break;
      LSTEP(t + 2, C, A, 1); if (t + 3 >= NT) break;
      LSTEP(t + 3, A, B, 0); if (t + 4 >= NT) break;
      LSTEP(t + 4, B, C, 1); if (t + 5 >= NT) break;
      LSTEP(t + 5, C, A, 0);
    }
#undef LSTEP
#undef LLOAD
#undef LWRITE
  } else {
    float m_reg = -1e30f; bf16x8 qr[4];
    const bf16* Qw = Qrow0 + (size_t)(rb * 32 + r32) * 3328 + g * 64 + hi * 8;
#pragma unroll
    for (int d0 = 0; d0 < 4; ++d0) qr[d0] = *reinterpret_cast<const bf16x8*>(Qw + d0 * 16);
    const int qpos = qpos0 + rb * 32 + r32;
    const LAS char* vb0 = V_lds + v_rd_base(lane);
    BARRIER1();
    for (int j = 0; j < NT; ++j) { const int bsel = j & 1;
      f32x16 p0, p1; float mn, al; bf16x8 pa0, pa1, pa2, pa3;
      qkt<false>(p0, p1, K_lds + bsel * SHM_K, qr, nullptr, r32, hi, g);
      if (j >= NT - 3) { const int base_ = 64 * j - qpos + 255 + 4 * hi;
#pragma unroll
        for (int r = 0; r < 16; ++r) { const int i0_ = base_ + (r & 3) + 8 * (r >> 2); p0[r] += tab[i0_]; p1[r] += tab[i0_ + 32]; } }
      partialSM(p0, p1, m_reg, mn, al);
      if (__any(al < 1.f)) { if (hi == 0) al_l[r32] = al; asm volatile("s_waitcnt lgkmcnt(0)" ::: "memory");
#pragma unroll
        for (int d = 0; d < 4; ++d)
#pragma unroll
          for (int r = 0; r < 16; ++r) o[d][r] *= al_l[crow(r, hi)]; }
      finishSM(p0, p1, al, l_reg, pa0, pa1, pa2, pa3);
      pv_d0(o, vb0 + bsel * SHM_V, pa0, pa1, pa2, pa3);
      BARRIER1(); }
  }
#undef BARRIER1
  __syncthreads();
  if (hi == 0) li_l[r32] = l_reg;
  asm volatile("s_waitcnt lgkmcnt(0)" ::: "memory");
  float rli[16];
#pragma unroll
  for (int r = 0; r < 16; ++r) rli[r] = __builtin_amdgcn_rcpf(li_l[crow(r, hi)]);
  LAS float* X = (LAS float*)lds + rb * 4096 + lane;
  if (live && g == 1) {
#pragma unroll
    for (int r = 0; r < 16; ++r)
#pragma unroll
      for (int d0 = 0; d0 < 4; ++d0) X[(r * 4 + d0) * 64] = o[d0][r] * rli[r];
  }
  __syncthreads();
  if (live && g == 0) {
    const float lam = ((const LAS float*)(lds + OFF_LAM))[0], osc = ((const LAS float*)(lds + OFF_LAM))[1];
    float ss[16];
#pragma unroll
    for (int r = 0; r < 16; ++r) { float s = 0.f;
#pragma unroll
      for (int d0 = 0; d0 < 4; ++d0) { const float od = o[d0][r] * rli[r] - lam * X[(r * 4 + d0) * 64]; o[d0][r] = od; s += od * od; }
      ss[r] = s; }
#pragma unroll
    for (int r = 0; r < 16; ++r) { float s = ss[r]; s += __shfl_xor(s, 1); s += __shfl_xor(s, 2); s += __shfl_xor(s, 4); s += __shfl_xor(s, 8); s += __shfl_xor(s, 16);
      ss[r] = osc * __builtin_amdgcn_rsqf(s * (1.f / 128.f) + RMS_EPS); }
    float gn[4];
#pragma unroll
    for (int d0 = 0; d0 < 4; ++d0) gn[d0] = gnorm[d0 * 32 + r32];
    bf16* Ow = Orow0 + (size_t)(rb * 32) * 1024 + r32;
#pragma unroll
    for (int r = 0; r < 16; ++r) { const int orow = crow(r, hi);
#pragma unroll
      for (int d0 = 0; d0 < 4; ++d0) Ow[(size_t)orow * 1024 + d0 * 32] = (bf16)(cvtpk(o[d0][r] * ss[r] * gn[d0], 0.f) & 0xffffu); }
  }
  __syncthreads();
}
#undef KSWZ
#undef SBAR
}

namespace gla {
constexpr int P72 = 72;
constexpr int L_TOT = 0, L_DL = 2048, L_QT = 4096, L_KT = L_QT + 64 * P72 * 2, L_KDT = L_KT + 64 * P72 * 2, L_A = L_KDT + 64 * P72 * 2, L_VT = L_A + 64 * P72 * 2, L_END = L_VT + 128 * P72 * 2;
static_assert(L_END <= RING_BYTES, "gla LDS map");
__device__ __forceinline__ int crow(int r, int hi) { return (r & 3) + 8 * (r >> 2) + 4 * hi; }
typedef float cvf2_t __attribute__((ext_vector_type(2)));
typedef __bf16 cvb2_t __attribute__((ext_vector_type(2)));
__device__ __forceinline__ unsigned cvt2(float lo, float hi) { const cvf2_t v = {lo, hi}; return __builtin_bit_cast(unsigned, __builtin_convertvector(v, cvb2_t)); }
__device__ __forceinline__ v4u pair16(v2u a, v2u b) {
  const auto r0 = __builtin_amdgcn_permlane32_swap(a.x, b.x, false, false); const auto r1 = __builtin_amdgcn_permlane32_swap(a.y, b.y, false, false);
  return (v4u){r0[0], r1[0], r0[1], r1[1]}; }
__device__ __forceinline__ float fexp(float x) { return __builtin_amdgcn_exp2f(x * 1.4426950408889634f); }
__device__ __forceinline__ float logsig(float z) { return fminf(z, 0.f) - 0.6931471805599453f * __builtin_amdgcn_logf(1.f + __builtin_amdgcn_exp2f(-1.4426950408889634f * fabsf(z))); }
__device__ __forceinline__ bf16x8 ldsfrag(const LAS unsigned char* img, int row, int k0) { return *(const LAS bf16x8*)(img + (row * P72 + k0) * 2); }

#define G1IN_DECL(p) float p##z[8]; unsigned p##qk[8]; bf16x8 p##v0, p##v1; float p##bal
#define G1IN_ARGS(p) p##z, p##qk, p##v0, p##v1, p##bal
__device__ __forceinline__ void g1_load(float (&z)[8], unsigned (&qk)[8], bf16x8& v0, bf16x8& v1, float& bal, int c, int h, const bf16* ACT, const float* LOGA, const float* balpha) {
    const int tid = fresh_tid(), lane = tid & 63, t0 = 8 * (tid >> 6), row0 = 64 * c;
    bal = balpha[h * 64 + lane];
#pragma unroll
    for (int i = 0; i < 8; ++i) z[i] = LOGA[(size_t)(row0 + t0 + i) * 256 + h * 64 + lane];
#pragma unroll
    for (int i = 0; i < 8; ++i) qk[i] = *(const unsigned*)(ACT + (size_t)(row0 + t0 + i) * NIN + 2 * (h * 64 + lane));
    { const int s = lane, jc = (tid >> 6) * 8; v0 = *(const bf16x8*)(ACT + (size_t)(row0 + s) * NIN + 768 + h * 128 + jc); v1 = *(const bf16x8*)(ACT + (size_t)(row0 + s) * NIN + 768 + h * 128 + 64 + jc); }
}
template <bool PF>
__device__ __forceinline__ void g1_unit(LAS unsigned char* lds, const float (&inz)[8], const unsigned (&inqk)[8], const bf16x8& inv0, const bf16x8& inv1, const float& inbal, int c, int h, int layer,
                                        bf16* UT, float* Dw, bf16* OI, bf16* QT, bf16* SCT, const float* state_in  , float* state_out  ,
                                        float (&nz)[8], unsigned (&nqk)[8], bf16x8& nv0, bf16x8& nv1, float& nbal, int cn, int hn, const bf16* ACT, const float* LOGA, const float* balpha) {
    const int tid = fresh_tid(), wid = __builtin_amdgcn_readfirstlane(tid >> 6), lane = tid & 63, r = lane & 31, hh = lane >> 5;
    const int row0 = 64 * c;
    LAS float* TOT = (LAS float*)(lds + L_TOT); LAS float* DL = (LAS float*)(lds + L_DL);
    LAS unsigned char* Qi = lds + L_QT; LAS unsigned char* Ki = lds + L_KT; LAS unsigned char* KDi = lds + L_KDT; LAS unsigned char* Ai = lds + L_A; LAS unsigned char* Vi = lds + L_VT;
    { const int d = lane, tg = wid, t0 = 8 * tg;
      const float bal = inbal;
      float cs[8]; float run = 0.f;
#pragma unroll
      for (int i = 0; i < 8; ++i) { const float z = inz[i] + bal; run += logsig(z) * 0.0625f; cs[i] = run; }
      float qv[8], kv[8];
#pragma unroll
      for (int i = 0; i < 8; ++i) { qv[i] = bf2f((unsigned short)(inqk[i] & 0xffffu)); kv[i] = bf2f((unsigned short)(inqk[i] >> 16)); }
      TOT[tg * 64 + d] = run;
#pragma unroll
      for (int k = 0; k < 2; ++k) { const int s = lane, jc = wid * 8 + 64 * k;
        const bf16x8 v = k ? inv1 : inv0;
#pragma unroll
        for (int e = 0; e < 8; ++e) *(LAS short*)(Vi + ((jc + e) * P72 + s) * 2) = v[e]; }
      __syncthreads();
      if constexpr (PF) g1_load(nz, nqk, nv0, nv1, nbal, cn, hn, ACT, LOGA, balpha);
      float off = 0.f, blast = 0.f;
#pragma unroll
      for (int g2 = 0; g2 < 8; ++g2) { const float tv = TOT[g2 * 64 + d]; blast += tv; if (g2 < tg) off += tv; }
      unsigned kd[4];
      float kdf[8];
#pragma unroll
      for (int i = 0; i < 8; ++i) { const float b = off + cs[i]; const float eb = fexp(b);
        const float qt = qv[i] * 0.125f * eb, kt = kv[i] * fexp(-b); kdf[i] = kv[i] * fexp(blast - b);
        const unsigned qk2_ = cvt2(qt, kt); const unsigned short qb = (unsigned short)(qk2_ & 0xffffu);
        *(LAS unsigned short*)(Qi + ((t0 + i) * P72 + d) * 2) = qb; *(LAS unsigned short*)(Ki + ((t0 + i) * P72 + d) * 2) = (unsigned short)(qk2_ >> 16);
        }
#pragma unroll
      for (int i = 0; i < 4; ++i) kd[i] = cvt2(kdf[2 * i], kdf[2 * i + 1]);
      *(LAS v4u*)(KDi + (d * P72 + t0) * 2) = (v4u){kd[0], kd[1], kd[2], kd[3]};
      if (tg == 0) { const float Dd = fexp(blast); DL[d] = Dd; Dw[(size_t)(c * 4 + h) * 64 + d] = Dd; }
    }
    __syncthreads();
    { const int tq = tid >> 3, cq = (tid & 7) * 8; *(bf16x8*)(QT + (size_t)(row0 + tq) * 256 + h * 64 + cq) = *(const LAS bf16x8*)(Qi + (tq * P72 + cq) * 2); }
    if (wid < 3) { const int sb = (wid == 2), tb = (wid >= 1); f32x16 acc = {};
#pragma unroll
      for (int kk = 0; kk < 4; ++kk) acc = __builtin_amdgcn_mfma_f32_32x32x16_bf16(ldsfrag(Ki, sb * 32 + r, kk * 16 + 8 * hh), ldsfrag(Qi, tb * 32 + r, kk * 16 + 8 * hh), acc, 0, 0, 0);
      const int t = tb * 32 + r;
#pragma unroll
      for (int q = 0; q < 4; ++q) { const int s0 = sb * 32 + 8 * q + 4 * hh; float v[4];
#pragma unroll
        for (int e = 0; e < 4; ++e) v[e] = (s0 + e <= t) ? acc[4 * q + e] : 0.f;
        *(LAS v2u*)(Ai + (t * P72 + s0) * 2) = (v2u){cvt2(v[0], v[1]), cvt2(v[2], v[3])}; }
    } else if (wid == 3) {
#pragma unroll
      for (int q = 0; q < 4; ++q) *(LAS v2u*)(Ai + (r * P72 + 32 + 8 * q + 4 * hh) * 2) = (v2u){0u, 0u};
    } else {
      const int jb = wid - 4, j = jb * 32 + r;
#pragma unroll
      for (int db = 0; db < 2; ++db) { f32x16 acc = {};
#pragma unroll
        for (int kk = 0; kk < 4; ++kk) acc = __builtin_amdgcn_mfma_f32_32x32x16_bf16(ldsfrag(KDi, db * 32 + r, kk * 16 + 8 * hh), ldsfrag(Vi, j, kk * 16 + 8 * hh), acc, 0, 0, 0);
        if (c < NPCH) {
#pragma unroll
          for (int q = 0; q < 4; q += 2) { const int d0 = db * 32 + 8 * q + 8 * hh;
            *(v4u*)(UT + ((size_t)(c * 4 + h) * 128 + j) * 64 + d0) = pair16((v2u){cvt2(acc[4 * q], acc[4 * q + 1]), cvt2(acc[4 * q + 2], acc[4 * q + 3])},
                                                                             (v2u){cvt2(acc[4 * q + 4], acc[4 * q + 5]), cvt2(acc[4 * q + 6], acc[4 * q + 7])}); }
        } else { const int b = c - NPCH; const size_t sbase = (size_t)(b * 4 + h) * 8192;
#pragma unroll
          for (int q = 0; q < 4; ++q) { const int d0 = db * 32 + 8 * q + 4 * hh; float si[4];
#pragma unroll
            for (int e = 0; e < 4; ++e) { si[e] = state_in[sbase + (size_t)(d0 + e) * 128 + j]; state_out[sbase + (size_t)(d0 + e) * 128 + j] = DL[d0 + e] * si[e] + acc[4 * q + e]; }
            *(v2u*)(SCT + ((size_t)(c * 4 + h) * 128 + j) * 64 + d0) = (v2u){cvt2(si[0], si[1]), cvt2(si[2], si[3])}; }
        }
      }
    }
    __syncthreads();
    { const int jb = wid >> 1, tb = wid & 1; f32x16 acc = {};
#pragma unroll
      for (int kk = 0; kk < 4; ++kk) acc = __builtin_amdgcn_mfma_f32_32x32x16_bf16(ldsfrag(Vi, jb * 32 + r, kk * 16 + 8 * hh), ldsfrag(Ai, tb * 32 + r, kk * 16 + 8 * hh), acc, 0, 0, 0);
      bf16* op = OI + (size_t)(row0 + tb * 32 + r) * 512 + h * 128 + jb * 32 + 8 * hh;
#pragma unroll
      for (int q = 0; q < 4; q += 2) *(v4u*)(op + 8 * q) = pair16((v2u){cvt2(acc[4 * q], acc[4 * q + 1]), cvt2(acc[4 * q + 2], acc[4 * q + 3])},
                                                                   (v2u){cvt2(acc[4 * q + 4], acc[4 * q + 5]), cvt2(acc[4 * q + 6], acc[4 * q + 7])}); }
    __syncthreads();
}

__device__ __forceinline__ void g2_group(LAS unsigned char* lds, int eg, const bf16* UT, const float* Dw, bf16* SCT, float* gout  ) {
    const int tid = fresh_tid(); const int el = tid & 127, seg = tid >> 7; const int e = eg * 128 + el; const int h = e >> 13, j = (e >> 6) & 127, d = e & 63;
    LAS float* PL = (LAS float*)lds;
    const size_t ustride = 4 * 128 * 64, dstride = 4 * 64;
    const bf16* up = UT + ((size_t)h * 128 + j) * 64 + d + (size_t)(64 * seg) * ustride; const float* dp = Dw + h * 64 + d + (size_t)(64 * seg) * dstride;
    float Dv[64]; unsigned short Ub[64];
#pragma unroll
    for (int cc = 0; cc < 64; ++cc) Dv[cc] = dp[(size_t)cc * dstride];
#pragma unroll
    for (int cc = 0; cc < 64; ++cc) Ub[cc] = up[(size_t)cc * ustride];
    float P = 1.f, L = 0.f;
#pragma unroll
    for (int cc = 0; cc < 64; ++cc) { L = fmaf(Dv[cc], L, bf2f(Ub[cc])); P *= Dv[cc]; }
    PL[(seg * 128 + el) * 2] = P; PL[(seg * 128 + el) * 2 + 1] = L;
    __syncthreads();
    float S = 0.f;
    for (int s2 = 0; s2 < seg; ++s2) S = fmaf(PL[(s2 * 128 + el) * 2], S, PL[(s2 * 128 + el) * 2 + 1]);
    bf16* sp = SCT + ((size_t)h * 128 + j) * 64 + d + (size_t)(64 * seg) * ustride;
#pragma unroll
    for (int cc = 0; cc < 64; ++cc) { sp[(size_t)cc * ustride] = (bf16)(cvt2(S, S) & 0xffffu); S = fmaf(Dv[cc], S, bf2f(Ub[cc])); }
    if (seg == 3) gout[((size_t)h * 64 + d) * 128 + j] = S;
    __syncthreads();
}

__device__ __forceinline__ void g3_unit(LAS float* part, int c, int h, const bf16* ACT, const bf16* OI, const bf16* QT, const bf16* SCT, const float* gnorm  , bf16* MIX) {
    const int tid = fresh_tid(), wid = __builtin_amdgcn_readfirstlane(tid >> 6), lane = tid & 63, r = lane & 31, hh = lane >> 5;
    const int jb = wid >> 1, tb = wid & 1; const int row = 64 * c + tb * 32 + r;
    f32x16 acc = {};
    const bf16* ap = SCT + ((size_t)(c * 4 + h) * 128 + jb * 32 + r) * 64 + 8 * hh; const bf16* bp = QT + (size_t)row * 256 + h * 64 + 8 * hh;
#pragma unroll
    for (int kk = 0; kk < 4; ++kk) acc = __builtin_amdgcn_mfma_f32_32x32x16_bf16(*(const bf16x8*)(ap + kk * 16), *(const bf16x8*)(bp + kk * 16), acc, 0, 0, 0);
    const int j0 = jb * 32 + 4 * hh;
    const bf16* oip = OI + (size_t)row * 512 + h * 128 + j0;
    const bf16* gp = ACT + (size_t)row * NIN + 1280 + h * 128 + j0;
    v2u ggv[4]; f32x4 gnv[4];
#pragma unroll
    for (int q = 0; q < 4; ++q) { ggv[q] = *(const v2u*)(gp + 8 * q); gnv[q] = *(const f32x4*)(gnorm + j0 + 8 * q); }
    float ss = 0.f;
#pragma unroll
    for (int q = 0; q < 4; ++q) { const v2u ow = *(const v2u*)(oip + 8 * q);
      const float oi[4] = {__builtin_bit_cast(float, ow.x << 16), __builtin_bit_cast(float, ow.x & 0xffff0000u), __builtin_bit_cast(float, ow.y << 16), __builtin_bit_cast(float, ow.y & 0xffff0000u)};
#pragma unroll
      for (int e = 0; e < 4; ++e) { acc[4 * q + e] += oi[e]; ss += acc[4 * q + e] * acc[4 * q + e]; } }
    ss += __shfl_xor(ss, 32);
    if (hh == 0) part[wid * 32 + r] = ss;
    __syncthreads();
    const float tot = part[tb * 32 + r] + part[(tb + 2) * 32 + r] + part[(tb + 4) * 32 + r] + part[(tb + 6) * 32 + r];
    const float rstd = __builtin_amdgcn_rsqf(tot * (1.f / 128.f) + RMS_EPS);
    bf16* mp = MIX + (size_t)row * 1024 + h * 128 + jb * 32 + 8 * hh;
    v2u yq[4];
#pragma unroll
    for (int q = 0; q < 4; ++q) { const v2u gg = ggv[q]; const f32x4 gn = gnv[q];
      float gv[4] = {bf2f((unsigned short)(gg.x & 0xffffu)), bf2f((unsigned short)(gg.x >> 16)), bf2f((unsigned short)(gg.y & 0xffffu)), bf2f((unsigned short)(gg.y >> 16))}; float y[4];
#pragma unroll
      for (int e = 0; e < 4; ++e) { const float sg = gv[e] * __builtin_amdgcn_rcpf(1.f + fexp(-gv[e])); y[e] = acc[4 * q + e] * rstd * gn[e] * sg; }
      yq[q] = (v2u){cvt2(y[0], y[1]), cvt2(y[2], y[3])}; }
#pragma unroll
    for (int q = 0; q < 4; q += 2) *(v4u*)(mp + 8 * q) = pair16(yq[q], yq[q + 1]);
    __syncthreads();
}
}

namespace mini {
__device__ __forceinline__ int crow(int r, int hi) { return (r & 3) + 8 * (r >> 2) + 4 * hi; }
template <int K>
__device__ __forceinline__ void piece(LAS unsigned char* lds, int p, const bf16* A  , const bf16* Bt, bf16* xb  , float* rowsq  ) {
    const int tid = fresh_tid(), wid = __builtin_amdgcn_readfirstlane(tid >> 6), lane = tid & 63, r = lane & 31, hh = lane >> 5;
    const int r0 = (p >> 4) * 64, c0 = (p & 15) * 64;
    constexpr int KW = K / 8, NS = KW / 16;
    static_assert(KW % 16 == 0, "K / 8 must be a multiple of 16");
    const bf16* ap = A + (size_t)(r0 + r) * K + wid * KW + 8 * hh; const bf16* bp = Bt + (size_t)(c0 + r) * K + wid * KW + 8 * hh;
    f32x16 acc[2][2] = {};
    constexpr int U = (NS % 11 == 0) ? 11 : 8;
    static_assert(NS % U == 0, "batching");
    for (int kb = 0; kb < NS; kb += U) {
        bf16x8 a0[U], a1[U], b0[U], b1[U];
#pragma unroll
        for (int u = 0; u < U; ++u) { a0[u] = *(const bf16x8*)(ap + (kb + u) * 16); a1[u] = *(const bf16x8*)(ap + (size_t)32 * K + (kb + u) * 16);
                                      b0[u] = *(const bf16x8*)(bp + (kb + u) * 16); b1[u] = *(const bf16x8*)(bp + (size_t)32 * K + (kb + u) * 16); }
#pragma unroll
        for (int u = 0; u < U; ++u) {
            acc[0][0] = __builtin_amdgcn_mfma_f32_32x32x16_bf16(a0[u], b0[u], acc[0][0], 0, 0, 0); acc[0][1] = __builtin_amdgcn_mfma_f32_32x32x16_bf16(a0[u], b1[u], acc[0][1], 0, 0, 0);
            acc[1][0] = __builtin_amdgcn_mfma_f32_32x32x16_bf16(a1[u], b0[u], acc[1][0], 0, 0, 0); acc[1][1] = __builtin_amdgcn_mfma_f32_32x32x16_bf16(a1[u], b1[u], acc[1][1], 0, 0, 0); }
    }
    LAS float* P = (LAS float*)lds;
#pragma unroll
    for (int i = 0; i < 2; ++i)
#pragma unroll
        for (int j = 0; j < 2; ++j)
#pragma unroll
            for (int q = 0; q < 16; ++q) P[(((wid * 2 + i) * 2 + j) * 16 + q) * 64 + lane] = acc[i][j][q];
    __syncthreads();
    float vv[8]; unsigned short xin[8];
#pragma unroll
    for (int q = 0; q < 8; ++q) { const int e = tid + 512 * q; const int ln = e & 63, reg = (e >> 6) & 15, j = (e >> 10) & 1, i = e >> 11;
        xin[q] = xb[(size_t)(r0 + 32 * i + crow(reg, ln >> 5)) * 1024 + c0 + 32 * j + (ln & 31)]; }
#pragma unroll
    for (int q = 0; q < 8; ++q) { const int e = tid + 512 * q;
        float s = 0.f;
#pragma unroll
        for (int w = 0; w < 8; ++w) s += P[w * 4096 + e];
        const int ln = e & 63, reg = (e >> 6) & 15, j = (e >> 10) & 1, i = e >> 11;
        const int row = r0 + 32 * i + crow(reg, ln >> 5), col = c0 + 32 * j + (ln & 31);
        const float v = bf2f(xin[q]) + s;
        xb[(size_t)row * 1024 + col] = (bf16)f2bf(v); vv[q] = v; }
#pragma unroll
    for (int q = 0; q < 8; ++q) { if (q & 2) continue;
        float sq = vv[q] * vv[q] + vv[q + 2] * vv[q + 2]; sq += __shfl_xor(sq, 1); sq += __shfl_xor(sq, 2); sq += __shfl_xor(sq, 4); sq += __shfl_xor(sq, 8); sq += __shfl_xor(sq, 16);
        const int e = tid + 512 * q, ln = e & 63, reg = (e >> 6) & 15, i = e >> 11; const int row = r0 + 32 * i + crow(reg, ln >> 5);
        if ((ln & 31) == 0) rowsq[(size_t)row * 16 + (p & 15)] = sq; }
    __syncthreads();
}
}

__global__ void __launch_bounds__(NWAVES * 64, 2) hymba_fwd(Args args) {
    extern __shared__ __attribute__((aligned(16))) unsigned char lds[];
    Frame F;
    F.lds = (LAS unsigned char*)lds;
    for (int u = threadIdx.x; u < (LDS_BYTES - LDSCTL_OFF) / 4; u += NWAVES * 64) ((LAS unsigned*)(F.lds + LDSCTL_OFF))[u] = 0u;
    __syncthreads();
    if (threadIdx.x == 0) { LAS unsigned long long* t = (LAS unsigned long long*)(F.lds + PTAB_OFF);
#pragma unroll
        for (int i = 0; i < 18; ++i) t[i] = (unsigned long long)args.in[i];
        t[18] = (unsigned long long)args.out; t[19] = (unsigned long long)args.ws; }
    __syncthreads();
#define CTL_ ((gu32*)(wsp(F) + WS_CTL))
    (void)xcd_barrier_post((unsigned*)(CTL_ + CW_BAR), (volatile LAS unsigned*)(F.lds + MISC_OFF) + 8);
#ifdef PROBE_DUP_BAR
#define GRID_BAR() do { XcdBarrier b_; b_.bar = (unsigned*)(CTL_ + CW_BAR); b_.x = xb_xcc_id(); b_.st = (volatile LAS unsigned*)(F.lds + MISC_OFF) + 8; xcd_barrier(b_); xcd_barrier(b_); } while (0)
#else
#define GRID_BAR() do { XcdBarrier b_; b_.bar = (unsigned*)(CTL_ + CW_BAR); b_.x = xb_xcc_id(); b_.st = (volatile LAS unsigned*)(F.lds + MISC_OFF) + 8; xcd_barrier(b_); } while (0)
#endif

#define CNT_SIGNAL(w, n) do { asm volatile("s_waitcnt vmcnt(0)" ::: "memory"); __syncthreads(); \
        if (threadIdx.x == 0) { __builtin_amdgcn_fence(__ATOMIC_RELEASE, "agent"); asm volatile("s_waitcnt vmcnt(0)" ::: "memory"); (void)xb_add((unsigned*)(w), (unsigned)(n)); } } while (0)
#define CNT_WAIT(w, target) do { if (threadIdx.x == 0) { unsigned* bar_ = (unsigned*)(CTL_ + CW_BAR); XB_SPIN(xb_ld((unsigned*)(w)) < (unsigned)(target), bar_); \
        __builtin_amdgcn_fence(__ATOMIC_ACQUIRE, "agent"); asm volatile("s_waitcnt vmcnt(0)" ::: "memory"); } __syncthreads(); } while (0)
#define WSB(off) (wsp(F) + (off))
#define X_ ((float*)WSB(WS_X))
#define XN_ ((bf16*)WSB(WS_XN))
#define ACT_ ((bf16*)WSB(WS_ACT))
#define MIX_ ((bf16*)WSB(WS_MIX))
#define HB_ ((bf16*)WSB(WS_H))
#define LOGA_ ((float*)WSB(WS_LOGA))

#ifndef SKIP_P0
    p0_items(F, 0, 1664, 0, grid_n());
#endif
    rows_to_bf16_sq(F, inp(F, 0), inp(F, 1), XN_, (float*)WSB(WS_RSQ));
    att::attn_setup_tab(F.lds, inp(F, 17));
    GRID_BAR();

    for (int l = 0; l < DEPTH; ++l) {
#define WL_ (WSB(WS_W) + (size_t)l * W_LAYER)
#define SRCP_ (l == 0 ? inp(F, 0) : (const float*)X_)
#define SRCS_ (l == 0 ? inp(F, 1) : (const float*)X_ + (size_t)SEQ * DM)
#ifndef SKIP_IN
        { pg8::Gemm g{XN_, (const bf16*)(WL_ + WO_IN), M, NIN, DM}; pg8::StaticOrder S; S.init(M, NIN, grid_n(), (int)blockIdx.x);
          rstd_prepass(F, S, (const float*)WSB(WS_RSQ) + (size_t)(2 * l) * M * 16);
#ifdef STAGGER_US
          if ((int)blockIdx.x >= (M / 256) * (NIN / 256) - 3 * grid_n()) { const unsigned long long t0_ = __builtin_amdgcn_s_memrealtime(); while (__builtin_amdgcn_s_memrealtime() - t0_ < (unsigned long long)(STAGGER_US * 100)) __builtin_amdgcn_s_sleep(32); }
#endif
          pg8::EpiIn E{wsp(F), outp(F), l, WS_ACT, WS_LOGA, (const LAS float*)(F.lds + RSTD_OFF)};
          pg8::gemm_phase<pg8::EpiIn, pg8::StaticOrder, true, true>(F.lds + RING_OFF, g, S, E);
#if defined(PROBE_DUP_GEMM) || defined(PROBE_DUP_IN)
          __syncthreads(); pg8::gemm_phase<pg8::EpiIn, pg8::StaticOrder, true, true>(F.lds + RING_OFF, g, S, E);
#endif
          { const int full = (M / 256) * (NIN / 256) - ((M / 256) * (NIN / 256) / grid_n()) * grid_n();
            const int i_lo = l * 6400 + 1664, i_hi = (l + 1 < DEPTH) ? (l + 1) * 6400 + 1664 : DEPTH * 6400;
            __syncthreads();
            int cu0_ = (full > 0 && full < grid_n()) ? full : 0; asm volatile("" : "+s"(cu0_));
            p0_items(F, i_lo, i_hi, cu0_, grid_n() - cu0_);
#ifdef PROBE_DUP_TAIL
            __syncthreads(); p0_items(F, i_lo, i_hi, cu0_, grid_n() - cu0_);
#endif
            }
        }
#endif
        GRID_BAR();
#ifndef SKIP_G1
#ifdef PROBE_DUP_G1
        for (int rep1_ = 0; rep1_ < 5; ++rep1_)
#endif
        { G1IN_DECL(gA); G1IN_DECL(gB); const int G_ = grid_n(); int u = blockIdx.x; constexpr int NU = NPCH * 4;
#define G1_LOAD(gx, uu) gla::g1_load(G1IN_ARGS(gx), (uu) >> 2, (uu) & 3, ACT_, LOGA_, inp(F, 7) + (size_t)l * 256)
#define G1_RUN(gx, uu, gn, un) gla::g1_unit<true>(F.lds + RING_OFF, G1IN_ARGS(gx), (uu) >> 2, (uu) & 3, l, (bf16*)WSB(WS_U), (float*)WSB(WS_D), (bf16*)WSB(WS_OI), (bf16*)WSB(WS_QT), (bf16*)WSB(WS_SC), \
                         inp(F, 4) + (size_t)l * DECB * 4 * 8192, outp(F) + OG_S + (size_t)l * DECB * 4 * 8192, \
                         G1IN_ARGS(gn), (un) >> 2, (un) & 3, ACT_, LOGA_, inp(F, 7) + (size_t)l * 256)
#define CLAMPU(x) ((x) < NU ? (x) : NU - 1)
          G1_LOAD(gA, CLAMPU(u));
          for (; u < NU; u += 2 * G_) {
            G1_RUN(gA, u, gB, CLAMPU(u + G_));
            if (u + G_ < NU) { G1_RUN(gB, u + G_, gA, CLAMPU(u + 2 * G_)); } }
#undef CLAMPU
#undef G1_LOAD
#undef G1_RUN
        }
#endif
        GRID_BAR();
#ifdef PROBE_DUP_GLA
        for (int rep_ = 0; rep_ < 5; ++rep_)
#endif
        for (int eg = blockIdx.x; eg < 256; eg += grid_n())
#ifndef SKIP_G2
            gla::g2_group(F.lds + RING_OFF, eg, (const bf16*)WSB(WS_U), (const float*)WSB(WS_D), (bf16*)WSB(WS_SC), outp(F) + OG_P + (size_t)l * 4 * 8192);
#endif
            ;
        { int ng_ = 0; for (int eg = blockIdx.x; eg < 256; eg += grid_n()) ++ng_;
          CNT_SIGNAL(CTL_ + CW_QUEUE + 64 * l + 16, ng_); }
        bool g2ok = false, g1sok = false;
        att::attn_setup(F.lds + RING_OFF, inp(F, 9) + (size_t)l * 256, l);
#ifdef PROBE_DUP_ATT
        for (int rep = 0; rep < 2; ++rep)
#else
        const int rep = 0;
#endif
        for (int it = 0;; ++it) {
            if (it == 0) __syncthreads();
            volatile LAS int* slot = (volatile LAS int*)(F.lds + MISC_OFF) + 16 + (it & 1);
            if (threadIdx.x == 0) *slot = (int)__hip_atomic_fetch_add((unsigned*)(CTL_ + CW_QUEUE + 64 * (l + 4 * rep)), 1u, __ATOMIC_RELAXED, __HIP_MEMORY_SCOPE_AGENT);
            __syncthreads();
            const int idx = __builtin_amdgcn_readfirstlane(*slot);
            if (idx >= 128 + 512 + NCHUNK * 4) break;
            if (idx < 64) { const int cS = NPCH + (idx >> 2), hS = idx & 3; G1IN_DECL(gS);
                gla::g1_load(G1IN_ARGS(gS), cS, hS, ACT_, LOGA_, inp(F, 7) + (size_t)l * 256);
                gla::g1_unit<false>(F.lds + RING_OFF, G1IN_ARGS(gS), cS, hS, l, (bf16*)WSB(WS_U), (float*)WSB(WS_D), (bf16*)WSB(WS_OI), (bf16*)WSB(WS_QT), (bf16*)WSB(WS_SC),
                             inp(F, 4) + (size_t)l * DECB * 4 * 8192, outp(F) + OG_S + (size_t)l * DECB * 4 * 8192, G1IN_ARGS(gS), cS, hS, ACT_, LOGA_, inp(F, 7) + (size_t)l * 256);
                CNT_SIGNAL(CTL_ + CW_QUEUE + 64 * l + 32, 1);
            } else if (idx < 128) { const int b = (idx - 64) >> 2, h = idx & 3;
                const float* kc = inp(F, 2) + ((size_t)(l * DECB + b) * PAST) * 512 + h * 128; const float* vc = inp(F, 3) + ((size_t)(l * DECB + b) * PAST) * 512 + h * 128;
                const float* kn = outp(F) + OK_S + ((size_t)(l * DECB + b) * 64) * 512 + h * 128; const float* vn = outp(F) + OV_S + ((size_t)(l * DECB + b) * 64) * 512 + h * 128;
#ifndef SKIP_AS
                att::attn_unit_sample(F.lds + RING_OFF, kc, vc, kn, vn, ACT_ + (size_t)(SEQ + 64 * b) * NIN + 1792 + h * 128, MIX_ + (size_t)(SEQ + 64 * b) * DM + 512 + h * 128,
                                      PAST, h, inp(F, 10) + (size_t)l * 128);
#endif
            } else if (idx < 640) { const int i = idx - 128, u = 127 - (i >> 2), h = i & 3;
#ifndef SKIP_AP
                int i2 = i; asm volatile("" : "+s"(i2));
                if (att::attn_unit_prompt_t<false>(F.lds + RING_OFF, ACT_ + 2304 + h * 128, ACT_ + 2816 + h * 128, ACT_ + (size_t)(128 * u) * NIN + 1792 + h * 128,
                                      MIX_ + (size_t)(128 * u) * DM + 512 + h * 128, 2 * u + 2, 128 * u, h, inp(F, 10) + (size_t)l * 128)) {
                    const int u2 = 127 - (i2 >> 2), h2 = i2 & 3; __syncthreads();
                    (void)att::attn_unit_prompt_t<true>(F.lds + RING_OFF, ACT_ + 2304 + h2 * 128, ACT_ + 2816 + h2 * 128, ACT_ + (size_t)(128 * u2) * NIN + 1792 + h2 * 128,
                                      MIX_ + (size_t)(128 * u2) * DM + 512 + h2 * 128, 2 * u2 + 2, 128 * u2, h2, inp(F, 10) + (size_t)l * 128); }
#ifdef PROBE_DUP_PROMPT
                { int i3 = i; asm volatile("" : "+s"(i3)); const int u3 = 127 - (i3 >> 2), h3 = i3 & 3; __syncthreads();
                  (void)att::attn_unit_prompt_t<false>(F.lds + RING_OFF, ACT_ + 2304 + h3 * 128, ACT_ + 2816 + h3 * 128, ACT_ + (size_t)(128 * u3) * NIN + 1792 + h3 * 128,
                                      MIX_ + (size_t)(128 * u3) * DM + 512 + h3 * 128, 2 * u3 + 2, 128 * u3, h3, inp(F, 10) + (size_t)l * 128); }
#endif
#endif
            } else { const int i = idx - 640;
                if ((i >> 2) < NPCH) { if (!g2ok) { CNT_WAIT(CTL_ + CW_QUEUE + 64 * l + 16, 256); g2ok = true; } }
                else { if (!g1sok) { CNT_WAIT(CTL_ + CW_QUEUE + 64 * l + 32, 64); g1sok = true; } }
#ifndef SKIP_G3
#ifdef PROBE_DUP_G3
                for (int r3_ = 0; r3_ < 5; ++r3_)
#endif
                gla::g3_unit((LAS float*)(F.lds + RING_OFF + att::OFF_G3), i >> 2, i & 3, ACT_, (const bf16*)WSB(WS_OI), (const bf16*)WSB(WS_QT), (const bf16*)WSB(WS_SC), inp(F, 8) + (size_t)l * 128, MIX_);
#endif
            }
        }
        GRID_BAR();
#ifndef SKIP_OUT
        { pg8::Gemm g{MIX_, (const bf16*)(WL_ + WO_OUT), SEQ, DM, DM}; pg8::StaticOrder S; S.init(SEQ, DM, grid_n(), (int)blockIdx.x);
          pg8::EpiRes E{XN_, (float*)WSB(WS_RSQ) + (size_t)(1 + 2 * l) * M * 16};
          pg8::gemm_phase<pg8::EpiRes, pg8::StaticOrder, true, true>(F.lds + RING_OFF, g, S, E);
          __syncthreads();
          for (int p = blockIdx.x; p < 256; p += grid_n())
              mini::piece<DM>(F.lds + RING_OFF, p, MIX_ + (size_t)SEQ * DM, (const bf16*)(WL_ + WO_OUT), XN_ + (size_t)SEQ * DM, (float*)WSB(WS_RSQ) + ((size_t)(1 + 2 * l) * M + SEQ) * 16);
        }
#endif
        GRID_BAR();
#ifndef SKIP_F1
        { pg8::Gemm g{XN_, (const bf16*)(WL_ + WO_F1), M, NF1, DM}; pg8::StaticOrder S; S.init(M, NF1, grid_n(), (int)blockIdx.x);
          rstd_prepass(F, S, (const float*)WSB(WS_RSQ) + (size_t)(1 + 2 * l) * M * 16);
          pg8::EpiSwi E{HB_, DFF, (const LAS float*)(F.lds + RSTD_OFF)};
          pg8::gemm_phase<pg8::EpiSwi, pg8::StaticOrder, true, true>(F.lds + RING_OFF, g, S, E);
#if defined(PROBE_DUP_GEMM) || defined(PROBE_DUP_F1)
          __syncthreads(); pg8::gemm_phase<pg8::EpiSwi, pg8::StaticOrder, true, true>(F.lds + RING_OFF, g, S, E);
#endif
        }
#endif
        GRID_BAR();
#ifndef SKIP_F2
        { pg8::Gemm g{HB_, (const bf16*)(WL_ + WO_F2), SEQ, DM, DFF}; pg8::StaticOrder S; S.init(SEQ, DM, grid_n(), (int)blockIdx.x);
          pg8::EpiRes E{XN_, (float*)WSB(WS_RSQ) + (size_t)(2 + 2 * l) * M * 16};
          pg8::gemm_phase<pg8::EpiRes, pg8::StaticOrder, true, true>(F.lds + RING_OFF, g, S, E);
          __syncthreads();
          for (int p = blockIdx.x; p < 256; p += grid_n())
              mini::piece<DFF>(F.lds + RING_OFF, p, HB_ + (size_t)SEQ * DFF, (const bf16*)(WL_ + WO_F2), XN_ + (size_t)SEQ * DM, (float*)WSB(WS_RSQ) + ((size_t)(2 + 2 * l) * M + SEQ) * 16);
        }
#endif
        GRID_BAR();
    }
    norm_rows_f32(F, XN_, inp(F, 16), outp(F) + OY);
}

extern "C" void kernel_launch(void* const* d_in, const int* in_sizes, int n_in, void* d_out, int out_size, void* d_ws, size_t ws_size, hipStream_t stream) {
    static int grid = 0;
    if (grid == 0) {
        if (n_in != 18 || (size_t)out_size != OUT_TOTAL || ws_size < WS_END) { fprintf(stderr, "kernel_launch: shape mismatch n_in %d out %d ws %zu\n", n_in, out_size, ws_size); grid = -1; return; }
        int dev = 0, cus = 0, per_cu = 0;
        if (hipGetDevice(&dev) != hipSuccess || hipDeviceGetAttribute(&cus, hipDeviceAttributeMultiprocessorCount, dev) != hipSuccess) { grid = -1; return; }
        if (hipFuncSetAttribute((const void*)hymba_fwd, hipFuncAttributeMaxDynamicSharedMemorySize, LDS_BYTES) != hipSuccess) { fprintf(stderr, "kernel_launch: hipFuncSetAttribute failed\n"); grid = -1; return; }
        if (hipOccupancyMaxActiveBlocksPerMultiprocessor(&per_cu, (const void*)hymba_fwd, NWAVES * 64, LDS_BYTES) != hipSuccess || per_cu < 1)
            fprintf(stderr, "kernel_launch: occupancy query reports %d\n", per_cu);
        (void)hipGetLastError();
        grid = cus;
    }
    if (grid < 0) return;
    if (hipMemsetAsync((char*)d_ws + WS_CTL, 0, CTL_ZERO_BYTES, stream) != hipSuccess) return;
    Args a{};
    for (int i = 0; i < 18; ++i) a.in[i] = (const float*)d_in[i];
    a.out = (float*)d_out; a.ws = (unsigned char*)d_ws;
    hipLaunchKernelGGL(hymba_fwd, dim3(grid), dim3(NWAVES * 64), LDS_BYTES, stream, a);
    const hipError_t le = hipPeekAtLastError();
    if (le != hipSuccess) fprintf(stderr, "kernel_launch: launch failed: %s\n", hipGetErrorName(le));
}
```

```cpp
#define EPI_WT
#include <hip/hip_runtime.h>
#include <cstdio>
#include <cstdint>
namespace pg8 {
#define PG8_LAS __attribute__((address_space(3)))
typedef unsigned short bf16_t;
typedef short bf16x8 __attribute__((ext_vector_type(8)));
typedef float f32x4 __attribute__((ext_vector_type(4)));
typedef unsigned u32x4 __attribute__((ext_vector_type(4)));
constexpr int BM = 256, BK = 64, HALF = 128, HTB = HALF * BK * 2  , STAGE_BYTES = 8 * HTB, NXCD = 8, WGM = 8;

__host__ __device__ __forceinline__ int lds_byte(int r, int c) { const int st = (r >> 4) * 2 + (c >> 5), rr = r & 15, cc = c & 31, ob = rr * 64 + cc * 2; return st * 1024 + (ob ^ (((ob >> 9) & 1) << 5)); }
__host__ __device__ __forceinline__ void stage_rc(int b, int& R, int& C) { const int st = b / 1024, sb = b % 1024, swz = sb ^ (((sb >> 9) & 1) << 5); R = (st >> 1) * 16 + swz / 64; C = (st & 1) * 32 + (swz % 64) / 2; }
__host__ __device__ __forceinline__ int perm32(int rho) { const int n = rho >> 4, i = rho & 15; return 8 * (i >> 2) + 4 * n + (i & 3); }

struct Unit { int pm, pn; };
struct Gemm { const bf16_t* A; const bf16_t* Bt; int M, N, K; };

struct StaticOrder {
    int nM, nN, nwg, G, c;
    __host__ __device__ void init(int M, int N, int G_, int c_) { nM = M / BM; nN = N / BM; nwg = nM * nN; G = G_; c = c_; }
    __host__ __device__ bool next(int i, Unit& u) const {
        const long L = (long)i * G + c; if (L >= nwg) return false;
        int wgid = (int)L; { const int q = nwg / NXCD, r = nwg % NXCD, xcd = wgid % NXCD, off = wgid / NXCD; wgid = (xcd < r ? xcd * (q + 1) : r * (q + 1) + (xcd - r) * q) + off; }
        const int nig = WGM * nN, gid = wgid / nig, fm = gid * WGM, gsz = (nM - fm) < WGM ? (nM - fm) : WGM;
        u.pm = fm + ((wgid % nig) % gsz); u.pn = (wgid % nig) / gsz; return true;
    }
    __device__ __forceinline__ void a_ready(const Unit&) const {}
    __device__ __forceinline__ void done(const Unit&) const {}
};

__device__ __forceinline__ unsigned cvt_pk_bf16(float lo, float hi) { unsigned r; asm volatile("v_cvt_pk_bf16_f32 %0, %1, %2" : "=v"(r) : "v"(lo), "v"(hi)); return r; }
#ifdef EPI_WT
__device__ __forceinline__ void st16(void* p, u32x4 w) { asm volatile("global_store_dwordx4 %0, %1, off sc1\n\ts_nop 1" :: "v"(p), "v"(w) : "memory"); }
#else
__device__ __forceinline__ void st16(void* p, u32x4 w) { *(u32x4*)p = w; }
#endif
__device__ __forceinline__ float silu_f(float v) { return v * __builtin_amdgcn_rcpf(1.f + __expf(-v)); }
__device__ __forceinline__ float logsig_f(float z) { return fminf(z, 0.f) - log1pf(__expf(-fabsf(z))); }

__device__ __forceinline__ float row_rstd(const float* rsq, int row) {
    const f32x4* p = (const f32x4*)(rsq + (size_t)row * 16); const f32x4 a = p[0], b = p[1], c = p[2], d = p[3];
    const float s = ((a[0] + a[1]) + (a[2] + a[3])) + ((b[0] + b[1]) + (b[2] + b[3])) + (((c[0] + c[1]) + (c[2] + c[3])) + ((d[0] + d[1]) + (d[2] + d[3])));
    return __builtin_amdgcn_rsqf(s * (1.f / 1024.f) + 1e-6f);
}
#ifndef EPI_REP
#define EPI_REP 1
#endif
constexpr int IN_N = 3328;
constexpr int PROMPT_ROWS = 16384;

struct EpiIn {
    static constexpr bool PERM = true, AFTER_DRAIN = false;
    unsigned char* ws; float* out; int layer;
    size_t act_off, loga_off;
    const PG8_LAS float* rstd;
    __device__ __forceinline__ void operator()(const f32x4 (&acc)[2][2][4][2], const Unit& u, int wr, int wc, int fr, int fq, int ui) const {
        const int row0 = u.pm * BM + wr * 64 + fr; const int pn = u.pn; const int cl0 = wc * 32 + 8 * fq;
        float* fo = nullptr; int fld = 512;
        if (pn == 2) { fo = (float*)(ws + loga_off) + (size_t)row0 * 256 + cl0; fld = 256; }
        else if (pn >= 9) { const bool samp = (u.pm >= PROMPT_ROWS / BM); const bool isv = (pn >= 11);
            const size_t b = samp ? (isv ? (size_t)87162880 : (size_t)85065728) + (size_t)layer * 524288 : (isv ? (size_t)51380224 : (size_t)17825792) + (size_t)layer * 8388608;
            fo = out + b + (size_t)(row0 - (samp ? PROMPT_ROWS : 0)) * 512 + ((pn - 9) & 1) * 256 + cl0; }
        bf16_t* ab = (bf16_t*)(ws + act_off) + (size_t)row0 * IN_N + pn * BM + cl0;
        for (int rep_ = 0; rep_ < EPI_REP; ++rep_) { asm volatile("" ::: "memory");
        const float qsc = (pn == 7 || pn == 8) ? 0.18033688011112042f : 1.f;
#pragma unroll
        for (int ai = 0; ai < 2; ++ai)
#pragma unroll
            for (int m = 0; m < 4; ++m) { const size_t ro = (size_t)(ai * HALF + m * 16);
                const float rs = rstd[ui * BM + wr * 64 + fr + ai * HALF + m * 16] * qsc;
#pragma unroll
                for (int bj = 0; bj < 2; ++bj) { f32x4 v0 = acc[ai][bj][m][0] * rs, v1 = acc[ai][bj][m][1] * rs;
                    u32x4 w; w.x = cvt_pk_bf16(v0[0], v0[1]); w.y = cvt_pk_bf16(v0[2], v0[3]); w.z = cvt_pk_bf16(v1[0], v1[1]); w.w = cvt_pk_bf16(v1[2], v1[3]);
                    if (pn != 2) st16(ab + ro * IN_N + bj * HALF, w);
                    if (fo) { __builtin_nontemporal_store(v0, (f32x4*)(fo + ro * fld + bj * HALF)); __builtin_nontemporal_store(v1, (f32x4*)(fo + ro * fld + bj * HALF + 4)); } } }
        }
    }
};

struct EpiSwi {
    static constexpr bool PERM = true, AFTER_DRAIN = false;
    bf16_t* H; int ldh; const PG8_LAS float* rstd;
    __device__ __forceinline__ void operator()(const f32x4 (&acc)[2][2][4][2], const Unit& u, int wr, int wc, int fr, int fq, int ui) const {
        const int row0 = u.pm * BM + wr * 64 + fr; bf16_t* hb = H + (size_t)row0 * ldh + u.pn * HALF + wc * 32 + 8 * fq;
        for (int rep_ = 0; rep_ < EPI_REP; ++rep_) { asm volatile("" ::: "memory");
#pragma unroll
        for (int ai = 0; ai < 2; ++ai)
#pragma unroll
            for (int m = 0; m < 4; ++m) { const float rs = rstd[ui * BM + wr * 64 + fr + ai * HALF + m * 16];
                const float c2 = -1.4426950408889634f * rs, rs2 = rs * rs;
                const f32x4 a0 = acc[ai][0][m][0], a1 = acc[ai][0][m][1], u0 = acc[ai][1][m][0], u1 = acc[ai][1][m][1];
                f32x4 r0, r1;
#pragma unroll
                for (int e = 0; e < 4; ++e) { r0[e] = __builtin_amdgcn_rcpf(1.f + __builtin_amdgcn_exp2f(a0[e] * c2)) * rs2; r1[e] = __builtin_amdgcn_rcpf(1.f + __builtin_amdgcn_exp2f(a1[e] * c2)) * rs2; }
                const f32x4 o0 = (a0 * u0) * r0, o1 = (a1 * u1) * r1;
                u32x4 w; w.x = cvt_pk_bf16(o0[0], o0[1]); w.y = cvt_pk_bf16(o0[2], o0[3]); w.z = cvt_pk_bf16(o1[0], o1[1]); w.w = cvt_pk_bf16(o1[2], o1[3]);
                st16(hb + (size_t)(ai * HALF + m * 16) * ldh, w); }
        }
    }
};

struct EpiRes {
    static constexpr bool PERM = true, AFTER_DRAIN = false;
    bf16_t* xb; float* rowsq;
    __device__ __forceinline__ void operator()(const f32x4 (&acc)[2][2][4][2], const Unit& u, int wr, int wc, int fr, int fq, int ui) const {
        const int row0 = u.pm * BM + wr * 64 + fr; const int c0 = u.pn * BM + wc * 32 + 8 * fq;
        bf16_t* xbb = xb + (size_t)row0 * 1024 + c0;
        u32x4 sres[2][4][2];
#pragma unroll
        for (int ai = 0; ai < 2; ++ai)
#pragma unroll
            for (int m = 0; m < 4; ++m)
#pragma unroll
                for (int bj = 0; bj < 2; ++bj) sres[ai][m][bj] = *(const u32x4*)(xbb + (size_t)(ai * HALF + m * 16) * 1024 + bj * HALF);
#pragma unroll
        for (int ai = 0; ai < 2; ++ai)
#pragma unroll
            for (int m = 0; m < 4; ++m) { const size_t ro = (size_t)(ai * HALF + m * 16) * 1024; float sq = 0.f;
#pragma unroll
                for (int bj = 0; bj < 2; ++bj) { const u32x4 s = sres[ai][m][bj];
                    f32x4 v0, v1;
                    v0[0] = __builtin_bit_cast(float, s.x << 16) + acc[ai][bj][m][0][0]; v0[1] = __builtin_bit_cast(float, s.x & 0xffff0000u) + acc[ai][bj][m][0][1];
                    v0[2] = __builtin_bit_cast(float, s.y << 16) + acc[ai][bj][m][0][2]; v0[3] = __builtin_bit_cast(float, s.y & 0xffff0000u) + acc[ai][bj][m][0][3];
                    v1[0] = __builtin_bit_cast(float, s.z << 16) + acc[ai][bj][m][1][0]; v1[1] = __builtin_bit_cast(float, s.z & 0xffff0000u) + acc[ai][bj][m][1][1];
                    v1[2] = __builtin_bit_cast(float, s.w << 16) + acc[ai][bj][m][1][2]; v1[3] = __builtin_bit_cast(float, s.w & 0xffff0000u) + acc[ai][bj][m][1][3];
                    sq += (v0[0] * v0[0] + v0[1] * v0[1]) + (v0[2] * v0[2] + v0[3] * v0[3]) + (v1[0] * v1[0] + v1[1] * v1[1]) + (v1[2] * v1[2] + v1[3] * v1[3]);
                    u32x4 w; w.x = cvt_pk_bf16(v0[0], v0[1]); w.y = cvt_pk_bf16(v0[2], v0[3]); w.z = cvt_pk_bf16(v1[0], v1[1]); w.w = cvt_pk_bf16(v1[2], v1[3]);
                    st16(xbb + ro + bj * HALF, w); }
                { const unsigned u1 = __builtin_bit_cast(unsigned, sq); const auto r1 = __builtin_amdgcn_permlane16_swap(u1, u1, false, false); const unsigned a1 = r1[0], b1 = r1[1];
                  sq = __builtin_bit_cast(float, a1) + __builtin_bit_cast(float, b1);
                  const unsigned u2 = __builtin_bit_cast(unsigned, sq); const auto r2 = __builtin_amdgcn_permlane32_swap(u2, u2, false, false); const unsigned a2 = r2[0], b2 = r2[1];
                  sq = __builtin_bit_cast(float, a2) + __builtin_bit_cast(float, b2); }
                if (fq == 0) rowsq[(size_t)(row0 + ai * HALF + m * 16) * 16 + u.pn * 4 + wc] = sq; }
    }
};
template <class Epi, class Sched, bool ALIGN_EPI = false, bool SP2 = false>
__device__ __forceinline__ void gemm_phase(PG8_LAS unsigned char* lds, const Gemm g, const Sched& S, const Epi& E) {
    int tid_ = threadIdx.x; asm volatile("" : "+v"(tid_));
    const int tid = tid_, wid = __builtin_amdgcn_readfirstlane(tid >> 6), lane = tid & 63, wr = wid >> 2, wc = wid & 3, fr = lane & 15, fq = lane >> 4;
    const int K = g.K, nt = K / BK;
    unsigned voffA[2], voffB[2];
#pragma unroll
    for (int i = 0; i < 2; ++i) { int R, C; stage_rc(tid * 16 + i * 8192, R, C); const int Rb = Epi::PERM ? ((R & ~31) + perm32(R & 31)) : R;
        voffA[i] = (unsigned)(R * K + C) * 2u; voffB[i] = (unsigned)(Rb * K + C) * 2u; }
    const size_t kstep = (size_t)(BK * 2);
    const size_t hstep = (size_t)HALF * K * 2;
    const size_t tstep = 2 * hstep;
    const unsigned ldsw = (unsigned)wid * 1024u;
    const int aoff = lds_byte(wr * 64 + fr, fq * 8), boff = lds_byte(wc * 32 + fr, fq * 8);
#define PG8_SA(b, h) (((b) * 2 + (h)) * HTB)
#define PG8_SB(b, h) ((4 + (b) * 2 + (h)) * HTB)
#define PG8_STAGE(bufoff, gbase, voff) do { _Pragma("unroll") for (int _i = 0; _i < 2; ++_i) \
        __builtin_amdgcn_global_load_lds((const unsigned*)((const char*)(gbase) + (voff)[_i]), (PG8_LAS unsigned*)(lds + (bufoff) + ldsw + _i * 8192), 16, 0, 0); } while (0)
#define PG8_LDA(dst, b, h) do { _Pragma("unroll") for (int m = 0; m < 4; ++m) _Pragma("unroll") for (int k = 0; k < 2; ++k) dst[m][k] = *(const PG8_LAS bf16x8*)(lds + PG8_SA(b, h) + aoff + m * 2048 + k * 1024); } while (0)
#define PG8_LDB(dst, b, h) do { _Pragma("unroll") for (int n = 0; n < 2; ++n) _Pragma("unroll") for (int k = 0; k < 2; ++k) dst[n][k] = *(const PG8_LAS bf16x8*)(lds + PG8_SB(b, h) + boff + n * 2048 + k * 1024); } while (0)
#define PG8_MMA(ai, bj, At, Bt) do { __builtin_amdgcn_s_setprio(1); _Pragma("unroll") for (int m = 0; m < 4; ++m) _Pragma("unroll") for (int n = 0; n < 2; ++n) _Pragma("unroll") for (int k = 0; k < 2; ++k) \
        acc[ai][bj][m][n] = __builtin_amdgcn_mfma_f32_16x16x32_bf16(Bt[n][k], At[m][k], acc[ai][bj][m][n], 0, 0, 0); __builtin_amdgcn_s_setprio(0); } while (0)
#define PG8_WAIT_V(n) asm volatile("s_waitcnt vmcnt(" #n ")" ::: "memory")
#define PG8_WAIT_L(n) asm volatile("s_waitcnt lgkmcnt(" #n ")" ::: "memory")
#define PG8_BAR __builtin_amdgcn_s_barrier()
#define PG8_SCHED __builtin_amdgcn_sched_barrier(0)
    Unit cur, nxt; int ui = 0;
    if (!S.next(0, cur)) return;
    f32x4 acc[2][2][4][2];
#pragma unroll
    for (int a = 0; a < 2; ++a)
#pragma unroll
        for (int b = 0; b < 2; ++b)
#pragma unroll
            for (int m = 0; m < 4; ++m)
#pragma unroll
                for (int n = 0; n < 2; ++n) acc[a][b][m][n] = (f32x4){0.f, 0.f, 0.f, 0.f};
    bf16x8 At[4][2], B0[2][2], B1[2][2];
    const char* cA = (const char*)g.A + (size_t)cur.pm * tstep; const char* cB = (const char*)g.Bt + (size_t)cur.pn * tstep;
    S.a_ready(cur);
    if constexpr (SP2) {
        PG8_STAGE(PG8_SB(0, 0), cB, voffB); PG8_STAGE(PG8_SB(0, 1), cB + hstep, voffB); PG8_STAGE(PG8_SA(0, 0), cA, voffA); PG8_STAGE(PG8_SA(0, 1), cA + hstep, voffA);
        if (wr == 1) PG8_BAR;
        PG8_WAIT_V(2); PG8_BAR;
        PG8_STAGE(PG8_SB(1, 0), cB + kstep, voffB); PG8_STAGE(PG8_SA(1, 0), cA + kstep, voffA); PG8_STAGE(PG8_SB(1, 1), cB + hstep + kstep, voffB);
        PG8_WAIT_V(6); PG8_BAR;
    } else {
        PG8_STAGE(PG8_SB(0, 0), cB, voffB); PG8_STAGE(PG8_SA(0, 0), cA, voffA); PG8_STAGE(PG8_SB(0, 1), cB + hstep, voffB); PG8_STAGE(PG8_SA(0, 1), cA + hstep, voffA);
        if (wr == 1) PG8_BAR;
        PG8_WAIT_V(4); PG8_BAR;
        PG8_STAGE(PG8_SB(1, 0), cB + kstep, voffB); PG8_STAGE(PG8_SA(1, 0), cA + kstep, voffA); PG8_STAGE(PG8_SB(1, 1), cB + hstep + kstep, voffB);
        PG8_WAIT_V(6); PG8_BAR;
    }
    for (;;) {
        const bool has_next = S.next(ui + 1, nxt);
        const char* nA = has_next ? (const char*)g.A + (size_t)nxt.pm * tstep : cA; const char* nB = has_next ? (const char*)g.Bt + (size_t)nxt.pn * tstep : cB;
        for (int t = 0; t < nt; t += 2) {
            const bool last = (t == nt - 2);
            const char* a1 = cA + (size_t)(t + 1) * kstep;
            const char* a2 = last ? nA : cA + (size_t)(t + 2) * kstep; const char* b2 = last ? nB : cB + (size_t)(t + 2) * kstep;
            const char* a3 = a2 + kstep; const char* b3 = b2 + kstep;
            if (last && has_next) S.a_ready(nxt);
            if constexpr (SP2) {
            PG8_LDB(B0, 0, 0); PG8_LDB(B1, 0, 1); PG8_SCHED; PG8_LDA(At, 0, 0); PG8_STAGE(PG8_SA(1, 1), a1 + hstep, voffA);
            PG8_WAIT_V(8); PG8_WAIT_L(0); PG8_BAR; PG8_MMA(0, 0, At, B0); PG8_MMA(0, 1, At, B1); PG8_BAR; PG8_SCHED;
            PG8_LDA(At, 0, 1); PG8_STAGE(PG8_SB(0, 0), b2, voffB); PG8_STAGE(PG8_SB(0, 1), b2 + hstep, voffB); PG8_STAGE(PG8_SA(0, 0), a2, voffA);
            PG8_WAIT_V(8); PG8_WAIT_L(0); PG8_BAR; PG8_MMA(1, 0, At, B0); PG8_MMA(1, 1, At, B1); PG8_BAR; PG8_SCHED;
            PG8_LDB(B0, 1, 0); PG8_LDB(B1, 1, 1); PG8_SCHED; PG8_LDA(At, 1, 0); PG8_STAGE(PG8_SA(0, 1), a2 + hstep, voffA);
            PG8_WAIT_V(8); PG8_WAIT_L(0); PG8_BAR; PG8_MMA(0, 0, At, B0); PG8_MMA(0, 1, At, B1); PG8_BAR; PG8_SCHED;
            PG8_LDA(At, 1, 1); PG8_STAGE(PG8_SB(1, 0), b3, voffB); PG8_STAGE(PG8_SB(1, 1), b3 + hstep, voffB); PG8_STAGE(PG8_SA(1, 0), a3, voffA);
            PG8_WAIT_V(8); PG8_WAIT_L(0); PG8_BAR; PG8_MMA(1, 0, At, B0); PG8_MMA(1, 1, At, B1); PG8_BAR; PG8_SCHED;
            } else {
            PG8_LDB(B0, 0, 0); PG8_SCHED; PG8_LDA(At, 0, 0); PG8_STAGE(PG8_SA(1, 1), a1 + hstep, voffA);
            PG8_WAIT_L(8); PG8_BAR; PG8_WAIT_L(0); PG8_MMA(0, 0, At, B0); PG8_BAR; PG8_SCHED;
            PG8_LDB(B1, 0, 1); PG8_STAGE(PG8_SB(0, 0), b2, voffB);
            PG8_BAR; PG8_WAIT_L(0); PG8_MMA(0, 1, At, B1); PG8_BAR;
            PG8_LDA(At, 0, 1); PG8_STAGE(PG8_SA(0, 0), a2, voffA);
            PG8_BAR; PG8_WAIT_L(0); PG8_MMA(1, 0, At, B0); PG8_BAR; PG8_SCHED;
            PG8_STAGE(PG8_SB(0, 1), b2 + hstep, voffB);
            PG8_WAIT_V(6); PG8_BAR; PG8_MMA(1, 1, At, B1); PG8_BAR;
            PG8_LDB(B0, 1, 0); PG8_SCHED; PG8_LDA(At, 1, 0); PG8_STAGE(PG8_SA(0, 1), a2 + hstep, voffA);
            PG8_WAIT_L(8); PG8_BAR; PG8_WAIT_L(0); PG8_MMA(0, 0, At, B0); PG8_BAR; PG8_SCHED;
            PG8_LDB(B1, 1, 1); PG8_STAGE(PG8_SB(1, 0), b3, voffB);
            PG8_BAR; PG8_WAIT_L(0); PG8_MMA(0, 1, At, B1); PG8_BAR;
            PG8_LDA(At, 1, 1); PG8_STAGE(PG8_SA(1, 0), a3, voffA);
            PG8_BAR; PG8_WAIT_L(0); PG8_MMA(1, 0, At, B0); PG8_BAR; PG8_SCHED;
            PG8_STAGE(PG8_SB(1, 1), b3 + hstep, voffB);
            PG8_WAIT_V(6); PG8_BAR; PG8_MMA(1, 1, At, B1); PG8_BAR;
            }
        }
        if constexpr (ALIGN_EPI) { if (wr == 0) PG8_BAR; }
        if constexpr (!Epi::AFTER_DRAIN) { E(acc, cur, wr, wc, fr, fq, ui); S.done(cur); }
        if (!has_next) break;
#pragma unroll
        for (int a = 0; a < 2; ++a)
#pragma unroll
            for (int b = 0; b < 2; ++b)
#pragma unroll
                for (int m = 0; m < 4; ++m)
#pragma unroll
                    for (int n = 0; n < 2; ++n) acc[a][b][m][n] = (f32x4){0.f, 0.f, 0.f, 0.f};
        cur = nxt; cA = nA; cB = nB; ++ui;
        if constexpr (ALIGN_EPI) { if (wr == 1) PG8_BAR; }
    }
    PG8_WAIT_V(0);
    if constexpr (!ALIGN_EPI) { if (wr == 0) PG8_BAR; }
    PG8_BAR;
    if constexpr (Epi::AFTER_DRAIN) { E.fused(acc, cur, wr, wc, fr, fq, lds, wid, lane); S.done(cur); }
#undef PG8_SA
#undef PG8_SB
#undef PG8_STAGE
#undef PG8_LDA
#undef PG8_LDB
#undef PG8_MMA
#undef PG8_WAIT_V
#undef PG8_WAIT_L
#undef PG8_BAR
#undef PG8_SCHED
}
}
constexpr int NWAVES = 8;
constexpr int DM = 1024, SEQ = 16384, DEPTH = 4, DECB = 16, DECS = 64, PAST = 4096;
constexpr int M = SEQ + DECB * DECS;
constexpr int NIN = pg8::IN_N;
constexpr int DFF = 2816, NF1 = 2 * DFF;
constexpr int WIN_ORIG = 3088;
constexpr int NCHUNK = M / 64;
constexpr int NPCH = SEQ / 64;
constexpr float RMS_EPS = 1e-6f;
constexpr size_t OY = 0, OK_P = 17825792, OV_P = 51380224, OG_P = 84934656, OK_S = 85065728, OV_S = 87162880, OG_S = 89260032, OUT_TOTAL = 91357184;

constexpr size_t MiB = 1u << 20;
constexpr size_t WS_CTL = 0, CTL_ZERO_BYTES = 128 * 1024;
constexpr size_t WS_W = 2 * MiB, W_LAYER = 25 * MiB;
constexpr size_t WO_IN = 0, WO_OUT = 6815744, WO_F1 = WO_OUT + 2 * MiB, WO_F2 = WO_F1 + 11 * MiB;
static_assert(WO_F2 + (size_t)DM * DFF * 2 == W_LAYER, "weight map");
constexpr size_t WS_X = 104 * MiB;
constexpr size_t WS_XN = 172 * MiB;
constexpr size_t WS_ACT = 206 * MiB;
constexpr size_t WS_MIX = 317 * MiB;
constexpr size_t WS_H = 351 * MiB;
constexpr size_t WS_LOGA = 445 * MiB;
constexpr size_t WS_U = 462 * MiB;
constexpr size_t WS_D = 496 * MiB;
constexpr size_t WS_SC = 497 * MiB;
constexpr size_t WS_OI = 529 * MiB;
constexpr size_t WS_QT = 563 * MiB;
constexpr size_t WS_RSQ = 576 * MiB;
constexpr size_t WS_END = 588 * MiB;
static_assert(WS_X + (size_t)M * DM * 4 <= WS_XN && WS_XN + (size_t)M * DM * 2 <= WS_ACT && WS_ACT + (size_t)M * NIN * 2 <= WS_MIX && WS_MIX + (size_t)M * DM * 2 <= WS_H &&
              WS_H + (size_t)M * DFF * 2 <= WS_LOGA && WS_LOGA + (size_t)M * 256 * 4 <= WS_U && WS_U + (size_t)NCHUNK * 4 * 64 * 128 * 4 <= WS_D && WS_D + (size_t)NCHUNK * 4 * 64 * 4 <= WS_SC &&
              WS_SC + (size_t)NPCH * 4 * 64 * 128 * 4 <= WS_OI && WS_OI + (size_t)M * 512 * 4 <= WS_QT && WS_QT + (size_t)M * 256 * 2 <= WS_RSQ && WS_RSQ + (size_t)9 * M * 64 <= WS_END, "d_ws map");
constexpr int CW_TMO = 0, CW_CODE = 1;
constexpr int CW_BAR = 4096;
constexpr int CW_QUEUE = 16384;

constexpr int RING_OFF = 0, RING_BYTES = 131072;
constexpr int LDSCTL_OFF = RING_BYTES, MISC_OFF = LDSCTL_OFF + 320;
constexpr int LDS_BYTES = 147456;

#define GAS __attribute__((address_space(1)))
#define LAS __attribute__((address_space(3)))
typedef unsigned short bf16;
typedef unsigned v4u __attribute__((ext_vector_type(4)));
typedef unsigned v2u __attribute__((ext_vector_type(2)));
typedef float f32x4 __attribute__((ext_vector_type(4)));
typedef float f32x16 __attribute__((ext_vector_type(16)));
typedef short bf16x8 __attribute__((ext_vector_type(8)));
typedef short s16x4 __attribute__((ext_vector_type(4)));
typedef GAS unsigned gu32;
#define RLX_AGENT __ATOMIC_RELAXED, __HIP_MEMORY_SCOPE_AGENT
#define LDS_WAIT() asm volatile("s_waitcnt lgkmcnt(0)" ::: "memory")
#define VM_WAIT() asm volatile("s_waitcnt vmcnt(0)" ::: "memory")
__device__ __forceinline__ unsigned f2bf(float f) { unsigned u = __builtin_bit_cast(unsigned, f); return (u + 0x7fffu + ((u >> 16) & 1u)) >> 16; }
typedef float pkf2_t __attribute__((ext_vector_type(2)));
typedef __bf16 pkb2_t __attribute__((ext_vector_type(2)));
__device__ __forceinline__ unsigned pk2(float lo, float hi) { const pkf2_t v = {lo, hi}; return __builtin_bit_cast(unsigned, __builtin_convertvector(v, pkb2_t)); }
__device__ __forceinline__ float bf2f(unsigned short b) { return __builtin_bit_cast(float, (unsigned)b << 16); }
__device__ __forceinline__ float wave_sum(float v) {
#define WS_DPP_(ctrl) do { const int t_ = __builtin_amdgcn_update_dpp(0, __builtin_bit_cast(int, v), (ctrl), 0xf, 0xf, false); v += __builtin_bit_cast(float, t_); } while (0)
    WS_DPP_(0xB1);
    WS_DPP_(0x4E);
    WS_DPP_(0x124);
    WS_DPP_(0x128);
#undef WS_DPP_
    { const unsigned u = __builtin_bit_cast(unsigned, v); const auto r = __builtin_amdgcn_permlane16_swap(u, u, false, false); const unsigned a = r[0], b = r[1];
      v = __builtin_bit_cast(float, a) + __builtin_bit_cast(float, b); }
    { const unsigned u = __builtin_bit_cast(unsigned, v); const auto r = __builtin_amdgcn_permlane32_swap(u, u, false, false); const unsigned a = r[0], b = r[1];
      v = __builtin_bit_cast(float, a) + __builtin_bit_cast(float, b); }
    return v;
}
#define XB_TMO      128
#define XB_XCNT(j)  (256  + 64 * (j))
#define XB_XSUB(j)  (1280 + 64 * (j))
#define XB_XGEN(j)  (2304 + 64 * (j))
#define XB_TOP      3328
#define XB_TOPGEN   3392
#define XCD_BAR_WORDS 3456
#define XB_SPIN_CAP (1u << 18)

__device__ __forceinline__ unsigned xb_ld(unsigned* p)              { return __hip_atomic_load(p, __ATOMIC_RELAXED, __HIP_MEMORY_SCOPE_AGENT); }
__device__ __forceinline__ unsigned xb_add(unsigned* p, unsigned v) { return __hip_atomic_fetch_add(p, v, __ATOMIC_RELAXED, __HIP_MEMORY_SCOPE_AGENT); }
__device__ __forceinline__ unsigned xb_xcc_id() { return (unsigned)__builtin_amdgcn_s_getreg((3 << 11) | 20) & 0xFu; }
#define XB_SPIN(cond, bar) do { unsigned _sp = 0; while (cond) { __builtin_amdgcn_s_sleep(1); \
    if ((++_sp & 255u) == 0u) { if (xb_ld(&(bar)[XB_TMO])) break; if (_sp > XB_SPIN_CAP) { atomicAdd(&(bar)[XB_TMO], 1u); break; } } } } while (0)

struct XcdBarrier {
    unsigned* bar; unsigned x;
    volatile LAS unsigned* st;
};

__device__ __forceinline__ XcdBarrier xcd_barrier_post(unsigned* bar, volatile LAS unsigned* st) {
    XcdBarrier b; b.bar = bar; b.x = xb_xcc_id(); b.st = st;
    if (threadIdx.x == 0) (void)xb_add(&bar[XB_XCNT(b.x)], 1u);
    return b;
}
__device__ __forceinline__ void xcd_barrier_complete(unsigned* bar, unsigned x, unsigned& nloc, unsigned& nx) {
    const unsigned G = gridDim.x * gridDim.y * gridDim.z;
    unsigned sum, cnt, mine, sp = 0u;
    for (;;) {
        sum = 0u; cnt = 0u; mine = 0u;
#pragma unroll
        for (unsigned j = 0; j < 16; ++j) { const unsigned c = xb_ld(&bar[XB_XCNT(j)]); sum += c; cnt += (c > 0u) ? 1u : 0u; mine = (j == x) ? c : mine; }
        if (sum == G) break;
        __builtin_amdgcn_s_sleep(1);
        if ((++sp & 255u) == 0u) { if (xb_ld(&bar[XB_TMO])) break; if (sp > XB_SPIN_CAP) { atomicAdd(&bar[XB_TMO], 1u); break; } }
    }
    nloc = mine > 0u ? mine : 1u; nx = cnt > 0u ? cnt : 1u;
}

__device__ __forceinline__ void xcd_barrier(const XcdBarrier& b) {
    asm volatile("s_waitcnt vmcnt(0)" ::: "memory");
    __syncthreads();
    if (threadIdx.x == 0) {
        unsigned* bar = b.bar;
        __builtin_amdgcn_s_waitcnt(0);
        unsigned nloc = b.st[0], nx = b.st[1];
        if (nloc == 0u) { xcd_barrier_complete(bar, b.x, nloc, nx); b.st[0] = nloc; b.st[1] = nx; }
        const unsigned old = xb_add(&bar[XB_XSUB(b.x)], 1u);
        const unsigned gen = old / nloc;
        if (old + 1u == (gen + 1u) * nloc) {
            __builtin_amdgcn_fence(__ATOMIC_RELEASE, "agent");
            asm volatile("s_waitcnt vmcnt(0)" ::: "memory");
            const unsigned og = xb_add(&bar[XB_TOP], 1u);
            const unsigned tg = og / nx;
            if (og + 1u == (tg + 1u) * nx) xb_add(&bar[XB_TOPGEN], 1u);
            else XB_SPIN(xb_ld(&bar[XB_TOPGEN]) == tg, bar);
            __builtin_amdgcn_fence(__ATOMIC_ACQUIRE, "agent");
            xb_add(&bar[XB_XGEN(b.x)], 1u);
            asm volatile("s_waitcnt vmcnt(0)" ::: "memory");
        } else {
            XB_SPIN(xb_ld(&bar[XB_XGEN(b.x)]) == gen, bar);
            __builtin_amdgcn_fence(__ATOMIC_ACQUIRE, "agent");
            asm volatile("s_waitcnt vmcnt(0)" ::: "memory");
        }
    }
    __syncthreads();
}
struct Frame {
    LAS unsigned char* lds;
};
__device__ __forceinline__ int grid_n() { return (int)gridDim.x; }
__device__ __forceinline__ int vcu_id() { const int G = (int)gridDim.x, bx = (int)blockIdx.x; return (G % 8 == 0) ? (bx % 8) * (G / 8) + bx / 8 : bx; }
__device__ __forceinline__ int fresh_tid() { int t = threadIdx.x; asm volatile("" : "+v"(t)); return t; }

__device__ __forceinline__ void tr_store(LAS float* scr, bf16* WT, int K, int dstrow0, int k0, int lane, int dstep = 1) {
    LDS_WAIT(); asm volatile("" ::: "memory");
    const int c = lane & 7;
#pragma unroll
    for (int j = 0; j < 4; ++j) { const int n = (lane >> 3) + 8 * j; const LAS float* s = scr + (8 * c) * 33 + n;
        v4u o; o.x = pk2(s[0 * 33], s[1 * 33]); o.y = pk2(s[2 * 33], s[3 * 33]); o.z = pk2(s[4 * 33], s[5 * 33]); o.w = pk2(s[6 * 33], s[7 * 33]);
        *(GAS v4u*)(WT + (size_t)(dstrow0 + n * dstep) * K + k0 + 8 * c) = o; }
    LDS_WAIT(); asm volatile("" ::: "memory");
}
__device__ __forceinline__ void tr_item(const float* W, int ld, int K, int srccol0, bf16* WT, int dstrow0, int k0, LAS float* scr, int lane, const float* gk, int dstep = 1) {
    const int ks = lane >> 3, nq = (lane & 7) * 4; f32x4 v[8];
#pragma unroll
    for (int i = 0; i < 8; ++i) v[i] = *(const f32x4*)(W + (size_t)(k0 + 8 * i + ks) * ld + srccol0 + nq);
#pragma unroll
    for (int i = 0; i < 8; ++i) { const int kk = 8 * i + ks; f32x4 x = v[i]; if (gk) x = x * gk[k0 + kk];
        LAS float* d = scr + kk * 33 + nq; d[0] = x[0]; d[1] = x[1]; d[2] = x[2]; d[3] = x[3]; }
    tr_store(scr, WT, K, dstrow0, k0, lane, dstep);
}
__device__ __forceinline__ void tr_item_z(const float* Win, const float* a2, int n0z, bf16* WT, int k0, LAS float* scr, int lane, const float* gk) {
    float av[16];
#pragma unroll
    for (int r = 0; r < 16; ++r) av[r] = a2[r * 256 + n0z + (lane & 31)];
#pragma unroll 8
    for (int i = 0; i < 32; ++i) { const int kk = 2 * i + (lane >> 5); const float* wr_ = Win + (size_t)(k0 + kk) * WIN_ORIG + 1536; float s = 0.f;
#pragma unroll
        for (int r4 = 0; r4 < 4; ++r4) { const f32x4 w4 = ((const f32x4*)wr_)[r4];
            s = fmaf(w4[0], av[4 * r4], s); s = fmaf(w4[1], av[4 * r4 + 1], s); s = fmaf(w4[2], av[4 * r4 + 2], s); s = fmaf(w4[3], av[4 * r4 + 3], s); }
        scr[kk * 33 + (lane & 31)] = s * gk[k0 + kk]; }
    tr_store(scr, WT, DM, 512 + n0z, k0, lane);
}

struct Args { const float* in[18]; float* out; unsigned char* ws; };
constexpr int PTAB_OFF = MISC_OFF + 128;
__device__ __forceinline__ const float* inp(const Frame& F, int i) {
    unsigned off = (unsigned)(PTAB_OFF + 8 * i); asm volatile("" : "+v"(off));
    const volatile LAS unsigned* t = (const volatile LAS unsigned*)(F.lds + off);
    const unsigned lo = __builtin_amdgcn_readfirstlane(t[0]), hi = __builtin_amdgcn_readfirstlane(t[1]);
    return (const float*)(const GAS float*)(((unsigned long long)hi << 32) | lo);
}
__device__ __forceinline__ float* outp(const Frame& F) { return (float*)inp(F, 18); }
__device__ __forceinline__ unsigned char* wsp(const Frame& F) { return (unsigned char*)inp(F, 19); }

__device__ __forceinline__ void p0_items(Frame& F, int it_lo, int it_hi, int cu0, int ncu);
__device__ __forceinline__ void p0_prologue(Frame& F, int l_lo, int l_hi, int cu0, int ncu) { p0_items(F, l_lo * 6400, l_hi * 6400, cu0, ncu); }
__device__ __forceinline__ void p0_items(Frame& F, int it_lo, int it_hi, int cu0, int ncu) {
    const int tid_ = fresh_tid(), lane_ = tid_ & 63, wave_ = __builtin_amdgcn_readfirstlane(tid_ >> 6);
    LAS float* scr = (LAS float*)(F.lds + RING_OFF + wave_ * 16384);
    const int me = (int)blockIdx.x - cu0; if (me < 0 || me >= ncu) return;
    const int gw = me * NWAVES + wave_, NGW = ncu * NWAVES;
    constexpr int I_IN = 16 * 104, I_OUT = 16 * 32, I_F1 = 16 * 176, I_F2 = 44 * 32, I_L = I_IN + I_OUT + I_F1 + I_F2;
    static_assert(I_L == 6400, "item count");
    for (int it = it_lo + gw; it < it_hi; it += NGW) {
        const int l = it / I_L; int r = it % I_L;
        unsigned char* wl = wsp(F) + WS_W + (size_t)l * W_LAYER;
        if (r < I_IN) { const int kb = r / 104, nb = r % 104, n0 = 32 * nb; const float* W = inp(F, 5) + (size_t)l * DM * WIN_ORIG;
            if (n0 >= 512 && n0 < 768) tr_item_z(W, inp(F, 6) + (size_t)l * 16 * 256, n0 - 512, (bf16*)(wl + WO_IN), 64 * kb, scr, lane_, inp(F, 12) + (size_t)l * DM);
            else if (n0 < 512) {
                const int dst = n0 < 256 ? 2 * n0 : 2 * (n0 - 256) + 1; tr_item(W, WIN_ORIG, DM, n0, (bf16*)(wl + WO_IN), dst, 64 * kb, scr, lane_, inp(F, 12) + (size_t)l * DM, 2); }
            else { const int src = n0 < 1792 ? n0 - 256 : n0 - 240; tr_item(W, WIN_ORIG, DM, src, (bf16*)(wl + WO_IN), n0, 64 * kb, scr, lane_, inp(F, 12) + (size_t)l * DM); }
            continue; }
        r -= I_IN;
        if (r < I_OUT) { const int kb = r / 32, nb = r % 32; tr_item(inp(F, 11) + (size_t)l * DM * DM, DM, DM, 32 * nb, (bf16*)(wl + WO_OUT), 32 * nb, 64 * kb, scr, lane_, nullptr); continue; }
        r -= I_OUT;
        if (r < I_F1) { const int kb = r / 176, nb = r % 176, n0 = 32 * nb, pn = n0 >> 8, j = n0 & 255; const int src = j < 128 ? 128 * pn + j : DFF + 128 * pn + (j - 128);
            tr_item(inp(F, 14) + (size_t)l * DM * NF1, NF1, DM, src, (bf16*)(wl + WO_F1), n0, 64 * kb, scr, lane_, inp(F, 13) + (size_t)l * DM); continue; }
        r -= I_F1;
        { const int kb = r / 32, nb = r % 32; tr_item(inp(F, 15) + (size_t)l * DFF * DM, DM, DFF, 32 * nb, (bf16*)(wl + WO_F2), 32 * nb, 64 * kb, scr, lane_, nullptr); }
    }
}

__device__ __forceinline__ void rows_to_bf16_sq(Frame& F, const float* srcp, const float* srcs, bf16* XB, float* rowsq) {
    const int tid_ = fresh_tid(), lane_ = tid_ & 63, wave_ = __builtin_amdgcn_readfirstlane(tid_ >> 6);
    const int gw = vcu_id() * NWAVES + wave_, NGW = grid_n() * NWAVES;
    for (int m0 = gw; m0 < M; m0 += 2 * NGW) {
        const int m1 = (m0 + NGW < M) ? m0 + NGW : m0;
        f32x4 v[2][4]; float s[2] = {0.f, 0.f};
#pragma unroll
        for (int t = 0; t < 2; ++t) { const int m = t ? m1 : m0; const float* xrow = m < SEQ ? srcp + (size_t)m * DM : srcs + (size_t)(m - SEQ) * DM;
            const GAS f32x4* xr = (const GAS f32x4*)xrow + lane_;
#pragma unroll
            for (int j = 0; j < 4; ++j) v[t][j] = xr[64 * j]; }
#pragma unroll
        for (int t = 0; t < 2; ++t) {
#pragma unroll
            for (int j = 0; j < 4; ++j) s[t] += (v[t][j].x * v[t][j].x + v[t][j].y * v[t][j].y) + (v[t][j].z * v[t][j].z + v[t][j].w * v[t][j].w);
            s[t] = wave_sum(s[t]); }
#pragma unroll
        for (int t = 0; t < 2; ++t) { const int m = t ? m1 : m0;
            GAS unsigned long long* o8 = (GAS unsigned long long*)(XB + (size_t)m * DM) + lane_;
#pragma unroll
            for (int j = 0; j < 4; ++j) o8[64 * j] = (unsigned long long)pk2(v[t][j].x, v[t][j].y) | ((unsigned long long)pk2(v[t][j].z, v[t][j].w) << 32);
            if (lane_ < 16) rowsq[(size_t)m * 16 + lane_] = lane_ == 0 ? s[t] : 0.f; }
    }
}
__device__ __forceinline__ void norm_rows_f32(Frame& F, const bf16* src, const float* g, float* out) {
    const int tid_ = fresh_tid(), lane_ = tid_ & 63, wave_ = __builtin_amdgcn_readfirstlane(tid_ >> 6);
    const int gw = vcu_id() * NWAVES + wave_, NGW = grid_n() * NWAVES;
    f32x4 gv[4];
#pragma unroll
    for (int j = 0; j < 4; ++j) gv[j] = ((const GAS f32x4*)g)[lane_ + 64 * j];
    for (int m0 = gw; m0 < M; m0 += 2 * NGW) {
        const int m1 = (m0 + NGW < M) ? m0 + NGW : m0;
        v2u w[2][4];
#pragma unroll
        for (int t = 0; t < 2; ++t) { const GAS v2u* xr = (const GAS v2u*)(src + (size_t)(t ? m1 : m0) * DM) + lane_;
#pragma unroll
            for (int j = 0; j < 4; ++j) w[t][j] = xr[64 * j]; }
#pragma unroll
        for (int t = 0; t < 2; ++t) { f32x4 v[4]; float s = 0.f;
#pragma unroll
            for (int j = 0; j < 4; ++j) { v[j].x = __builtin_bit_cast(float, w[t][j].x << 16); v[j].y = __builtin_bit_cast(float, w[t][j].x & 0xffff0000u);
                v[j].z = __builtin_bit_cast(float, w[t][j].y << 16); v[j].w = __builtin_bit_cast(float, w[t][j].y & 0xffff0000u);
                s += (v[j].x * v[j].x + v[j].y * v[j].y) + (v[j].z * v[j].z + v[j].w * v[j].w); }
            const float rstd = __builtin_amdgcn_rsqf(wave_sum(s) * (1.f / DM) + RMS_EPS);
            GAS f32x4* o = (GAS f32x4*)(out + (size_t)(t ? m1 : m0) * DM) + lane_;
#pragma unroll
            for (int j = 0; j < 4; ++j) o[64 * j] = v[j] * rstd * gv[j]; }
    }
}

constexpr int RSTD_OFF = MISC_OFF + 512;
static_assert(RSTD_OFF + 8 * 256 * 4 <= LDS_BYTES, "rstd table");
__device__ __forceinline__ void rstd_prepass(Frame& F, const pg8::StaticOrder& S, const float* rsq) {
    const int tid_ = fresh_tid(); LAS float* tab = (LAS float*)(F.lds + RSTD_OFF);
    for (int idx = tid_; idx < 8 * 256; idx += NWAVES * 64) { pg8::Unit u; if (!S.next(idx >> 8, u)) break; tab[idx] = pg8::row_rstd(rsq, u.pm * 256 + (idx & 255)); }
    __syncthreads();
}

#ifdef PROBE_EXTRA_BARRIER
#define PROBE_XBAR asm volatile("s_barrier" ::: "memory")
#else
#define PROBE_XBAR do {} while (0)
#endif
#ifdef PROBE_EXTRA_EXP
#define PROBE_XEXP(x) do { float t_; asm volatile("v_exp_f32 %0, %1" : "=v"(t_) : "v"(x)); } while (0)
#else
#define PROBE_XEXP(x) do {} while (0)
#endif
namespace att {
typedef float f32x8 __attribute__((ext_vector_type(8)));
typedef unsigned u32x4 __attribute__((ext_vector_type(4)));
constexpr float THRL = 8.f * 1.4426950408889634f;
constexpr int SHM_V = 16384, SHM_K = 16384;
constexpr int OFF_V = 0, OFF_K = 2 * SHM_V;
constexpr int RK = 0, RV = 3 * SHM_K;
constexpr int OFF_WS = 7 * SHM_K, TAB_N = 384, OFF_LAM = OFF_WS + 2048, OFF_G3 = OFF_LAM + 256, OFF_END = OFF_G3 + 1024;
constexpr int OFF_TAB = MISC_OFF + 512 + 8 * 256 * 4 + 64;
static_assert(OFF_END <= RING_BYTES && OFF_TAB + 4 * TAB_N * 4 <= LDS_BYTES, "attention LDS map");
#define KSWZ(row, colB) ((row) * 256 + ((colB) ^ (((row) & 7) << 4)))
#define SBAR() __builtin_amdgcn_sched_barrier(0)
__device__ __forceinline__ int crow(int r, int hi) { return (r & 3) + 8 * (r >> 2) + 4 * hi; }
__device__ __forceinline__ unsigned cvtpk(float lo, float hi) { unsigned r; asm volatile("v_cvt_pk_bf16_f32 %0, %1, %2" : "=v"(r) : "v"(lo), "v"(hi)); return r; }
template <bool F32> struct Stage;
template <> struct Stage<false> { using E = bf16; using T = bf16x8;
  __device__ static __forceinline__ T ld8(const E* p) { return *reinterpret_cast<const bf16x8*>(p); }
  __device__ static __forceinline__ bf16x8 tobf(T x) { return x; } };
template <> struct Stage<true> { using E = float; using T = f32x8;
  __device__ static __forceinline__ T ld8(const E* p) { return *reinterpret_cast<const f32x8*>(p); }
  __device__ static __forceinline__ bf16x8 tobf(T x) { u32x4 w = {cvtpk(x[0], x[1]), cvtpk(x[2], x[3]), cvtpk(x[4], x[5]), cvtpk(x[6], x[7])}; return __builtin_bit_cast(bf16x8, w); } };

__device__ __forceinline__ float rowmax32(const f32x16& p0, const f32x16& p1) {
  float pmax = p0[0];
#pragma unroll
  for (int r = 1; r < 16; ++r) pmax = fmaxf(pmax, p0[r]);
#pragma unroll
  for (int r = 0; r < 16; ++r) pmax = fmaxf(pmax, p1[r]);
  auto rr = __builtin_amdgcn_permlane32_swap(__float_as_uint(pmax), __float_as_uint(pmax), false, false);
  return fmaxf(__uint_as_float(rr[0]), __uint_as_float(rr[1]));
}
__device__ __forceinline__ void partialSM(f32x16& p0, f32x16& p1, float& m_reg, float& mn, float& alpha) {
  const float pmax = rowmax32(p0, p1);
  if (__builtin_expect(__all(pmax - m_reg <= THRL), 1)) { mn = m_reg; alpha = 1.f; }
  else { mn = fmaxf(m_reg, pmax); alpha = __builtin_amdgcn_exp2f(m_reg - mn); m_reg = mn; }
#pragma unroll
  for (int r = 0; r < 16; ++r) p0[r] -= mn;
#pragma unroll
  for (int r = 0; r < 16; ++r) p1[r] -= mn;
#pragma unroll
  for (int r = 0; r < 16; ++r) p0[r] = __builtin_amdgcn_exp2f(p0[r]);
}
__device__ __forceinline__ void finishSM(f32x16& p0, f32x16& p1, float alpha, float& l_reg, bf16x8& pa0, bf16x8& pa1, bf16x8& pa2, bf16x8& pa3) {
#pragma unroll
  for (int r = 0; r < 16; ++r) p1[r] = __builtin_amdgcn_exp2f(p1[r]);
  float ps = 0;
#pragma unroll
  for (int r = 0; r < 16; ++r) ps += p0[r];
#pragma unroll
  for (int r = 0; r < 16; ++r) ps += p1[r];
  { auto rr = __builtin_amdgcn_permlane32_swap(__float_as_uint(ps), __float_as_uint(ps), false, false);
    ps = __uint_as_float(rr[0]) + __uint_as_float(rr[1]); }
  l_reg = l_reg * alpha + ps;
#define PK4(P, BASE, OUT) do { unsigned a0 = cvtpk(P[BASE + 0], P[BASE + 1]), a1 = cvtpk(P[BASE + 2], P[BASE + 3]);   \
    unsigned b0 = cvtpk(P[BASE + 4], P[BASE + 5]), b1 = cvtpk(P[BASE + 6], P[BASE + 7]);                              \
    auto r0 = __builtin_amdgcn_permlane32_swap(a0, b0, false, false); auto r1 = __builtin_amdgcn_permlane32_swap(a1, b1, false, false); \
    u32x4 w = {r0[0], r1[0], r0[1], r1[1]}; OUT = __builtin_bit_cast(bf16x8, w); } while (0)
  PK4(p0, 0, pa0); PK4(p0, 8, pa1); PK4(p1, 0, pa2); PK4(p1, 8, pa3);
#undef PK4
}
template <bool QL>
__device__ __forceinline__ void qkt(f32x16& p0, f32x16& p1, const LAS char* Ks, const bf16x8* qr, const LAS char* ql, int r32, int hi, int g) {
  p0 = f32x16{}; p1 = f32x16{};
#pragma unroll
  for (int d0 = 0; d0 < 4; ++d0) { const int cb = ((g * 4 + d0) * 16 + hi * 8) * 2;
    const bf16x8 b0 = *(const LAS bf16x8*)(Ks + KSWZ(r32, cb));
    const bf16x8 b1 = *(const LAS bf16x8*)(Ks + KSWZ(32 + r32, cb));
    bf16x8 q; if constexpr (QL) q = *(const LAS bf16x8*)(ql + d0 * 1024); else q = qr[d0];
    p0 = __builtin_amdgcn_mfma_f32_32x32x16_bf16(b0, q, p0, 0, 0, 0);
    p1 = __builtin_amdgcn_mfma_f32_32x32x16_bf16(b1, q, p1, 0, 0, 0); }
}
__device__ __forceinline__ int v_st(int k, int c) { const int kk = (k & ~0xC) | ((k & 4) << 1) | ((k & 8) >> 1); return ((kk >> 3) * 4 + (c >> 5)) * 512 + ((kk & 7) * 32 + (c & 31)) * 2; }
__device__ __forceinline__ int v_rd_base(int lane) { return ((lane & 3) << 3) | (((lane >> 2) & 3) << 6) | (((lane >> 4) & 1) << 5) | (((lane >> 5) & 1) << 8); }
constexpr int v_rd_off(int d0, int ks, int half) { return d0 * 512 + ks * 4096 + half * 2048; }
typedef short v4i16_t __attribute__((ext_vector_type(4)));
template <int OFF> __device__ __forceinline__ s16x4 tr_read(const LAS char* vb) {
  return __builtin_bit_cast(s16x4, __builtin_amdgcn_ds_read_tr16_b64_v4i16((LAS v4i16_t*)(vb + OFF)));
}
template <int D0> __device__ __forceinline__ void pv_one(f32x16& od, const LAS char* vb, bf16x8 pa0, bf16x8 pa1, bf16x8 pa2, bf16x8 pa3) {
  const s16x4 l0 = tr_read<v_rd_off(D0, 0, 0)>(vb), h0 = tr_read<v_rd_off(D0, 0, 1)>(vb), l1 = tr_read<v_rd_off(D0, 1, 0)>(vb), h1 = tr_read<v_rd_off(D0, 1, 1)>(vb);
  const s16x4 l2 = tr_read<v_rd_off(D0, 2, 0)>(vb), h2 = tr_read<v_rd_off(D0, 2, 1)>(vb), l3 = tr_read<v_rd_off(D0, 3, 0)>(vb), h3 = tr_read<v_rd_off(D0, 3, 1)>(vb);
#define PK(L, H) (bf16x8){L[0], L[1], L[2], L[3], H[0], H[1], H[2], H[3]}
  od = __builtin_amdgcn_mfma_f32_32x32x16_bf16(pa0, PK(l0, h0), od, 0, 0, 0);
  od = __builtin_amdgcn_mfma_f32_32x32x16_bf16(pa1, PK(l1, h1), od, 0, 0, 0);
  od = __builtin_amdgcn_mfma_f32_32x32x16_bf16(pa2, PK(l2, h2), od, 0, 0, 0);
  od = __builtin_amdgcn_mfma_f32_32x32x16_bf16(pa3, PK(l3, h3), od, 0, 0, 0);
#undef PK
}
__device__ __forceinline__ void pv_d0(f32x16* o, const LAS char* vb, bf16x8 pa0, bf16x8 pa1, bf16x8 pa2, bf16x8 pa3) {
  pv_one<0>(o[0], vb, pa0, pa1, pa2, pa3); pv_one<1>(o[1], vb, pa0, pa1, pa2, pa3); pv_one<2>(o[2], vb, pa0, pa1, pa2, pa3); pv_one<3>(o[3], vb, pa0, pa1, pa2, pa3);
}
template <int KS> __device__ __forceinline__ void pv_kstep(f32x16* o, const LAS char* vb, bf16x8 pa) {
  const s16x4 l0 = tr_read<v_rd_off(0, KS, 0)>(vb), h0 = tr_read<v_rd_off(0, KS, 1)>(vb), l1 = tr_read<v_rd_off(1, KS, 0)>(vb), h1 = tr_read<v_rd_off(1, KS, 1)>(vb);
  const s16x4 l2 = tr_read<v_rd_off(2, KS, 0)>(vb), h2 = tr_read<v_rd_off(2, KS, 1)>(vb), l3 = tr_read<v_rd_off(3, KS, 0)>(vb), h3 = tr_read<v_rd_off(3, KS, 1)>(vb);
#define PK(L, H) (bf16x8){L[0], L[1], L[2], L[3], H[0], H[1], H[2], H[3]}
  o[0] = __builtin_amdgcn_mfma_f32_32x32x16_bf16(pa, PK(l0, h0), o[0], 0, 0, 0);
  o[1] = __builtin_amdgcn_mfma_f32_32x32x16_bf16(pa, PK(l1, h1), o[1], 0, 0, 0);
  o[2] = __builtin_amdgcn_mfma_f32_32x32x16_bf16(pa, PK(l2, h2), o[2], 0, 0, 0);
  o[3] = __builtin_amdgcn_mfma_f32_32x32x16_bf16(pa, PK(l3, h3), o[3], 0, 0, 0);
#undef PK
}
struct VF { s16x4 l0, h0, l1, h1, l2, h2, l3, h3; };
template <int KS> __device__ __forceinline__ void vf_load(VF& f, const LAS char* vb) {
  f.l0 = tr_read<v_rd_off(0, KS, 0)>(vb); f.h0 = tr_read<v_rd_off(0, KS, 1)>(vb); f.l1 = tr_read<v_rd_off(1, KS, 0)>(vb); f.h1 = tr_read<v_rd_off(1, KS, 1)>(vb);
  f.l2 = tr_read<v_rd_off(2, KS, 0)>(vb); f.h2 = tr_read<v_rd_off(2, KS, 1)>(vb); f.l3 = tr_read<v_rd_off(3, KS, 0)>(vb); f.h3 = tr_read<v_rd_off(3, KS, 1)>(vb);
}
__device__ __forceinline__ void vf_mma(f32x16* o, const VF& f, bf16x8 pa) {
#define PK(L, H) (bf16x8){L[0], L[1], L[2], L[3], H[0], H[1], H[2], H[3]}
  o[0] = __builtin_amdgcn_mfma_f32_32x32x16_bf16(pa, PK(f.l0, f.h0), o[0], 0, 0, 0);
  o[1] = __builtin_amdgcn_mfma_f32_32x32x16_bf16(pa, PK(f.l1, f.h1), o[1], 0, 0, 0);
  o[2] = __builtin_amdgcn_mfma_f32_32x32x16_bf16(pa, PK(f.l2, f.h2), o[2], 0, 0, 0);
  o[3] = __builtin_amdgcn_mfma_f32_32x32x16_bf16(pa, PK(f.l3, f.h3), o[3], 0, 0, 0);
#undef PK
}
__device__ __forceinline__ void pv_ks(f32x16* o, const LAS char* vb, bf16x8 pa0, bf16x8 pa1, bf16x8 pa2, bf16x8 pa3) {
  pv_kstep<0>(o, vb, pa0); pv_kstep<1>(o, vb, pa1); pv_kstep<2>(o, vb, pa2); pv_kstep<3>(o, vb, pa3);
}

__device__ __forceinline__ int t5_bucket(int rel) {
  const int ret = rel > 0 ? 16 : 0; const int n = rel < 0 ? -rel : rel;
  if (n < 8) return ret + n;
  int large = 8 + (31 - __builtin_clz((unsigned)(n * n))) - 6; if (large > 15) large = 15;
  return ret + large;
}
__device__ __forceinline__ void attn_setup_tab(LAS unsigned char* lds, const float* rel_bias) {
  const int tid = fresh_tid();
  LAS float* tab = (LAS float*)(lds + OFF_TAB);
  for (int e = tid; e < 4 * TAB_N; e += 512) { const int h = e / TAB_N, idx = e % TAB_N, rel = idx - 255;
    tab[e] = (rel_bias[t5_bucket(rel) * 4 + h] - rel_bias[15 * 4 + h]) * 1.4426950408889634f; }
}
__device__ __forceinline__ void attn_setup(LAS unsigned char* lds, const float* lamp  , int layer) {
  const int tid = fresh_tid();
  if (tid < 64) { const float a = lamp[tid] * lamp[64 + tid], b = lamp[128 + tid] * lamp[192 + tid];
    const float sa = wave_sum(a), sb = wave_sum(b);
    if (tid == 0) { const float lam_init = 0.8f - 0.6f * expf(-0.3f * (float)layer);
      ((LAS float*)(lds + OFF_LAM))[0] = expf(sa) - expf(sb) + lam_init; ((LAS float*)(lds + OFF_LAM))[1] = 1.f - lam_init; } }
  __syncthreads();
}


__device__ __forceinline__ void glds16(const void* gsrc, unsigned lds_dst) { unsigned keep;
  asm volatile("s_mov_b32 %0, m0\n\ts_mov_b32 m0, %2\n\ts_nop 0\n\tglobal_load_lds_dwordx4 %1, off\n\ts_mov_b32 m0, %0" : "=&s"(keep) : "v"(gsrc), "s"(lds_dst) : "memory"); }
template <int IMM> __device__ __forceinline__ void glds16_s(const void* sbase, unsigned voff, unsigned lds_dst) { unsigned keep;
  asm volatile("s_mov_b32 %0, m0\n\ts_mov_b32 m0, %3\n\ts_nop 0\n\tglobal_load_lds_dwordx4 %1, %2 offset:%4\n\ts_mov_b32 m0, %0" : "=&s"(keep) : "v"(voff), "s"(sbase), "s"(lds_dst), "i"(IMM) : "memory"); }
__device__ __forceinline__ void glds16_pair(const void* sbase, unsigned voffA, unsigned voffB_minus_1024, unsigned lds_dst) {
  asm volatile("s_mov_b32 m0, %3\n\ts_nop 0\n\tglobal_load_lds_dwordx4 %0, %2 offset:0\n\tglobal_load_lds_dwordx4 %1, %2 offset:1024" :: "v"(voffA), "v"(voffB_minus_1024), "s"(sbase), "s"(lds_dst) : "memory", "m0"); }
template <bool SAFE>
__device__ __forceinline__ bool attn_unit_prompt_t(LAS unsigned char* lds, const bf16* Kg, const bf16* Vg, const bf16* Qrow0, bf16* Orow0, int NT, int qpos0, int h, const float* gnorm) {
  constexpr int LDK = 3328;
  const int tid = fresh_tid(), wid = __builtin_amdgcn_readfirstlane(tid >> 6), lane = tid & 63, r32 = lane & 31, hi = lane >> 5;
  const int g = wid >> 2, rb = wid & 3;
  volatile LAS int* badflag = (volatile LAS int*)(lds + OFF_G3);
  if (!SAFE && tid == 0) *badflag = 0;
  int zflag; asm volatile("s_mov_b32 %0, 0" : "=s"(zflag));
  LAS char* K_lds = (LAS char*)lds + RK; LAS char* V_lds = (LAS char*)lds + RV;
  LAS float* wsf = (LAS float*)(lds + OFF_WS) + wid * 64; LAS float* li_l = wsf; LAS float* al_l = wsf + 32;
  const LAS float* tab = (const LAS float*)(lds + OFF_TAB) + h * TAB_N;
  float mhat = 0.f; f32x16 o[4] = {}; f32x4 osum = {}; f32x16 negm = {}; bf16x8 qr[4];
  const bf16* Qw = Qrow0 + (size_t)(rb * 32 + r32) * 3328 + g * 64 + hi * 8;
#pragma unroll
  for (int d0 = 0; d0 < 4; ++d0) qr[d0] = *reinterpret_cast<const bf16x8*>(Qw + d0 * 16);
  const int qpos = qpos0 + rb * 32 + r32;
  unsigned kso0, kso1, vso0;
  { const int row = 8 * wid + (lane >> 4); kso0 = (unsigned)(row * LDK * 2 + (((lane & 15) ^ (row & 7)) << 4)); kso1 = kso0 + (unsigned)(4 * LDK * 2) + ((kso0 & 64u) ? (unsigned)-64 : 64u);
    const int kk = wid * 8 + ((lane & 31) >> 2), k = kk, c = (lane >> 5) * 32 + (lane & 3) * 8; vso0 = (unsigned)((k * LDK + c) * 2); }
  const int pw = wid * 2048; const unsigned kl0 = (unsigned)(uintptr_t)K_lds, vl0 = (unsigned)(uintptr_t)V_lds;
  const unsigned kso1m = kso1 - 1024u, vsoA = vso0 + 1024u, vsoB = vso0 + 128u;
#define DMA_K(t, so) do { const char* kb_ = (const char*)(Kg + (size_t)(t) * 64 * LDK); \
    glds16_pair(kb_, kso0, kso1m, (unsigned)__builtin_amdgcn_readfirstlane((int)(kl0 + (unsigned)((so) + pw)))); } while (0)
#define DMA_V(t, so) do { const char* vb_ = (const char*)(Vg + (size_t)(t) * 64 * LDK) - 1024; \
    glds16_pair(vb_, vsoA, vsoB, (unsigned)__builtin_amdgcn_readfirstlane((int)(vl0 + (unsigned)((so) + pw)))); } while (0)
#define WAITBAR(j) do { if ((j) + 2 < NT) asm volatile("s_waitcnt vmcnt(4)\n\ts_barrier" ::: "memory"); else asm volatile("s_waitcnt vmcnt(0)\n\ts_barrier" ::: "memory"); } while (0)
#define RESC(a) do { if (__any((a) < 1.f)) { if (hi == 0) al_l[r32] = (a); asm volatile("s_waitcnt lgkmcnt(0)" ::: "memory"); \
    _Pragma("unroll") for (int d = 0; d < 4; ++d) _Pragma("unroll") for (int r = 0; r < 16; ++r) o[d][r] *= al_l[crow(r, hi)]; \
    _Pragma("unroll") for (int r = 0; r < 4; ++r) osum[r] *= al_l[4 * (lane >> 4) + r + 16 * (lane & 1)]; } } while (0)
#define QKT(P0, P1, Ks) do { const LAS char* ks_ = (Ks); \
    _Pragma("unroll") for (int d0 = 0; d0 < 4; ++d0) { const int cb = ((g * 4 + d0) * 16 + hi * 8) * 2; \
      const bf16x8 b0 = *(const LAS bf16x8*)(ks_ + KSWZ(r32, cb)); const bf16x8 b1 = *(const LAS bf16x8*)(ks_ + KSWZ(32 + r32, cb)); \
      if (d0 == 0) { P0 = __builtin_amdgcn_mfma_f32_32x32x16_bf16(b0, qr[0], negm, 0, 0, 0); P1 = __builtin_amdgcn_mfma_f32_32x32x16_bf16(b1, qr[0], negm, 0, 0, 0); } \
      else { P0 = __builtin_amdgcn_mfma_f32_32x32x16_bf16(b0, qr[d0], P0, 0, 0, 0); P1 = __builtin_amdgcn_mfma_f32_32x32x16_bf16(b1, qr[d0], P1, 0, 0, 0); } } } while (0)
#define KFR(d0, half) (*(const LAS bf16x8*)(ks_ + KSWZ(32 * (half) + r32, ((g * 4 + (d0)) * 16 + hi * 8) * 2)))
#define KPRE(Ks) const LAS char* ks_ = (Ks); const bf16x8 k00_ = KFR(0, 0), k01_ = KFR(0, 1), k10_ = KFR(1, 0), k11_ = KFR(1, 1)
#define QKT2(P0, P1) do { P0 = __builtin_amdgcn_mfma_f32_32x32x16_bf16(k00_, qr[0], negm, 0, 0, 0); P1 = __builtin_amdgcn_mfma_f32_32x32x16_bf16(k01_, qr[0], negm, 0, 0, 0); \
    const bf16x8 k20_ = KFR(2, 0), k21_ = KFR(2, 1), k30_ = KFR(3, 0), k31_ = KFR(3, 1); SBAR(); \
    P0 = __builtin_amdgcn_mfma_f32_32x32x16_bf16(k10_, qr[1], P0, 0, 0, 0); P1 = __builtin_amdgcn_mfma_f32_32x32x16_bf16(k11_, qr[1], P1, 0, 0, 0); SBAR(); \
    P0 = __builtin_amdgcn_mfma_f32_32x32x16_bf16(k20_, qr[2], P0, 0, 0, 0); P1 = __builtin_amdgcn_mfma_f32_32x32x16_bf16(k21_, qr[2], P1, 0, 0, 0); \
    P0 = __builtin_amdgcn_mfma_f32_32x32x16_bf16(k30_, qr[3], P0, 0, 0, 0); P1 = __builtin_amdgcn_mfma_f32_32x32x16_bf16(k31_, qr[3], P1, 0, 0, 0); SBAR(); } while (0)
#define PARTIAL(P0, P1, AL, FIRST, RMV) do { const float rm_ = (RMV); AL = 1.f; \
    if ((FIRST) || (SAFE ? __any(rm_ > THRL) : (zflag != 0))) { asm volatile("; reference moves" ::: "memory"); \
      const float nm_ = mhat + ((FIRST) ? rm_ : fmaxf(rm_, 0.f)); const float dl_ = nm_ - mhat; mhat = nm_; \
      _Pragma("unroll") for (int r = 0; r < 16; ++r) { P0[r] -= dl_; P1[r] -= dl_; } \
      _Pragma("unroll") for (int r = 0; r < 16; ++r) negm[r] -= dl_; \
      if (!(FIRST)) { AL = __builtin_amdgcn_exp2f(-dl_); } } \
    _Pragma("unroll") for (int r = 0; r < 16; ++r) { PROBE_XEXP(P0[r]); PROBE_XEXP(P1[r]); P0[r] = __builtin_amdgcn_exp2f(P0[r]); } } while (0)
#define PK4_(P, BASE, OUT) do { u32x4 w = {cvtpk(P[BASE + 0], P[BASE + 1]), cvtpk(P[BASE + 2], P[BASE + 3]), cvtpk(P[BASE + 4], P[BASE + 5]), cvtpk(P[BASE + 6], P[BASE + 7])}; \
    OUT = __builtin_bit_cast(bf16x8, w); } while (0)
#define BIASMASK(P0, P1, j) do { if ((j) >= NT - 4) { const bool msk_ = ((j) == NT - 1 && rb < 2); \
    if (msk_) { _Pragma("unroll") for (int r = 0; r < 16; ++r) { P0[r] = -1e30f; P1[r] = -1e30f; } } \
    else { const int base_ = 64 * (j) - qpos + 255 + 4 * hi; \
      _Pragma("unroll") for (int r = 0; r < 16; ++r) { const int i0_ = base_ + (r & 3) + 8 * (r >> 2); P0[r] += tab[i0_]; P1[r] += tab[i0_ + 32]; } } } } while (0)
#define ROT() do { const int t_ = s0; s0 = s1; s1 = s2; s2 = t_; } while (0)
  const LAS char* vrd = V_lds + v_rd_base(lane);
#define ONESMMA(pa) osum = __builtin_amdgcn_mfma_f32_16x16x32_bf16(pa, ones, osum, 0, 0, 0)
#define FINISH_PV(P0, P1, vp, C0, C1, RM) do { const LAS char* vp_ = (vp); VF fa_, fb_; \
    vf_load<0>(fa_, vp_); \
    _Pragma("unroll") for (int r = 0; r < 16; ++r) P1[r] = __builtin_amdgcn_exp2f(P1[r]); \
    bf16x8 pa_; PK4_(P0, 0, pa_); vf_load<1>(fb_, vp_); vf_mma(o, fa_, pa_); ONESMMA(pa_); \
    PK4_(P0, 8, pa_); vf_load<2>(fa_, vp_); vf_mma(o, fb_, pa_); ONESMMA(pa_); \
    if (SAFE) RM = rowmax32(C0, C1); \
    PK4_(P1, 0, pa_); vf_load<3>(fb_, vp_); vf_mma(o, fa_, pa_); ONESMMA(pa_); \
    PK4_(P1, 8, pa_); vf_mma(o, fb_, pa_); ONESMMA(pa_); } while (0)
  const short one_ = (((lane >> 4) & 1) == (lane & 1)) ? (short)16256 : (short)0;
  const bf16x8 ones = {one_, one_, one_, one_, one_, one_, one_, one_};
  f32x16 pA0, pA1, pB0, pB1; float alA = 1.f, alB = 1.f, rmx;
  int s0 = 2 * SHM_K, s1 = 0, s2 = SHM_K;
  if (wid >= 4) __builtin_amdgcn_s_setprio(1);
#define VS(t) (((t) & 3) * SHM_V)
  DMA_K(0, 0); DMA_V(0, VS(0)); DMA_K(1, SHM_K); DMA_V(1, VS(1));
  asm volatile("" :: "v"(qr[0]), "v"(qr[1]), "v"(qr[2]), "v"(qr[3]) : "memory");
#ifdef ATT_SKEW
#define WB1(j) do { if ((j) + 2 < NT) asm volatile("s_waitcnt vmcnt(6)\n\ts_barrier" ::: "memory"); else asm volatile("s_waitcnt vmcnt(0)\n\ts_barrier" ::: "memory"); } while (0)
#define WB2(j) do { if ((j) + 2 < NT) asm volatile("s_waitcnt vmcnt(4)\n\ts_barrier" ::: "memory"); else asm volatile("s_waitcnt vmcnt(0)\n\ts_barrier" ::: "memory"); } while (0)
  const int ph = wid >> 2;
  if (ph != 0) { asm volatile("s_waitcnt vmcnt(6)\n\ts_barrier" ::: "memory"); }
  WB1(0); DMA_K(2, s0);
  QKT(pA0, pA1, K_lds + s1);
  WB2(0); DMA_V(2, VS(2));
  BIASMASK(pA0, pA1, 0); rmx = rowmax32(pA0, pA1); PARTIAL(pA0, pA1, alA, true, rmx);
  ROT();
#else
  WAITBAR(0); DMA_K(2, s0); DMA_V(2, VS(2));
  QKT(pA0, pA1, K_lds + s1); BIASMASK(pA0, pA1, 0); rmx = rowmax32(pA0, pA1); PARTIAL(pA0, pA1, alA, true, rmx);
  ROT();
#endif
#ifdef ATT_SKEW
#define HALFSTEP(C0, C1, Q0, Q1, ALC, jj, BAND) do { \
    if (BAND) { WB1(jj); } else { asm volatile("s_waitcnt vmcnt(6)\n\ts_barrier" ::: "memory"); } \
    KPRE(K_lds + s1); SBAR(); \
    if (!(BAND) || (jj) + 2 < NT) { DMA_K((jj) + 2, s0); } \
    SBAR(); QKT2(C0, C1); SBAR(); \
    if (BAND) { WB2(jj); } else { asm volatile("s_waitcnt vmcnt(4)\n\ts_barrier" ::: "memory"); } \
    if (!(BAND) || (jj) + 2 < NT) { DMA_V((jj) + 2, VS((jj) + 2)); } \
    if (BAND) { BIASMASK(C0, C1, jj); } \
    FINISH_PV(Q0, Q1, vrd + VS((jj) - 1), C0, C1, rmx); \
    PARTIAL(C0, C1, ALC, false, rmx); RESC(ALC); ROT(); } while (0)
#else
#define HALFSTEP(C0, C1, Q0, Q1, ALC, jj, BAND) do { \
    if (BAND) { WAITBAR(jj); } else { asm volatile("s_waitcnt vmcnt(4)\n\ts_barrier" ::: "memory"); } \
    KPRE(K_lds + s1); SBAR(); \
    if (BAND) { if ((jj) + 2 < NT) { DMA_K((jj) + 2, s0); DMA_V((jj) + 2, VS((jj) + 2)); } } \
    else { DMA_K((jj) + 2, s0); DMA_V((jj) + 2, VS((jj) + 2)); } \
    SBAR(); QKT2(C0, C1); PROBE_XBAR; \
    if (BAND) { BIASMASK(C0, C1, jj); } \
    FINISH_PV(Q0, Q1, vrd + VS((jj) - 1), C0, C1, rmx); \
    PARTIAL(C0, C1, ALC, false, rmx); RESC(ALC); ROT(); } while (0)
#endif
  int j = 1;
  for (; j + 1 < NT - 4; j += 2) { HALFSTEP(pB0, pB1, pA0, pA1, alB, j, false); HALFSTEP(pA0, pA1, pB0, pB1, alA, j + 1, false); }
  for (; j + 1 < NT; j += 2) { HALFSTEP(pB0, pB1, pA0, pA1, alB, j, true); HALFSTEP(pA0, pA1, pB0, pB1, alA, j + 1, true); }
#undef HALFSTEP
#ifdef ATT_SKEW
  WB1(NT - 1);
  QKT(pB0, pB1, K_lds + s1);
  WB2(NT - 1); BIASMASK(pB0, pB1, NT - 1);
#else
  WAITBAR(NT - 1);
  QKT(pB0, pB1, K_lds + s1); BIASMASK(pB0, pB1, NT - 1);
#endif
  FINISH_PV(pA0, pA1, vrd + VS(NT - 2), pB0, pB1, rmx); PARTIAL(pB0, pB1, alB, false, rmx); RESC(alB);
  FINISH_PV(pB0, pB1, vrd + VS(NT - 1), pB0, pB1, rmx);
#ifdef ATT_SKEW
  if (ph == 0) { asm volatile("s_barrier" ::: "memory"); }
#undef WB1
#undef WB2
#endif
#undef DMA_K
#undef DMA_V
#undef WAITBAR
#undef RESC
#undef BIASMASK
#undef ROT
#undef VS
#undef QKT
#undef QKT2
#undef KPRE
#undef KFR
#undef PARTIAL
#undef FINISH_PV
#undef ONESMMA
#undef PK4_
  __builtin_amdgcn_s_setprio(0);
  float rli[16];
  if ((lane & 15) < 2) {
#pragma unroll
    for (int r = 0; r < 4; ++r) li_l[4 * (lane >> 4) + r + 16 * (lane & 15)] = osum[r]; }
#pragma unroll
  for (int r = 0; r < 16; ++r) rli[r] = __builtin_amdgcn_rcpf(li_l[crow(r, hi)]);
  bool bad = false;
  if (!SAFE) {
#pragma unroll
    for (int r = 0; r < 4; ++r) bad |= !(osum[r] < 3e38f); }
  __syncthreads();
  LAS float* X = (LAS float*)lds + rb * 4096 + lane;
  if (g == 1) {
#pragma unroll
    for (int r = 0; r < 16; ++r)
#pragma unroll
      for (int d0 = 0; d0 < 4; ++d0) X[(r * 4 + d0) * 64] = o[d0][r] * rli[r];
  }
  __syncthreads();
  if (g == 0) {
    const float lam = ((const LAS float*)(lds + OFF_LAM))[0], osc = ((const LAS float*)(lds + OFF_LAM))[1];
    float ss[16];
#pragma unroll
    for (int r = 0; r < 16; ++r) { float s = 0.f;
#pragma unroll
      for (int d0 = 0; d0 < 4; ++d0) { const float od = o[d0][r] * rli[r] - lam * X[(r * 4 + d0) * 64]; o[d0][r] = od; s += od * od; }
      ss[r] = s; if (!SAFE) bad |= !(s < 3e38f); }
#pragma unroll
    for (int r = 0; r < 16; ++r) { float s = ss[r]; s += __shfl_xor(s, 1); s += __shfl_xor(s, 2); s += __shfl_xor(s, 4); s += __shfl_xor(s, 8); s += __shfl_xor(s, 16);
      ss[r] = osc * __builtin_amdgcn_rsqf(s * (1.f / 128.f) + RMS_EPS); }
    float gn[4];
#pragma unroll
    for (int d0 = 0; d0 < 4; ++d0) gn[d0] = gnorm[d0 * 32 + r32];
    bf16* Ow = Orow0 + (size_t)(rb * 32) * 1024 + r32;
#pragma unroll
    for (int r = 0; r < 16; ++r) { const int orow = crow(r, hi);
#pragma unroll
      for (int d0 = 0; d0 < 4; ++d0) Ow[(size_t)orow * 1024 + d0 * 32] = (bf16)(cvtpk(o[d0][r] * ss[r] * gn[d0], 0.f) & 0xffffu); }
  }
  if (!SAFE) { if (__any(bad)) { if (lane == 0) *badflag = 1; } }
  __syncthreads();
#ifdef PROBE_FORCE_FALLBACK
  if (!SAFE) return (__builtin_amdgcn_readfirstlane(*badflag) != 0) || (h == 1) || ((NT & 6) == 2);
#endif
  if (!SAFE) return __builtin_amdgcn_readfirstlane(*badflag) != 0;
  return false;
}

__device__ __forceinline__ void attn_unit_sample(LAS unsigned char* lds, const float* Kg, const float* Vg, const float* Kl, const float* Vl, const bf16* Qrow0, bf16* Orow0,
                                                 int qpos0, int h, const float* gnorm) {
  using St = Stage<true>; constexpr int LDK = 512, NT = 65;
  const int tid = fresh_tid(), wid = __builtin_amdgcn_readfirstlane(tid >> 6), lane = tid & 63, r32 = lane & 31, hi = lane >> 5;
  const int g = wid & 1, rb = (wid >> 1) & 1; const bool live = wid < 4;
  LAS char* V_lds = (LAS char*)lds + OFF_V; LAS char* K_lds = (LAS char*)lds + OFF_K;
  LAS float* wsf = (LAS float*)(lds + OFF_WS) + wid * 64; LAS float* li_l = wsf; LAS float* al_l = wsf + 32;
  const LAS float* tab = (const LAS float*)(lds + OFF_TAB) + h * TAB_N;
  float l_reg = 0; f32x16 o[4] = {};
#define BARRIER1() asm volatile("s_waitcnt lgkmcnt(0)\n\ts_barrier" ::: "memory")
  if (!live) {
    const int lt = tid - 256, sr = lt >> 4, sc = (lt & 15) * 8;
    typename St::T A[8], B[8], C[8];
#define LLOAD(X, t) do { const float* kb_ = (t) < 64 ? Kg + (size_t)(t) * 64 * LDK : Kl; const float* vb_ = (t) < 64 ? Vg + (size_t)(t) * 64 * LDK : Vl; \
      _Pragma("unroll") for (int i_ = 0; i_ < 4; ++i_) { X[i_] = St::ld8(vb_ + (size_t)(sr + 16 * i_) * LDK + sc); X[4 + i_] = St::ld8(kb_ + (size_t)(sr + 16 * i_) * LDK + sc); } } while (0)
#define LWRITE(X, b) do { _Pragma("unroll") for (int i_ = 0; i_ < 4; ++i_) { *(LAS bf16x8*)(V_lds + (b) * SHM_V + v_st(sr + 16 * i_, sc)) = St::tobf(X[i_]); \
      *(LAS bf16x8*)(K_lds + (b) * SHM_K + KSWZ(sr + 16 * i_, sc * 2)) = St::tobf(X[4 + i_]); } } while (0)
#define LSTEP(t, Xfree, Xnext, nb) do { const int t_ = (t); \
      if (t_ + 3 < NT) LLOAD(Xfree, t_ + 3); \
      if (t_ + 1 < NT) { if (t_ + 3 < NT) asm volatile("s_waitcnt vmcnt(32)" ::: "memory"); else if (t_ + 2 < NT) asm volatile("s_waitcnt vmcnt(16)" ::: "memory"); else asm volatile("s_waitcnt vmcnt(0)" ::: "memory"); \
        LWRITE(Xnext, nb); } \
      BARRIER1(); } while (0)
    LLOAD(A, 0); LLOAD(B, 1); LLOAD(C, 2);
    asm volatile("s_waitcnt vmcnt(32)" ::: "memory"); LWRITE(A, 0); BARRIER1();
    for (int t = 0; t < NT; t += 6) {
      LSTEP(t, A, B, 1);     if (t + 1 >= NT) break;
      LSTEP(t + 1, B, C, 0); if (t + 2 >= NT) break;
      LSTEP(t + 2, C, A, 1); if (t + 3 >= NT) break;
      LSTEP(t + 3, A, B, 0); if (t + 4 >= NT) break;
      LSTEP(t + 4, B, C, 1); if (t + 5 >= NT) break;
      LSTEP(t + 5, C, A, 0);
    }
#undef LSTEP
#undef LLOAD
#undef LWRITE
  } else {
    float m_reg = -1e30f; bf16x8 qr[4];
    const bf16* Qw = Qrow0 + (size_t)(rb * 32 + r32) * 3328 + g * 64 + hi * 8;
#pragma unroll
    for (int d0 = 0; d0 < 4; ++d0) qr[d0] = *reinterpret_cast<const bf16x8*>(Qw + d0 * 16);
    const int qpos = qpos0 + rb * 32 + r32;
    const LAS char* vb0 = V_lds + v_rd_base(lane);
    BARRIER1();
    for (int j = 0; j < NT; ++j) { const int bsel = j & 1;
      f32x16 p0, p1; float mn, al; bf16x8 pa0, pa1, pa2, pa3;
      qkt<false>(p0, p1, K_lds + bsel * SHM_K, qr, nullptr, r32, hi, g);
      if (j >= NT - 3) { const int base_ = 64 * j - qpos + 255 + 4 * hi;
#pragma unroll
        for (int r = 0; r < 16; ++r) { const int i0_ = base_ + (r & 3) + 8 * (r >> 2); p0[r] += tab[i0_]; p1[r] += tab[i0_ + 32]; } }
      partialSM(p0, p1, m_reg, mn, al);
      if (__any(al < 1.f)) { if (hi == 0) al_l[r32] = al; asm volatile("s_waitcnt lgkmcnt(0)" ::: "memory");
#pragma unroll
        for (int d = 0; d < 4; ++d)
#pragma unroll
          for (int r = 0; r < 16; ++r) o[d][r] *= al_l[crow(r, hi)]; }
      finishSM(p0, p1, al, l_reg, pa0, pa1, pa2, pa3);
      pv_d0(o, vb0 + bsel * SHM_V, pa0, pa1, pa2, pa3);
      BARRIER1(); }
  }
#undef BARRIER1
  __syncthreads();
  if (hi == 0) li_l[r32] = l_reg;
  asm volatile("s_waitcnt lgkmcnt(0)" ::: "memory");
  float rli[16];
#pragma unroll
  for (int r = 0; r < 16; ++r) rli[r] = __builtin_amdgcn_rcpf(li_l[crow(r, hi)]);
  LAS float* X = (LAS float*)lds + rb * 4096 + lane;
  if (live && g == 1) {
#pragma unroll
    for (int r = 0; r < 16; ++r)
#pragma unroll
      for (int d0 = 0; d0 < 4; ++d0) X[(r * 4 + d0) * 64] = o[d0][r] * rli[r];
  }
  __syncthreads();
  if (live && g == 0) {
    const float lam = ((const LAS float*)(lds + OFF_LAM))[0], osc = ((const LAS float*)(lds + OFF_LAM))[1];
    float ss[16];
#pragma unroll
    for (int r = 0; r < 16; ++r) { float s = 0.f;
#pragma unroll
      for (int d0 = 0; d0 < 4; ++d0) { const float od = o[d0][r] * rli[r] - lam * X[(r * 4 + d0) * 64]; o[d0][r] = od; s += od * od; }
      ss[r] = s; }
#pragma unroll
    for (int r = 0; r < 16; ++r) { float s = ss[r]; s += __shfl_xor(s, 1); s += __shfl_xor(s, 2); s += __shfl_xor(s, 4); s += __shfl_xor(s, 8); s += __shfl_xor(s, 16);
      ss[r] = osc * __builtin_amdgcn_rsqf(s * (1.f / 128.f) + RMS_EPS); }
    float gn[4];
#pragma unroll
    for (int d0 = 0; d0 < 4; ++d0) gn[d0] = gnorm[d0 * 32 + r32];
    bf16* Ow = Orow0 + (size_t)(rb * 32) * 1024 + r32;
#pragma unroll
    for (int r = 0; r < 16; ++r) { const int orow = crow(r, hi);
#pragma unroll
      for (int d0 = 0; d0 < 4; ++d0) Ow[(size_t)orow * 1024 + d0 * 32] = (bf16)(cvtpk(o[d0][r] * ss[r] * gn[d0], 0.f) & 0xffffu); }
  }
  __syncthreads();
}
#undef KSWZ
#undef SBAR
}

namespace gla {
constexpr int P72 = 72;
constexpr int L_TOT = 0, L_DL = 2048, L_QT = 4096, L_KT = L_QT + 64 * P72 * 2, L_KDT = L_KT + 64 * P72 * 2, L_A = L_KDT + 64 * P72 * 2, L_VT = L_A + 64 * P72 * 2, L_END = L_VT + 128 * P72 * 2;
static_assert(L_END <= RING_BYTES, "gla LDS map");
__device__ __forceinline__ int crow(int r, int hi) { return (r & 3) + 8 * (r >> 2) + 4 * hi; }
typedef float cvf2_t __attribute__((ext_vector_type(2)));
typedef __bf16 cvb2_t __attribute__((ext_vector_type(2)));
__device__ __forceinline__ unsigned cvt2(float lo, float hi) { const cvf2_t v = {lo, hi}; return __builtin_bit_cast(unsigned, __builtin_convertvector(v, cvb2_t)); }
__device__ __forceinline__ v4u pair16(v2u a, v2u b) {
  const auto r0 = __builtin_amdgcn_permlane32_swap(a.x, b.x, false, false); const auto r1 = __builtin_amdgcn_permlane32_swap(a.y, b.y, false, false);
  return (v4u){r0[0], r1[0], r0[1], r1[1]}; }
__device__ __forceinline__ float fexp(float x) { return __builtin_amdgcn_exp2f(x * 1.4426950408889634f); }
__device__ __forceinline__ float logsig(float z) { return fminf(z, 0.f) - 0.6931471805599453f * __builtin_amdgcn_logf(1.f + __builtin_amdgcn_exp2f(-1.4426950408889634f * fabsf(z))); }
__device__ __forceinline__ bf16x8 ldsfrag(const LAS unsigned char* img, int row, int k0) { return *(const LAS bf16x8*)(img + (row * P72 + k0) * 2); }

#define G1IN_DECL(p) float p##z[8]; unsigned p##qk[8]; bf16x8 p##v0, p##v1; float p##bal
#define G1IN_ARGS(p) p##z, p##qk, p##v0, p##v1, p##bal
__device__ __forceinline__ void g1_load(float (&z)[8], unsigned (&qk)[8], bf16x8& v0, bf16x8& v1, float& bal, int c, int h, const bf16* ACT, const float* LOGA, const float* balpha) {
    const int tid = fresh_tid(), lane = tid & 63, t0 = 8 * (tid >> 6), row0 = 64 * c;
    bal = balpha[h * 64 + lane];
#pragma unroll
    for (int i = 0; i < 8; ++i) z[i] = LOGA[(size_t)(row0 + t0 + i) * 256 + h * 64 + lane];
#pragma unroll
    for (int i = 0; i < 8; ++i) qk[i] = *(const unsigned*)(ACT + (size_t)(row0 + t0 + i) * NIN + 2 * (h * 64 + lane));
    { const int s = lane, jc = (tid >> 6) * 8; v0 = *(const bf16x8*)(ACT + (size_t)(row0 + s) * NIN + 768 + h * 128 + jc); v1 = *(const bf16x8*)(ACT + (size_t)(row0 + s) * NIN + 768 + h * 128 + 64 + jc); }
}
template <bool PF>
__device__ __forceinline__ void g1_unit(LAS unsigned char* lds, const float (&inz)[8], const unsigned (&inqk)[8], const bf16x8& inv0, const bf16x8& inv1, const float& inbal, int c, int h, int layer,
                                        bf16* UT, float* Dw, bf16* OI, bf16* QT, bf16* SCT, const float* state_in  , float* state_out  ,
                                        float (&nz)[8], unsigned (&nqk)[8], bf16x8& nv0, bf16x8& nv1, float& nbal, int cn, int hn, const bf16* ACT, const float* LOGA, const float* balpha) {
    const int tid = fresh_tid(), wid = __builtin_amdgcn_readfirstlane(tid >> 6), lane = tid & 63, r = lane & 31, hh = lane >> 5;
    const int row0 = 64 * c;
    LAS float* TOT = (LAS float*)(lds + L_TOT); LAS float* DL = (LAS float*)(lds + L_DL);
    LAS unsigned char* Qi = lds + L_QT; LAS unsigned char* Ki = lds + L_KT; LAS unsigned char* KDi = lds + L_KDT; LAS unsigned char* Ai = lds + L_A; LAS unsigned char* Vi = lds + L_VT;
    { const int d = lane, tg = wid, t0 = 8 * tg;
      const float bal = inbal;
      float cs[8]; float run = 0.f;
#pragma unroll
      for (int i = 0; i < 8; ++i) { const float z = inz[i] + bal; run += logsig(z) * 0.0625f; cs[i] = run; }
      float qv[8], kv[8];
#pragma unroll
      for (int i = 0; i < 8; ++i) { qv[i] = bf2f((unsigned short)(inqk[i] & 0xffffu)); kv[i] = bf2f((unsigned short)(inqk[i] >> 16)); }
      TOT[tg * 64 + d] = run;
#pragma unroll
      for (int k = 0; k < 2; ++k) { const int s = lane, jc = wid * 8 + 64 * k;
        const bf16x8 v = k ? inv1 : inv0;
#pragma unroll
        for (int e = 0; e < 8; ++e) *(LAS short*)(Vi + ((jc + e) * P72 + s) * 2) = v[e]; }
      __syncthreads();
      if constexpr (PF) g1_load(nz, nqk, nv0, nv1, nbal, cn, hn, ACT, LOGA, balpha);
      float off = 0.f, blast = 0.f;
#pragma unroll
      for (int g2 = 0; g2 < 8; ++g2) { const float tv = TOT[g2 * 64 + d]; blast += tv; if (g2 < tg) off += tv; }
      unsigned kd[4];
      float kdf[8];
#pragma unroll
      for (int i = 0; i < 8; ++i) { const float b = off + cs[i]; const float eb = fexp(b);
        const float qt = qv[i] * 0.125f * eb, kt = kv[i] * fexp(-b); kdf[i] = kv[i] * fexp(blast - b);
        const unsigned qk2_ = cvt2(qt, kt); const unsigned short qb = (unsigned short)(qk2_ & 0xffffu);
        *(LAS unsigned short*)(Qi + ((t0 + i) * P72 + d) * 2) = qb; *(LAS unsigned short*)(Ki + ((t0 + i) * P72 + d) * 2) = (unsigned short)(qk2_ >> 16);
        }
#pragma unroll
      for (int i = 0; i < 4; ++i) kd[i] = cvt2(kdf[2 * i], kdf[2 * i + 1]);
      *(LAS v4u*)(KDi + (d * P72 + t0) * 2) = (v4u){kd[0], kd[1], kd[2], kd[3]};
      if (tg == 0) { const float Dd = fexp(blast); DL[d] = Dd; Dw[(size_t)(c * 4 + h) * 64 + d] = Dd; }
    }
    __syncthreads();
    { const int tq = tid >> 3, cq = (tid & 7) * 8; *(bf16x8*)(QT + (size_t)(row0 + tq) * 256 + h * 64 + cq) = *(const LAS bf16x8*)(Qi + (tq * P72 + cq) * 2); }
    if (wid < 3) { const int sb = (wid == 2), tb = (wid >= 1); f32x16 acc = {};
#pragma unroll
      for (int kk = 0; kk < 4; ++kk) acc = __builtin_amdgcn_mfma_f32_32x32x16_bf16(ldsfrag(Ki, sb * 32 + r, kk * 16 + 8 * hh), ldsfrag(Qi, tb * 32 + r, kk * 16 + 8 * hh), acc, 0, 0, 0);
      const int t = tb * 32 + r;
#pragma unroll
      for (int q = 0; q < 4; ++q) { const int s0 = sb * 32 + 8 * q + 4 * hh; float v[4];
#pragma unroll
        for (int e = 0; e < 4; ++e) v[e] = (s0 + e <= t) ? acc[4 * q + e] : 0.f;
        *(LAS v2u*)(Ai + (t * P72 + s0) * 2) = (v2u){cvt2(v[0], v[1]), cvt2(v[2], v[3])}; }
    } else if (wid == 3) {
#pragma unroll
      for (int q = 0; q < 4; ++q) *(LAS v2u*)(Ai + (r * P72 + 32 + 8 * q + 4 * hh) * 2) = (v2u){0u, 0u};
    } else {
      const int jb = wid - 4, j = jb * 32 + r;
#pragma unroll
      for (int db = 0; db < 2; ++db) { f32x16 acc = {};
#pragma unroll
        for (int kk = 0; kk < 4; ++kk) acc = __builtin_amdgcn_mfma_f32_32x32x16_bf16(ldsfrag(KDi, db * 32 + r, kk * 16 + 8 * hh), ldsfrag(Vi, j, kk * 16 + 8 * hh), acc, 0, 0, 0);
        if (c < NPCH) {
#pragma unroll
          for (int q = 0; q < 4; q += 2) { const int d0 = db * 32 + 8 * q + 8 * hh;
            *(v4u*)(UT + ((size_t)(c * 4 + h) * 128 + j) * 64 + d0) = pair16((v2u){cvt2(acc[4 * q], acc[4 * q + 1]), cvt2(acc[4 * q + 2], acc[4 * q + 3])},
                                                                             (v2u){cvt2(acc[4 * q + 4], acc[4 * q + 5]), cvt2(acc[4 * q + 6], acc[4 * q + 7])}); }
        } else { const int b = c - NPCH; const size_t sbase = (size_t)(b * 4 + h) * 8192;
#pragma unroll
          for (int q = 0; q < 4; ++q) { const int d0 = db * 32 + 8 * q + 4 * hh; float si[4];
#pragma unroll
            for (int e = 0; e < 4; ++e) { si[e] = state_in[sbase + (size_t)(d0 + e) * 128 + j]; state_out[sbase + (size_t)(d0 + e) * 128 + j] = DL[d0 + e] * si[e] + acc[4 * q + e]; }
            *(v2u*)(SCT + ((size_t)(c * 4 + h) * 128 + j) * 64 + d0) = (v2u){cvt2(si[0], si[1]), cvt2(si[2], si[3])}; }
        }
      }
    }
    __syncthreads();
    { const int jb = wid >> 1, tb = wid & 1; f32x16 acc = {};
#pragma unroll
      for (int kk = 0; kk < 4; ++kk) acc = __builtin_amdgcn_mfma_f32_32x32x16_bf16(ldsfrag(Vi, jb * 32 + r, kk * 16 + 8 * hh), ldsfrag(Ai, tb * 32 + r, kk * 16 + 8 * hh), acc, 0, 0, 0);
      bf16* op = OI + (size_t)(row0 + tb * 32 + r) * 512 + h * 128 + jb * 32 + 8 * hh;
#pragma unroll
      for (int q = 0; q < 4; q += 2) *(v4u*)(op + 8 * q) = pair16((v2u){cvt2(acc[4 * q], acc[4 * q + 1]), cvt2(acc[4 * q + 2], acc[4 * q + 3])},
                                                                   (v2u){cvt2(acc[4 * q + 4], acc[4 * q + 5]), cvt2(acc[4 * q + 6], acc[4 * q + 7])}); }
    __syncthreads();
}

__device__ __forceinline__ void g2_group(LAS unsigned char* lds, int eg, const bf16* UT, const float* Dw, bf16* SCT, float* gout  ) {
    const int tid = fresh_tid(); const int el = tid & 127, seg = tid >> 7; const int e = eg * 128 + el; const int h = e >> 13, j = (e >> 6) & 127, d = e & 63;
    LAS float* PL = (LAS float*)lds;
    const size_t ustride = 4 * 128 * 64, dstride = 4 * 64;
    const bf16* up = UT + ((size_t)h * 128 + j) * 64 + d + (size_t)(64 * seg) * ustride; const float* dp = Dw + h * 64 + d + (size_t)(64 * seg) * dstride;
    float Dv[64]; unsigned short Ub[64];
#pragma unroll
    for (int cc = 0; cc < 64; ++cc) Dv[cc] = dp[(size_t)cc * dstride];
#pragma unroll
    for (int cc = 0; cc < 64; ++cc) Ub[cc] = up[(size_t)cc * ustride];
    float P = 1.f, L = 0.f;
#pragma unroll
    for (int cc = 0; cc < 64; ++cc) { L = fmaf(Dv[cc], L, bf2f(Ub[cc])); P *= Dv[cc]; }
    PL[(seg * 128 + el) * 2] = P; PL[(seg * 128 + el) * 2 + 1] = L;
    __syncthreads();
    float S = 0.f;
    for (int s2 = 0; s2 < seg; ++s2) S = fmaf(PL[(s2 * 128 + el) * 2], S, PL[(s2 * 128 + el) * 2 + 1]);
    bf16* sp = SCT + ((size_t)h * 128 + j) * 64 + d + (size_t)(64 * seg) * ustride;
#pragma unroll
    for (int cc = 0; cc < 64; ++cc) { sp[(size_t)cc * ustride] = (bf16)(cvt2(S, S) & 0xffffu); S = fmaf(Dv[cc], S, bf2f(Ub[cc])); }
    if (seg == 3) gout[((size_t)h * 64 + d) * 128 + j] = S;
    __syncthreads();
}

__device__ __forceinline__ void g3_unit(LAS float* part, int c, int h, const bf16* ACT, const bf16* OI, const bf16* QT, const bf16* SCT, const float* gnorm  , bf16* MIX) {
    const int tid = fresh_tid(), wid = __builtin_amdgcn_readfirstlane(tid >> 6), lane = tid & 63, r = lane & 31, hh = lane >> 5;
    const int jb = wid >> 1, tb = wid & 1; const int row = 64 * c + tb * 32 + r;
    f32x16 acc = {};
    const bf16* ap = SCT + ((size_t)(c * 4 + h) * 128 + jb * 32 + r) * 64 + 8 * hh; const bf16* bp = QT + (size_t)row * 256 + h * 64 + 8 * hh;
#pragma unroll
    for (int kk = 0; kk < 4; ++kk) acc = __builtin_amdgcn_mfma_f32_32x32x16_bf16(*(const bf16x8*)(ap + kk * 16), *(const bf16x8*)(bp + kk * 16), acc, 0, 0, 0);
    const int j0 = jb * 32 + 4 * hh;
    const bf16* oip = OI + (size_t)row * 512 + h * 128 + j0;
    const bf16* gp = ACT + (size_t)row * NIN + 1280 + h * 128 + j0;
    v2u ggv[4]; f32x4 gnv[4];
#pragma unroll
    for (int q = 0; q < 4; ++q) { ggv[q] = *(const v2u*)(gp + 8 * q); gnv[q] = *(const f32x4*)(gnorm + j0 + 8 * q); }
    float ss = 0.f;
#pragma unroll
    for (int q = 0; q < 4; ++q) { const v2u ow = *(const v2u*)(oip + 8 * q);
      const float oi[4] = {__builtin_bit_cast(float, ow.x << 16), __builtin_bit_cast(float, ow.x & 0xffff0000u), __builtin_bit_cast(float, ow.y << 16), __builtin_bit_cast(float, ow.y & 0xffff0000u)};
#pragma unroll
      for (int e = 0; e < 4; ++e) { acc[4 * q + e] += oi[e]; ss += acc[4 * q + e] * acc[4 * q + e]; } }
    ss += __shfl_xor(ss, 32);
    if (hh == 0) part[wid * 32 + r] = ss;
    __syncthreads();
    const float tot = part[tb * 32 + r] + part[(tb + 2) * 32 + r] + part[(tb + 4) * 32 + r] + part[(tb + 6) * 32 + r];
    const float rstd = __builtin_amdgcn_rsqf(tot * (1.f / 128.f) + RMS_EPS);
    bf16* mp = MIX + (size_t)row * 1024 + h * 128 + jb * 32 + 8 * hh;
    v2u yq[4];
#pragma unroll
    for (int q = 0; q < 4; ++q) { const v2u gg = ggv[q]; const f32x4 gn = gnv[q];
      float gv[4] = {bf2f((unsigned short)(gg.x & 0xffffu)), bf2f((unsigned short)(gg.x >> 16)), bf2f((unsigned short)(gg.y & 0xffffu)), bf2f((unsigned short)(gg.y >> 16))}; float y[4];
#pragma unroll
      for (int e = 0; e < 4; ++e) { const float sg = gv[e] * __builtin_amdgcn_rcpf(1.f + fexp(-gv[e])); y[e] = acc[4 * q + e] * rstd * gn[e] * sg; }
      yq[q] = (v2u){cvt2(y[0], y[1]), cvt2(y[2], y[3])}; }
#pragma unroll
    for (int q = 0; q < 4; q += 2) *(v4u*)(mp + 8 * q) = pair16(yq[q], yq[q + 1]);
    __syncthreads();
}
}

namespace mini {
__device__ __forceinline__ int crow(int r, int hi) { return (r & 3) + 8 * (r >> 2) + 4 * hi; }
template <int K>
__device__ __forceinline__ void piece(LAS unsigned char* lds, int p, const bf16* A  , const bf16* Bt, bf16* xb  , float* rowsq  ) {
    const int tid = fresh_tid(), wid = __builtin_amdgcn_readfirstlane(tid >> 6), lane = tid & 63, r = lane & 31, hh = lane >> 5;
    const int r0 = (p >> 4) * 64, c0 = (p & 15) * 64;
    constexpr int KW = K / 8, NS = KW / 16;
    static_assert(KW % 16 == 0, "K / 8 must be a multiple of 16");
    const bf16* ap = A + (size_t)(r0 + r) * K + wid * KW + 8 * hh; const bf16* bp = Bt + (size_t)(c0 + r) * K + wid * KW + 8 * hh;
    f32x16 acc[2][2] = {};
    constexpr int U = (NS % 11 == 0) ? 11 : 8;
    static_assert(NS % U == 0, "batching");
    for (int kb = 0; kb < NS; kb += U) {
        bf16x8 a0[U], a1[U], b0[U], b1[U];
#pragma unroll
        for (int u = 0; u < U; ++u) { a0[u] = *(const bf16x8*)(ap + (kb + u) * 16); a1[u] = *(const bf16x8*)(ap + (size_t)32 * K + (kb + u) * 16);
                                      b0[u] = *(const bf16x8*)(bp + (kb + u) * 16); b1[u] = *(const bf16x8*)(bp + (size_t)32 * K + (kb + u) * 16); }
#pragma unroll
        for (int u = 0; u < U; ++u) {
            acc[0][0] = __builtin_amdgcn_mfma_f32_32x32x16_bf16(a0[u], b0[u], acc[0][0], 0, 0, 0); acc[0][1] = __builtin_amdgcn_mfma_f32_32x32x16_bf16(a0[u], b1[u], acc[0][1], 0, 0, 0);
            acc[1][0] = __builtin_amdgcn_mfma_f32_32x32x16_bf16(a1[u], b0[u], acc[1][0], 0, 0, 0); acc[1][1] = __builtin_amdgcn_mfma_f32_32x32x16_bf16(a1[u], b1[u], acc[1][1], 0, 0, 0); }
    }
    LAS float* P = (LAS float*)lds;
#pragma unroll
    for (int i = 0; i < 2; ++i)
#pragma unroll
        for (int j = 0; j < 2; ++j)
#pragma unroll
            for (int q = 0; q < 16; ++q) P[(((wid * 2 + i) * 2 + j) * 16 + q) * 64 + lane] = acc[i][j][q];
    __syncthreads();
    float vv[8]; unsigned short xin[8];
#pragma unroll
    for (int q = 0; q < 8; ++q) { const int e = tid + 512 * q; const int ln = e & 63, reg = (e >> 6) & 15, j = (e >> 10) & 1, i = e >> 11;
        xin[q] = xb[(size_t)(r0 + 32 * i + crow(reg, ln >> 5)) * 1024 + c0 + 32 * j + (ln & 31)]; }
#pragma unroll
    for (int q = 0; q < 8; ++q) { const int e = tid + 512 * q;
        float s = 0.f;
#pragma unroll
        for (int w = 0; w < 8; ++w) s += P[w * 4096 + e];
        const int ln = e & 63, reg = (e >> 6) & 15, j = (e >> 10) & 1, i = e >> 11;
        const int row = r0 + 32 * i + crow(reg, ln >> 5), col = c0 + 32 * j + (ln & 31);
        const float v = bf2f(xin[q]) + s;
        xb[(size_t)row * 1024 + col] = (bf16)f2bf(v); vv[q] = v; }
#pragma unroll
    for (int q = 0; q < 8; ++q) { if (q & 2) continue;
        float sq = vv[q] * vv[q] + vv[q + 2] * vv[q + 2]; sq += __shfl_xor(sq, 1); sq += __shfl_xor(sq, 2); sq += __shfl_xor(sq, 4); sq += __shfl_xor(sq, 8); sq += __shfl_xor(sq, 16);
        const int e = tid + 512 * q, ln = e & 63, reg = (e >> 6) & 15, i = e >> 11; const int row = r0 + 32 * i + crow(reg, ln >> 5);
        if ((ln & 31) == 0) rowsq[(size_t)row * 16 + (p & 15)] = sq; }
    __syncthreads();
}
}

__global__ void __launch_bounds__(NWAVES * 64, 2) hymba_fwd(Args args) {
    extern __shared__ __attribute__((aligned(16))) unsigned char lds[];
    Frame F;
    F.lds = (LAS unsigned char*)lds;
    for (int u = threadIdx.x; u < (LDS_BYTES - LDSCTL_OFF) / 4; u += NWAVES * 64) ((LAS unsigned*)(F.lds + LDSCTL_OFF))[u] = 0u;
    __syncthreads();
    if (threadIdx.x == 0) { LAS unsigned long long* t = (LAS unsigned long long*)(F.lds + PTAB_OFF);
#pragma unroll
        for (int i = 0; i < 18; ++i) t[i] = (unsigned long long)args.in[i];
        t[18] = (unsigned long long)args.out; t[19] = (unsigned long long)args.ws; }
    __syncthreads();
#define CTL_ ((gu32*)(wsp(F) + WS_CTL))
    (void)xcd_barrier_post((unsigned*)(CTL_ + CW_BAR), (volatile LAS unsigned*)(F.lds + MISC_OFF) + 8);
#ifdef PROBE_DUP_BAR
#define GRID_BAR() do { XcdBarrier b_; b_.bar = (unsigned*)(CTL_ + CW_BAR); b_.x = xb_xcc_id(); b_.st = (volatile LAS unsigned*)(F.lds + MISC_OFF) + 8; xcd_barrier(b_); xcd_barrier(b_); } while (0)
#else
#define GRID_BAR() do { XcdBarrier b_; b_.bar = (unsigned*)(CTL_ + CW_BAR); b_.x = xb_xcc_id(); b_.st = (volatile LAS unsigned*)(F.lds + MISC_OFF) + 8; xcd_barrier(b_); } while (0)
#endif

#define CNT_SIGNAL(w, n) do { asm volatile("s_waitcnt vmcnt(0)" ::: "memory"); __syncthreads(); \
        if (threadIdx.x == 0) { __builtin_amdgcn_fence(__ATOMIC_RELEASE, "agent"); asm volatile("s_waitcnt vmcnt(0)" ::: "memory"); (void)xb_add((unsigned*)(w), (unsigned)(n)); } } while (0)
#define CNT_WAIT(w, target) do { if (threadIdx.x == 0) { unsigned* bar_ = (unsigned*)(CTL_ + CW_BAR); XB_SPIN(xb_ld((unsigned*)(w)) < (unsigned)(target), bar_); \
        __builtin_amdgcn_fence(__ATOMIC_ACQUIRE, "agent"); asm volatile("s_waitcnt vmcnt(0)" ::: "memory"); } __syncthreads(); } while (0)
#define WSB(off) (wsp(F) + (off))
#define X_ ((float*)WSB(WS_X))
#define XN_ ((bf16*)WSB(WS_XN))
#define ACT_ ((bf16*)WSB(WS_ACT))
#define MIX_ ((bf16*)WSB(WS_MIX))
#define HB_ ((bf16*)WSB(WS_H))
#define LOGA_ ((float*)WSB(WS_LOGA))

#ifndef SKIP_P0
    p0_items(F, 0, 1664, 0, grid_n());
#endif
    rows_to_bf16_sq(F, inp(F, 0), inp(F, 1), XN_, (float*)WSB(WS_RSQ));
    att::attn_setup_tab(F.lds, inp(F, 17));
    GRID_BAR();

    for (int l = 0; l < DEPTH; ++l) {
#define WL_ (WSB(WS_W) + (size_t)l * W_LAYER)
#define SRCP_ (l == 0 ? inp(F, 0) : (const float*)X_)
#define SRCS_ (l == 0 ? inp(F, 1) : (const float*)X_ + (size_t)SEQ * DM)
#ifndef SKIP_IN
        { pg8::Gemm g{XN_, (const bf16*)(WL_ + WO_IN), M, NIN, DM}; pg8::StaticOrder S; S.init(M, NIN, grid_n(), (int)blockIdx.x);
          rstd_prepass(F, S, (const float*)WSB(WS_RSQ) + (size_t)(2 * l) * M * 16);
#ifdef STAGGER_US
          if ((int)blockIdx.x >= (M / 256) * (NIN / 256) - 3 * grid_n()) { const unsigned long long t0_ = __builtin_amdgcn_s_memrealtime(); while (__builtin_amdgcn_s_memrealtime() - t0_ < (unsigned long long)(STAGGER_US * 100)) __builtin_amdgcn_s_sleep(32); }
#endif
          pg8::EpiIn E{wsp(F), outp(F), l, WS_ACT, WS_LOGA, (const LAS float*)(F.lds + RSTD_OFF)};
          pg8::gemm_phase<pg8::EpiIn, pg8::StaticOrder, true, true>(F.lds + RING_OFF, g, S, E);
#if defined(PROBE_DUP_GEMM) || defined(PROBE_DUP_IN)
          __syncthreads(); pg8::gemm_phase<pg8::EpiIn, pg8::StaticOrder, true, true>(F.lds + RING_OFF, g, S, E);
#endif
          { const int full = (M / 256) * (NIN / 256) - ((M / 256) * (NIN / 256) / grid_n()) * grid_n();
            const int i_lo = l * 6400 + 1664, i_hi = (l + 1 < DEPTH) ? (l + 1) * 6400 + 1664 : DEPTH * 6400;
            __syncthreads();
            int cu0_ = (full > 0 && full < grid_n()) ? full : 0; asm volatile("" : "+s"(cu0_));
            p0_items(F, i_lo, i_hi, cu0_, grid_n() - cu0_);
#ifdef PROBE_DUP_TAIL
            __syncthreads(); p0_items(F, i_lo, i_hi, cu0_, grid_n() - cu0_);
#endif
            }
        }
#endif
        GRID_BAR();
#ifndef SKIP_G1
#ifdef PROBE_DUP_G1
        for (int rep1_ = 0; rep1_ < 5; ++rep1_)
#endif
        { G1IN_DECL(gA); G1IN_DECL(gB); const int G_ = grid_n(); int u = blockIdx.x; constexpr int NU = NPCH * 4;
#define G1_LOAD(gx, uu) gla::g1_load(G1IN_ARGS(gx), (uu) >> 2, (uu) & 3, ACT_, LOGA_, inp(F, 7) + (size_t)l * 256)
#define G1_RUN(gx, uu, gn, un) gla::g1_unit<true>(F.lds + RING_OFF, G1IN_ARGS(gx), (uu) >> 2, (uu) & 3, l, (bf16*)WSB(WS_U), (float*)WSB(WS_D), (bf16*)WSB(WS_OI), (bf16*)WSB(WS_QT), (bf16*)WSB(WS_SC), \
                         inp(F, 4) + (size_t)l * DECB * 4 * 8192, outp(F) + OG_S + (size_t)l * DECB * 4 * 8192, \
                         G1IN_ARGS(gn), (un) >> 2, (un) & 3, ACT_, LOGA_, inp(F, 7) + (size_t)l * 256)
#define CLAMPU(x) ((x) < NU ? (x) : NU - 1)
          G1_LOAD(gA, CLAMPU(u));
          for (; u < NU; u += 2 * G_) {
            G1_RUN(gA, u, gB, CLAMPU(u + G_));
            if (u + G_ < NU) { G1_RUN(gB, u + G_, gA, CLAMPU(u + 2 * G_)); } }
#undef CLAMPU
#undef G1_LOAD
#undef G1_RUN
        }
#endif
        GRID_BAR();
#ifdef PROBE_DUP_GLA
        for (int rep_ = 0; rep_ < 5; ++rep_)
#endif
        for (int eg = blockIdx.x; eg < 256; eg += grid_n())
#ifndef SKIP_G2
            gla::g2_group(F.lds + RING_OFF, eg, (const bf16*)WSB(WS_U), (const float*)WSB(WS_D), (bf16*)WSB(WS_SC), outp(F) + OG_P + (size_t)l * 4 * 8192);
#endif
            ;
        { int ng_ = 0; for (int eg = blockIdx.x; eg < 256; eg += grid_n()) ++ng_;
          CNT_SIGNAL(CTL_ + CW_QUEUE + 64 * l + 16, ng_); }
        bool g2ok = false, g1sok = false;
        att::attn_setup(F.lds + RING_OFF, inp(F, 9) + (size_t)l * 256, l);
#ifdef PROBE_DUP_ATT
        for (int rep = 0; rep < 2; ++rep)
#else
        const int rep = 0;
#endif
        for (int it = 0;; ++it) {
            if (it == 0) __syncthreads();
            volatile LAS int* slot = (volatile LAS int*)(F.lds + MISC_OFF) + 16 + (it & 1);
            if (threadIdx.x == 0) *slot = (int)__hip_atomic_fetch_add((unsigned*)(CTL_ + CW_QUEUE + 64 * (l + 4 * rep)), 1u, __ATOMIC_RELAXED, __HIP_MEMORY_SCOPE_AGENT);
            __syncthreads();
            const int idx = __builtin_amdgcn_readfirstlane(*slot);
            if (idx >= 128 + 512 + NCHUNK * 4) break;
            if (idx < 64) { const int cS = NPCH + (idx >> 2), hS = idx & 3; G1IN_DECL(gS);
                gla::g1_load(G1IN_ARGS(gS), cS, hS, ACT_, LOGA_, inp(F, 7) + (size_t)l * 256);
                gla::g1_unit<false>(F.lds + RING_OFF, G1IN_ARGS(gS), cS, hS, l, (bf16*)WSB(WS_U), (float*)WSB(WS_D), (bf16*)WSB(WS_OI), (bf16*)WSB(WS_QT), (bf16*)WSB(WS_SC),
                             inp(F, 4) + (size_t)l * DECB * 4 * 8192, outp(F) + OG_S + (size_t)l * DECB * 4 * 8192, G1IN_ARGS(gS), cS, hS, ACT_, LOGA_, inp(F, 7) + (size_t)l * 256);
                CNT_SIGNAL(CTL_ + CW_QUEUE + 64 * l + 32, 1);
            } else if (idx < 128) { const int b = (idx - 64) >> 2, h = idx & 3;
                const float* kc = inp(F, 2) + ((size_t)(l * DECB + b) * PAST) * 512 + h * 128; const float* vc = inp(F, 3) + ((size_t)(l * DECB + b) * PAST) * 512 + h * 128;
                const float* kn = outp(F) + OK_S + ((size_t)(l * DECB + b) * 64) * 512 + h * 128; const float* vn = outp(F) + OV_S + ((size_t)(l * DECB + b) * 64) * 512 + h * 128;
#ifndef SKIP_AS
                att::attn_unit_sample(F.lds + RING_OFF, kc, vc, kn, vn, ACT_ + (size_t)(SEQ + 64 * b) * NIN + 1792 + h * 128, MIX_ + (size_t)(SEQ + 64 * b) * DM + 512 + h * 128,
                                      PAST, h, inp(F, 10) + (size_t)l * 128);
#endif
            } else if (idx < 640) { const int i = idx - 128, u = 127 - (i >> 2), h = i & 3;
#ifndef SKIP_AP
                int i2 = i; asm volatile("" : "+s"(i2));
                if (att::attn_unit_prompt_t<false>(F.lds + RING_OFF, ACT_ + 2304 + h * 128, ACT_ + 2816 + h * 128, ACT_ + (size_t)(128 * u) * NIN + 1792 + h * 128,
                                      MIX_ + (size_t)(128 * u) * DM + 512 + h * 128, 2 * u + 2, 128 * u, h, inp(F, 10) + (size_t)l * 128)) {
                    const int u2 = 127 - (i2 >> 2), h2 = i2 & 3; __syncthreads();
                    (void)att::attn_unit_prompt_t<true>(F.lds + RING_OFF, ACT_ + 2304 + h2 * 128, ACT_ + 2816 + h2 * 128, ACT_ + (size_t)(128 * u2) * NIN + 1792 + h2 * 128,
                                      MIX_ + (size_t)(128 * u2) * DM + 512 + h2 * 128, 2 * u2 + 2, 128 * u2, h2, inp(F, 10) + (size_t)l * 128); }
#ifdef PROBE_DUP_PROMPT
                { int i3 = i; asm volatile("" : "+s"(i3)); const int u3 = 127 - (i3 >> 2), h3 = i3 & 3; __syncthreads();
                  (void)att::attn_unit_prompt_t<false>(F.lds + RING_OFF, ACT_ + 2304 + h3 * 128, ACT_ + 2816 + h3 * 128, ACT_ + (size_t)(128 * u3) * NIN + 1792 + h3 * 128,
                                      MIX_ + (size_t)(128 * u3) * DM + 512 + h3 * 128, 2 * u3 + 2, 128 * u3, h3, inp(F, 10) + (size_t)l * 128); }
#endif
#endif
            } else { const int i = idx - 640;
                if ((i >> 2) < NPCH) { if (!g2ok) { CNT_WAIT(CTL_ + CW_QUEUE + 64 * l + 16, 256); g2ok = true; } }
                else { if (!g1sok) { CNT_WAIT(CTL_ + CW_QUEUE + 64 * l + 32, 64); g1sok = true; } }
#ifndef SKIP_G3
#ifdef PROBE_DUP_G3
                for (int r3_ = 0; r3_ < 5; ++r3_)
#endif
                gla::g3_unit((LAS float*)(F.lds + RING_OFF + att::OFF_G3), i >> 2, i & 3, ACT_, (const bf16*)WSB(WS_OI), (const bf16*)WSB(WS_QT), (const bf16*)WSB(WS_SC), inp(F, 8) + (size_t)l * 128, MIX_);
#endif
            }
        }
        GRID_BAR();
#ifndef SKIP_OUT
        { pg8::Gemm g{MIX_, (const bf16*)(WL_ + WO_OUT), SEQ, DM, DM}; pg8::StaticOrder S; S.init(SEQ, DM, grid_n(), (int)blockIdx.x);
          pg8::EpiRes E{XN_, (float*)WSB(WS_RSQ) + (size_t)(1 + 2 * l) * M * 16};
          pg8::gemm_phase<pg8::EpiRes, pg8::StaticOrder, true, true>(F.lds + RING_OFF, g, S, E);
          __syncthreads();
          for (int p = blockIdx.x; p < 256; p += grid_n())
              mini::piece<DM>(F.lds + RING_OFF, p, MIX_ + (size_t)SEQ * DM, (const bf16*)(WL_ + WO_OUT), XN_ + (size_t)SEQ * DM, (float*)WSB(WS_RSQ) + ((size_t)(1 + 2 * l) * M + SEQ) * 16);
        }
#endif
        GRID_BAR();
#ifndef SKIP_F1
        { pg8::Gemm g{XN_, (const bf16*)(WL_ + WO_F1), M, NF1, DM}; pg8::StaticOrder S; S.init(M, NF1, grid_n(), (int)blockIdx.x);
          rstd_prepass(F, S, (const float*)WSB(WS_RSQ) + (size_t)(1 + 2 * l) * M * 16);
          pg8::EpiSwi E{HB_, DFF, (const LAS float*)(F.lds + RSTD_OFF)};
          pg8::gemm_phase<pg8::EpiSwi, pg8::StaticOrder, true, true>(F.lds + RING_OFF, g, S, E);
#if defined(PROBE_DUP_GEMM) || defined(PROBE_DUP_F1)
          __syncthreads(); pg8::gemm_phase<pg8::EpiSwi, pg8::StaticOrder, true, true>(F.lds + RING_OFF, g, S, E);
#endif
        }
#endif
        GRID_BAR();
#ifndef SKIP_F2
        { pg8::Gemm g{HB_, (const bf16*)(WL_ + WO_F2), SEQ, DM, DFF}; pg8::StaticOrder S; S.init(SEQ, DM, grid_n(), (int)blockIdx.x);
          pg8::EpiRes E{XN_, (float*)WSB(WS_RSQ) + (size_t)(2 + 2 * l) * M * 16};
          pg8::gemm_phase<pg8::EpiRes, pg8::StaticOrder, true, true>(F.lds + RING_OFF, g, S, E);
          __syncthreads();
          for (int p = blockIdx.x; p < 256; p += grid_n())
              mini::piece<DFF>(F.lds + RING_OFF, p, HB_ + (size_t)SEQ * DFF, (const bf16*)(WL_ + WO_F2), XN_ + (size_t)SEQ * DM, (float*)WSB(WS_RSQ) + ((size_t)(2 + 2 * l) * M + SEQ) * 16);
        }
#endif
        GRID_BAR();
    }
    norm_rows_f32(F, XN_, inp(F, 16), outp(F) + OY);
}

extern "C" void kernel_launch(void* const* d_in, const int* in_sizes, int n_in, void* d_out, int out_size, void* d_ws, size_t ws_size, hipStream_t stream) {
    static int grid = 0;
    if (grid == 0) {
        if (n_in != 18 || (size_t)out_size != OUT_TOTAL || ws_size < WS_END) { fprintf(stderr, "kernel_launch: shape mismatch n_in %d out %d ws %zu\n", n_in, out_size, ws_size); grid = -1; return; }
        int dev = 0, cus = 0, per_cu = 0;
        if (hipGetDevice(&dev) != hipSuccess || hipDeviceGetAttribute(&cus, hipDeviceAttributeMultiprocessorCount, dev) != hipSuccess) { grid = -1; return; }
        if (hipFuncSetAttribute((const void*)hymba_fwd, hipFuncAttributeMaxDynamicSharedMemorySize, LDS_BYTES) != hipSuccess) { fprintf(stderr, "kernel_launch: hipFuncSetAttribute failed\n"); grid = -1; return; }
        if (hipOccupancyMaxActiveBlocksPerMultiprocessor(&per_cu, (const void*)hymba_fwd, NWAVES * 64, LDS_BYTES) != hipSuccess || per_cu < 1)
            fprintf(stderr, "kernel_launch: occupancy query reports %d\n", per_cu);
        (void)hipGetLastError();
        grid = cus;
    }
    if (grid < 0) return;
    if (hipMemsetAsync((char*)d_ws + WS_CTL, 0, CTL_ZERO_BYTES, stream) != hipSuccess) return;
    Args a{};
    for (int i = 0; i < 18; ++i) a.in[i] = (const float*)d_in[i];
    a.out = (float*)d_out; a.ws = (unsigned char*)d_ws;
    hipLaunchKernelGGL(hymba_fwd, dim3(grid), dim3(NWAVES * 64), LDS_BYTES, stream, a);
    const hipError_t le = hipPeekAtLastError();
    if (le != hipSuccess) fprintf(stderr, "kernel_launch: launch failed: %s\n", hipGetErrorName(le));
}
```
